# Optimizing an MI355X kernel written in HIP

```python
import math
import jax, jax.numpy as jnp
from jax import lax
import numpy as np

D_MODEL = 1024
BATCH = 4
SEQ = 8192
DEPTH = 4

N_MIXERS = 4
EPS = 1e-6
Q_BLOCK = 128
CHUNK = 128

MLA_HEADS = 8
MLA_NOPE = 128
MLA_ROPE = 64
MLA_V = 128
MLA_Q_LORA = 384
MLA_KV_LORA = 256
ROPE_THETA = 10000.0

DIFF_HEADS = 8
DIFF_HD = D_MODEL // (2 * DIFF_HEADS)

MLSTM_HEADS = 8
MLSTM_QK = D_MODEL // 2 // MLSTM_HEADS
MLSTM_V = D_MODEL // MLSTM_HEADS

RET_HEADS = D_MODEL // 256
RET_QK = 256
RET_V = 2 * D_MODEL // RET_HEADS

FFN_HIDDEN = 2816
CONV_W = 3

kernel_name = 'hybrid_interleaved_encoder'


def n_of(kind):
    return len(range(kind, DEPTH, N_MIXERS))


def rms_norm(x, g):
    xf = x.astype(jnp.float32)
    y = xf * lax.rsqrt(jnp.mean(xf * xf, -1, keepdims=True) + EPS)
    return (y * g.astype(jnp.float32)).astype(x.dtype)


def head_group_norm(x, g):
    xf = x.astype(jnp.float32)
    mu = jnp.mean(xf, -1, keepdims=True)
    xc = xf - mu
    y = xc * lax.rsqrt(jnp.mean(xc * xc, -1, keepdims=True) + EPS)
    return (y * g.astype(jnp.float32)).astype(x.dtype)


def query_blocks(t):
    b, s = t.shape[:2]
    return jnp.moveaxis(t.reshape(b, s // Q_BLOCK, Q_BLOCK, *t.shape[2:]), 1, 0)


def merge_blocks(t):
    t = jnp.moveaxis(t, 0, 1)
    return t.reshape(t.shape[0], -1, *t.shape[3:])


def rope_cos_sin(s, dim):
    inv = ROPE_THETA ** (-jnp.arange(0, dim, 2, dtype=jnp.float32) / dim)
    ang = jnp.arange(s, dtype=jnp.float32)[:, None] * inv[None, :]
    return jnp.cos(ang), jnp.sin(ang)


def apply_rope(x, cos, sin):
    half = x.shape[-1] // 2
    x1, x2 = x[..., :half], x[..., half:]
    cos = cos.astype(x.dtype)
    sin = sin.astype(x.dtype)
    return jnp.concatenate([x1 * cos - x2 * sin, x1 * sin + x2 * cos], -1)


def to_chunks(t):
    b, s = t.shape[:2]
    t = t.reshape(b, s // CHUNK, CHUNK, *t.shape[2:])
    return jnp.moveaxis(jnp.moveaxis(t, 1, 0), 3, 2)


def from_chunks(t):
    t = jnp.moveaxis(jnp.moveaxis(t, 2, 3), 0, 1)
    return t.reshape(t.shape[0], -1, *t.shape[3:])


def mla_mixer(x, w_dq, q_norm_g, w_uq, w_dkv, kv_norm_g, w_ukv, w_o):
    b, s, _ = x.shape
    H = MLA_HEADS
    cq = rms_norm(x @ w_dq, q_norm_g)
    q = (cq @ w_uq).reshape(b, s, H, MLA_NOPE + MLA_ROPE)
    ckv_kr = x @ w_dkv
    ckv = rms_norm(ckv_kr[..., :MLA_KV_LORA], kv_norm_g)
    kv = (ckv @ w_ukv).reshape(b, s, H, MLA_NOPE + MLA_V)
    k_nope, v = kv[..., :MLA_NOPE], kv[..., MLA_NOPE:]
    cos, sin = rope_cos_sin(s, MLA_ROPE)
    q_nope = q[..., :MLA_NOPE]
    q_rope = apply_rope(q[..., MLA_NOPE:], cos[:, None, :], sin[:, None, :])
    k_rope = apply_rope(ckv_kr[..., MLA_KV_LORA:], cos, sin)
    scale = (MLA_NOPE + MLA_ROPE) ** -0.5

    def block(args):
        qn, qr = args
        sc = (jnp.einsum('bqhd,bkhd->bhqk', qn, k_nope).astype(jnp.float32)
              + jnp.einsum('bqhr,bkr->bhqk', qr, k_rope).astype(jnp.float32)) * scale
        p = jax.nn.softmax(sc, -1).astype(v.dtype)
        return jnp.einsum('bhqk,bkhd->bqhd', p, v)

    o = merge_blocks(lax.map(block, (query_blocks(q_nope), query_blocks(q_rope))))
    return o.reshape(b, s, H * MLA_V) @ w_o


def diff_mixer(x, w_qkv, lam_p, subln_g, w_o, layer_idx):
    b, s, _ = x.shape
    H, d = DIFF_HEADS, DIFF_HD
    qkv = x @ w_qkv
    q = qkv[..., :2 * H * d].reshape(b, s, H, 2, d)
    k = qkv[..., 2 * H * d:4 * H * d].reshape(b, s, H, 2, d)
    v = qkv[..., 4 * H * d:].reshape(b, s, H, 2 * d)
    lam_init = 0.8 - 0.6 * math.exp(-0.3 * layer_idx)
    lp = lam_p.astype(jnp.float32)
    lam = jnp.exp(jnp.sum(lp[0] * lp[1])) - jnp.exp(jnp.sum(lp[2] * lp[3])) + lam_init
    slopes = 2.0 ** (-8.0 * jnp.arange(1, H + 1, dtype=jnp.float32) / H)
    pos = jnp.arange(s, dtype=jnp.int32)
    scale = d ** -0.5

    def block(args):
        qb, qpos = args
        sc = jnp.einsum('bqhjd,bkhjd->bhjqk', qb, k).astype(jnp.float32) * scale
        dist = jnp.abs(qpos[:, None] - pos[None, :]).astype(jnp.float32)
        sc = sc - slopes[None, :, None, None, None] * dist[None, None, None]
        p = jax.nn.softmax(sc, -1)
        a = (p[:, :, 0] - lam * p[:, :, 1]).astype(v.dtype)
        return jnp.einsum('bhqk,bkhd->bqhd', a, v)

    o = merge_blocks(lax.map(block, (query_blocks(q), pos.reshape(-1, Q_BLOCK))))
    o = rms_norm(o, subln_g) * (1.0 - lam_init)
    return o.reshape(b, s, H * 2 * d) @ w_o


def mlstm_chunkwise(q, k, v, i_pre, log_f):
    b, s, H, dk = q.shape
    dv = v.shape[-1]
    f32 = jnp.float32
    xs = (to_chunks(q.astype(f32)), to_chunks(k.astype(f32)), to_chunks(v.astype(f32)),
          to_chunks(i_pre), to_chunks(log_f))
    tri = jnp.tril(jnp.ones((CHUNK, CHUNK), bool))

    def step(carry, inp):
        C, n, m = carry
        qc, kc, vc, ic, fc = inp
        bcum = jnp.cumsum(fc, -1)
        dmat = jnp.where(tri, bcum[..., :, None] - bcum[..., None, :] + ic[..., None, :], -jnp.inf)
        m_inter = bcum + m[..., None]
        m_t = jnp.maximum(jnp.max(dmat, -1), m_inter)
        w_intra = jnp.exp(dmat - m_t[..., None])
        w_inter = jnp.exp(m_inter - m_t)
        sqk = jnp.einsum('bhtd,bhsd->bhts', qc, kc) * w_intra
        num = (w_inter[..., None] * jnp.einsum('bhtd,bhde->bhte', qc, C)
               + jnp.einsum('bhts,bhse->bhte', sqk, vc))
        den = w_inter * jnp.einsum('bhtd,bhd->bht', qc, n) + jnp.sum(sqk, -1)
        h = num / jnp.maximum(jnp.abs(den), jnp.exp(-m_t))[..., None]
        b_last = bcum[..., -1]
        g_s = b_last[..., None] - bcum + ic
        m_new = jnp.maximum(b_last + m, jnp.max(g_s, -1))
        w_s = jnp.exp(g_s - m_new[..., None])
        decay = jnp.exp(b_last + m - m_new)
        C_new = decay[..., None, None] * C + jnp.einsum('bhs,bhsd,bhse->bhde', w_s, kc, vc)
        n_new = decay[..., None] * n + jnp.einsum('bhs,bhsd->bhd', w_s, kc)
        return (C_new, n_new, m_new), h

    init = (jnp.zeros((b, H, dk, dv), f32), jnp.zeros((b, H, dk), f32), jnp.zeros((b, H), f32))
    _, hs = lax.scan(step, init, xs)
    return from_chunks(hs).astype(v.dtype)


def mlstm_mixer(x, w_in, b_gates, norm_g, w_out):
    b, s, _ = x.shape
    H, dk, dv = MLSTM_HEADS, MLSTM_QK, MLSTM_V
    proj = x @ w_in
    o1, o2, o3, o4 = H * dk, 2 * H * dk, 2 * H * dk + H * dv, 2 * H * dk + 2 * H * dv
    q = proj[..., :o1].reshape(b, s, H, dk)
    k = proj[..., o1:o2].reshape(b, s, H, dk) * (dk ** -0.5)
    v = proj[..., o2:o3].reshape(b, s, H, dv)
    o_gate = jax.nn.sigmoid(proj[..., o3:o4])
    g = (proj[..., o4:] + b_gates).astype(jnp.float32).reshape(b, s, 4, H)
    h_f = mlstm_chunkwise(q, k, v, g[:, :, 0], jax.nn.log_sigmoid(g[:, :, 1]))
    fl = lambda t: jnp.flip(t, 1)
    h_b = fl(mlstm_chunkwise(fl(q), fl(k), fl(v), fl(g[:, :, 2]), jax.nn.log_sigmoid(fl(g[:, :, 3]))))
    h = head_group_norm(h_f + h_b, norm_g.reshape(H, dv))
    return (h.reshape(b, s, H * dv) * o_gate) @ w_out


def retention_chunkwise(q, k, v, log_gamma):
    b, s, H, dk = q.shape
    dv = v.shape[-1]
    f32 = jnp.float32
    idx = jnp.arange(CHUNK, dtype=f32)
    rel = idx[:, None] - idx[None, :]
    dmask = jnp.exp(jnp.maximum(rel, 0.0)[None] * log_gamma[:, None, None]) * (rel >= 0)[None]
    xi = jnp.exp((idx[None] + 1.0) * log_gamma[:, None])
    zeta = jnp.exp((CHUNK - 1.0 - idx[None]) * log_gamma[:, None])
    g_chunk = jnp.exp(CHUNK * log_gamma)
    xs = (to_chunks(q.astype(f32)), to_chunks(k.astype(f32)), to_chunks(v.astype(f32)))

    def step(R, inp):
        qc, kc, vc = inp
        inner = jnp.einsum('bhts,bhse->bhte', jnp.einsum('bhtd,bhsd->bhts', qc, kc) * dmask, vc)
        cross = jnp.einsum('bhtd,bhde->bhte', qc, R) * xi[None, :, :, None]
        R_new = g_chunk[None, :, None, None] * R + jnp.einsum('bhsd,bhse->bhde', kc * zeta[None, :, :, None], vc)
        return R_new, inner + cross

    _, ys = lax.scan(step, jnp.zeros((b, H, dk, dv), f32), xs)
    return from_chunks(ys).astype(v.dtype)


def retention_mixer(x, w_in, decay_logit, norm_g, w_o):
    b, s, _ = x.shape
    H, dk, dv = RET_HEADS, RET_QK, RET_V
    proj = x @ w_in
    o1, o2, o3 = H * dk, 2 * H * dk, 2 * H * dk + H * dv
    q = proj[..., :o1].reshape(b, s, H, dk)
    k = proj[..., o1:o2].reshape(b, s, H, dk) * (dk ** -0.5)
    v = proj[..., o2:o3].reshape(b, s, H, dv)
    gate = proj[..., o3:]
    lg = jax.nn.log_sigmoid(decay_logit.astype(jnp.float32))
    fl = lambda t: jnp.flip(t, 1)
    y = retention_chunkwise(q, k, v, lg[0]) + fl(retention_chunkwise(fl(q), fl(k), fl(v), lg[1]))
    y = head_group_norm(y, norm_g.reshape(H, dv)).reshape(b, s, H * dv)
    return (jax.nn.silu(gate) * y) @ w_o


def conv_ffn(x, w_up, conv_w, conv_b, w_down):
    u = x @ w_up
    s = u.shape[1]
    half = CONV_W // 2
    up = jnp.pad(u, ((0, 0), (half, half), (0, 0)))
    c = conv_b
    for j in range(CONV_W):
        c = c + conv_w[j] * up[:, j:j + s]
    g, val = c[..., :FFN_HIDDEN], c[..., FFN_HIDDEN:]
    return (jax.nn.gelu(g) * val) @ w_down


def setup_inputs(seed: int = 0) -> dict:
    key = jax.random.key(seed)
    ks = iter(jax.random.split(key, 40))
    D = D_MODEL
    nA, nB, nC, nD = n_of(0), n_of(1), n_of(2), n_of(3)

    def w(shape, fan_in):
        return jax.random.normal(next(ks), shape, jnp.float32) * (fan_in ** -0.5)

    def gain(shape):
        return 1.0 + 0.02 * jax.random.normal(next(ks), shape, jnp.float32)

    inp = {}
    inp['x'] = jax.random.normal(next(ks), (BATCH, SEQ, D), jnp.float32)
    inp['norm_g'] = gain((DEPTH, 4, D))
    inp['ffn_w_up'] = w((DEPTH, D, 2 * FFN_HIDDEN), D)
    inp['ffn_conv_w'] = w((DEPTH, CONV_W, 2 * FFN_HIDDEN), CONV_W)
    inp['ffn_conv_b'] = 0.01 * jax.random.normal(next(ks), (DEPTH, 2 * FFN_HIDDEN), jnp.float32)
    inp['ffn_w_down'] = w((DEPTH, FFN_HIDDEN, D), FFN_HIDDEN)
    inp['mla_w_dq'] = w((nA, D, MLA_Q_LORA), D)
    inp['mla_q_norm_g'] = gain((nA, MLA_Q_LORA))
    inp['mla_w_uq'] = w((nA, MLA_Q_LORA, MLA_HEADS * (MLA_NOPE + MLA_ROPE)), MLA_Q_LORA)
    inp['mla_w_dkv'] = w((nA, D, MLA_KV_LORA + MLA_ROPE), D)
    inp['mla_kv_norm_g'] = gain((nA, MLA_KV_LORA))
    inp['mla_w_ukv'] = w((nA, MLA_KV_LORA, MLA_HEADS * (MLA_NOPE + MLA_V)), MLA_KV_LORA)
    inp['mla_w_o'] = w((nA, MLA_HEADS * MLA_V, D), MLA_HEADS * MLA_V)
    inp['diff_w_qkv'] = w((nB, D, 3 * D), D)
    inp['diff_lambda'] = 0.1 * jax.random.normal(next(ks), (nB, 4, DIFF_HD), jnp.float32)
    inp['diff_subln_g'] = gain((nB, 2 * DIFF_HD))
    inp['diff_w_o'] = w((nB, D, D), D)
    H = MLSTM_HEADS
    inp['mlstm_w_in'] = w((nC, D, 2 * H * MLSTM_QK + 2 * H * MLSTM_V + 4 * H), D)
    i_bias = 0.1 * jax.random.normal(next(ks), (nC, 2, H), jnp.float32)
    f_bias = jnp.linspace(3.0, 6.0, H, dtype=jnp.float32)[None, None] + 0.1 * jax.random.normal(next(ks), (nC, 2, H), jnp.float32)
    inp['mlstm_b_gates'] = jnp.stack([i_bias[:, 0], f_bias[:, 0], i_bias[:, 1], f_bias[:, 1]], 1).reshape(nC, 4 * H)
    inp['mlstm_norm_g'] = gain((nC, H * MLSTM_V))
    inp['mlstm_w_out'] = w((nC, H * MLSTM_V, D), H * MLSTM_V)
    Hr = RET_HEADS
    inp['ret_w_in'] = w((nD, D, 2 * Hr * RET_QK + 2 * Hr * RET_V), D)
    eps_h = 2.0 ** (-5.0 - np.arange(Hr, dtype=np.float32))
    base_logit = jnp.asarray(np.log((1.0 - eps_h) / eps_h), jnp.float32)
    inp['ret_decay_logit'] = base_logit[None, None] + 0.1 * jax.random.normal(next(ks), (nD, 2, Hr), jnp.float32)
    inp['ret_norm_g'] = gain((nD, Hr * RET_V))
    inp['ret_w_o'] = w((nD, Hr * RET_V, D), Hr * RET_V)
    return inp


def reference(x, norm_g, ffn_w_up, ffn_conv_w, ffn_conv_b, ffn_w_down,
              mla_w_dq, mla_q_norm_g, mla_w_uq, mla_w_dkv, mla_kv_norm_g, mla_w_ukv, mla_w_o,
              diff_w_qkv, diff_lambda, diff_subln_g, diff_w_o,
              mlstm_w_in, mlstm_b_gates, mlstm_norm_g, mlstm_w_out,
              ret_w_in, ret_decay_logit, ret_norm_g, ret_w_o):
    h = x
    for i in range(DEPTH):
        kind, j = i % N_MIXERS, i // N_MIXERS
        a = rms_norm(h, norm_g[i, 0])
        if kind == 0:
            a = mla_mixer(a, mla_w_dq[j], mla_q_norm_g[j], mla_w_uq[j], mla_w_dkv[j],
                          mla_kv_norm_g[j], mla_w_ukv[j], mla_w_o[j])
        elif kind == 1:
            a = diff_mixer(a, diff_w_qkv[j], diff_lambda[j], diff_subln_g[j], diff_w_o[j], i)
        elif kind == 2:
            a = mlstm_mixer(a, mlstm_w_in[j], mlstm_b_gates[j], mlstm_norm_g[j], mlstm_w_out[j])
        else:
            a = retention_mixer(a, ret_w_in[j], ret_decay_logit[j], ret_norm_g[j], ret_w_o[j])
        h = h + rms_norm(a, norm_g[i, 1])
        f = conv_ffn(rms_norm(h, norm_g[i, 2]), ffn_w_up[i], ffn_conv_w[i], ffn_conv_b[i], ffn_w_down[i])
        h = h + rms_norm(f, norm_g[i, 3])
    return h
```

```cpp
#include <hip/hip_runtime.h>
#include <cstdio>
#include <cstdint>

#define DI __device__ __forceinline__
#define LAS __attribute__((address_space(3)))
#define GAS __attribute__((address_space(1)))
typedef unsigned short bf16;
typedef short bf16x8 __attribute__((ext_vector_type(8)));
typedef short s16x4 __attribute__((ext_vector_type(4)));
typedef float f32x2 __attribute__((ext_vector_type(2)));
typedef float f32x4 __attribute__((ext_vector_type(4)));
typedef float f32x16 __attribute__((ext_vector_type(16)));
typedef unsigned u32x2 __attribute__((ext_vector_type(2)));
typedef unsigned u32x4 __attribute__((ext_vector_type(4)));
typedef __bf16 bf16x2_t __attribute__((ext_vector_type(2)));

constexpr int BATCH = 4, SEQ = 8192, DM = 1024, MROWS = BATCH * SEQ;
constexpr int FFN_H = 2816, FFN_U = 2 * FFN_H;
constexpr float EPS = 1e-6f, LOG2E = 1.4426950408889634f;
constexpr int NWAVES = 8, NTHREADS = NWAVES * 64;

constexpr size_t MiB = 1u << 20;
constexpr size_t WS_CTL = 0, CTL_ZERO_BYTES = 1 * MiB;
constexpr size_t WS_ROPE = 1 * MiB;
constexpr size_t WS_WT = 4 * MiB;
constexpr size_t WT_MIX = WS_WT, WT_UP = WS_WT + 16 * MiB, WT_DOWN = WS_WT + 28 * MiB;
constexpr size_t WS_XN = 40 * MiB;
constexpr size_t WS_S = 104 * MiB;
constexpr size_t WS_END = 512 * MiB;

DI unsigned pk2(float lo, float hi) { f32x2 v = {lo, hi}; bf16x2_t b = __builtin_convertvector(v, bf16x2_t); return __builtin_bit_cast(unsigned, b); }
DI float bflo(unsigned w) { return __uint_as_float(w << 16); }
DI float bfhi(unsigned w) { return __uint_as_float(w & 0xffff0000u); }
DI float bf2f(bf16 b) { return __uint_as_float((unsigned)b << 16); }
DI bf16 f2bf(float f) { return (bf16)(pk2(f, 0.f) & 0xffffu); }
DI float wave_sum(float v) {
#pragma unroll
    for (int o = 1; o < 64; o <<= 1) v += __shfl_xor(v, o);
    return v;
}
DI float fexp2(float x) { return __builtin_amdgcn_exp2f(x); }
DI float fexp(float x) { return __builtin_amdgcn_exp2f(x * LOG2E); }
DI float frcp(float x) { return __builtin_amdgcn_rcpf(x); }
DI float sigmoidf_(float x) { return frcp(1.f + fexp(-x)); }
DI float log_sigmoid_(float x) { return fminf(x, 0.f) - log1pf(expf(-fabsf(x))); }
DI int crow(int r, int hi) { return (r & 3) + 8 * (r >> 2) + 4 * hi; }
#define MFMA32(a, b, c) __builtin_amdgcn_mfma_f32_32x32x16_bf16((a), (b), (c), 0, 0, 0)

DI bf16x8 frag_row(const LAS bf16* base, int ld, int row0, int k0, int lane) {
    return *(const LAS bf16x8*)(base + (row0 + (lane & 31)) * ld + k0 + 8 * (lane >> 5));
}
typedef short v4i16_t __attribute__((ext_vector_type(4)));
DI s16x4 tr_rd(const LAS bf16* p) { return __builtin_bit_cast(s16x4, __builtin_amdgcn_ds_read_tr16_b64_v4i16((LAS v4i16_t*)p)); }
DI bf16x8 frag_tr(const LAS bf16* base, int ld, int k0, int n0, int lane) {
    const int g = lane >> 4, i = lane & 15, r = i >> 2, c = i & 3, h = lane >> 5;
    const LAS bf16* p = base + (k0 + 8 * h + r) * ld + n0 + 16 * (g & 1) + 4 * c;
    const s16x4 lo = tr_rd(p), hi = tr_rd(p + 4 * ld);
    return (bf16x8){lo[0], lo[1], lo[2], lo[3], hi[0], hi[1], hi[2], hi[3]};
}
DI bf16x8 gfrag_row(const bf16* base, int ld, int row0, int k0, int lane) {
    return *(const bf16x8*)(base + (size_t)(row0 + (lane & 31)) * ld + k0 + 8 * (lane >> 5));
}

namespace pg8 {
typedef unsigned short bf16_t;
constexpr int BM = 256, BK = 64, HALF = 128, HTB = HALF * BK * 2, STAGE_BYTES = 8 * HTB, NXCD = 8, WGM = 8;
__host__ __device__ __forceinline__ int lds_byte(int r, int c) { const int st = (r >> 4) * 2 + (c >> 5), rr = r & 15, cc = c & 31, ob = rr * 64 + cc * 2; return st * 1024 + (ob ^ (((ob >> 9) & 1) << 5)); }
__host__ __device__ __forceinline__ void stage_rc(int b, int& R, int& C) { const int st = b / 1024, sb = b % 1024, swz = sb ^ (((sb >> 9) & 1) << 5); R = (st >> 1) * 16 + swz / 64; C = (st & 1) * 32 + (swz % 64) / 2; }
__host__ __device__ __forceinline__ int perm32(int rho) { const int n = rho >> 4, i = rho & 15; return 8 * (i >> 2) + 4 * n + (i & 3); }

struct Unit { int pm, pn; };
struct Gemm { const bf16_t* A; const bf16_t* Bt; int M, N, K; int lda; int kpairA; };

struct StaticOrder {
    int nM, nN, nwg, G, c;
    __host__ __device__ void init(int M, int N, int G_, int c_) { nM = M / BM; nN = N / BM; nwg = nM * nN; G = G_; c = c_; }
    __host__ __device__ bool next(int i, Unit& u) const {
        const long L = (long)i * G + c; if (L >= nwg) return false;
        int wgid = (int)L; { const int q = nwg / NXCD, r = nwg % NXCD, xcd = wgid % NXCD, off = wgid / NXCD; wgid = (xcd < r ? xcd * (q + 1) : r * (q + 1) + (xcd - r) * q) + off; }
        const int nig = WGM * nN, gid = wgid / nig, fm = gid * WGM, gsz = (nM - fm) < WGM ? (nM - fm) : WGM;
        u.pm = fm + ((wgid % nig) % gsz); u.pn = (wgid % nig) / gsz; return true;
    }
};

DI void store8(bf16_t* p, f32x4 v0, f32x4 v1, float sc) {
    u32x4 w; w.x = pk2(v0[0] * sc, v0[1] * sc); w.y = pk2(v0[2] * sc, v0[3] * sc); w.z = pk2(v1[0] * sc, v1[1] * sc); w.w = pk2(v1[2] * sc, v1[3] * sc);
    *(u32x4*)p = w;
}
template <bool GATES> struct EpiSeg {
    static constexpr bool PERM = true;
    bf16_t *p0, *p1, *p2, *p3; int ld0, ld1, ld2, ld3; int e0, e1, e2; float s0, s1, s2, s3;
    float* gates; const float* gbias; int gblk;
    DI void operator()(const f32x4 (&acc)[2][2][4][2], const Unit& u, int wr, int wc, int fr, int fq) const {
        const int row0 = u.pm * BM + wr * 64 + fr;
#pragma unroll
        for (int bj = 0; bj < 2; ++bj) {
            const int blk = 2 * u.pn + bj;
            if (GATES && blk >= gblk) {
                if (blk == gblk && wc == 0) {
                    const f32x4 b0 = *(const f32x4*)(gbias + 8 * fq), b1 = *(const f32x4*)(gbias + 8 * fq + 4);
#pragma unroll
                    for (int ai = 0; ai < 2; ++ai)
#pragma unroll
                        for (int m = 0; m < 4; ++m) { float* gp = gates + (size_t)(row0 + ai * HALF + m * 16) * 32 + 8 * fq;
                            *(f32x4*)gp = acc[ai][bj][m][0] + b0; *(f32x4*)(gp + 4) = acc[ai][bj][m][1] + b1; }
                }
                continue;
            }
            bf16_t* base; int ld, b0; float sc;
            if (blk < e0) { base = p0; ld = ld0; b0 = 0; sc = s0; }
            else if (blk < e1) { base = p1; ld = ld1; b0 = e0; sc = s1; }
            else if (blk < e2) { base = p2; ld = ld2; b0 = e1; sc = s2; }
            else { base = p3; ld = ld3; b0 = e2; sc = s3; }
            bf16_t* cp = base + (blk - b0) * 128 + wc * 32 + 8 * fq;
#pragma unroll
            for (int ai = 0; ai < 2; ++ai)
#pragma unroll
                for (int m = 0; m < 4; ++m) store8(cp + (size_t)(row0 + ai * HALF + m * 16) * ld, acc[ai][bj][m][0], acc[ai][bj][m][1], sc);
        }
    }
};
DI EpiSeg<false> epi_plain(bf16_t* O, int ld, float sc) { EpiSeg<false> E{}; E.p0 = O; E.ld0 = ld; E.e0 = 100000; E.e1 = 100000; E.e2 = 100000; E.s0 = sc; return E; }
struct EpiMlaKV {
    static constexpr bool PERM = true;
    bf16_t* KF; bf16_t* V;
    DI void operator()(const f32x4 (&acc)[2][2][4][2], const Unit& u, int wr, int wc, int fr, int fq) const {
        const int row0 = u.pm * BM + wr * 64 + fr;
#pragma unroll
        for (int bj = 0; bj < 2; ++bj) {
            bf16_t* cp = (bj == 0 ? KF + u.pn * 192 : V + u.pn * 128) + wc * 32 + 8 * fq; const int ld = (bj == 0) ? 1536 : 1024;
#pragma unroll
            for (int ai = 0; ai < 2; ++ai)
#pragma unroll
                for (int m = 0; m < 4; ++m) store8(cp + (size_t)(row0 + ai * HALF + m * 16) * ld, acc[ai][bj][m][0], acc[ai][bj][m][1], 1.f);
        }
    }
};
struct EpiFfnUp {
    static constexpr bool PERM = true;
    bf16_t* U; bf16_t* HALO;
    DI void operator()(const f32x4 (&acc)[2][2][4][2], const Unit& u, int wr, int wc, int fr, int fq) const {
        const int row0 = u.pm * BM + wr * 64 + fr;
#pragma unroll
        for (int bj = 0; bj < 2; ++bj) {
            const int col = u.pn * 256 + bj * 128 + wc * 32 + 8 * fq;
#pragma unroll
            for (int ai = 0; ai < 2; ++ai)
#pragma unroll
                for (int m = 0; m < 4; ++m) {
                    const int row = row0 + ai * HALF + m * 16;
                    store8(U + (size_t)row * FFN_U + col, acc[ai][bj][m][0], acc[ai][bj][m][1], 1.f);
                    if (fr == 0 || fr == 15) store8(HALO + ((size_t)(row >> 4) * 2 + (fr == 15 ? 1 : 0)) * FFN_U + col, acc[ai][bj][m][0], acc[ai][bj][m][1], 1.f);
                }
        }
    }
};

template <class Epi>
DI void gemm_phase(LAS unsigned char* lds, const int tid, const Gemm g, const StaticOrder& S, const Epi& E) {
    const int wid = __builtin_amdgcn_readfirstlane(tid >> 6), lane = tid & 63, wr = wid >> 2, wc = wid & 3, fr = lane & 15, fq = lane >> 4;
    const int K = g.K; int nt = K / BK; asm volatile("" : "+s"(nt));
    unsigned voffA[2], voffB[2];
#pragma unroll
    for (int i = 0; i < 2; ++i) { int R, C; stage_rc(tid * 16 + i * 8192, R, C); const int Rb = Epi::PERM ? ((R & ~31) + perm32(R & 31)) : R;
        voffA[i] = (unsigned)(R * g.lda + C) * 2u; voffB[i] = (unsigned)(Rb * K + C) * 2u; }
    const size_t kstep = (size_t)(BK * 2);
    const size_t kpairA = (size_t)g.kpairA;
    const size_t hstepA = (size_t)HALF * g.lda * 2, hstepB = (size_t)HALF * K * 2;
    const size_t tstepA = 2 * hstepA, tstepB = 2 * hstepB;
    const unsigned ldsw = (unsigned)wid * 1024u;
    const int aoff = lds_byte(wr * 64 + fr, fq * 8), boff = lds_byte(wc * 32 + fr, fq * 8);
#define PG8_SA(b, h) (((b) * 2 + (h)) * HTB)
#define PG8_SB(b, h) ((4 + (b) * 2 + (h)) * HTB)
#define PG8_STAGE(bufoff, gbase, voff) do { _Pragma("unroll") for (int _i = 0; _i < 2; ++_i) \
        __builtin_amdgcn_global_load_lds((const unsigned*)((const char*)(gbase) + (voff)[_i]), (LAS unsigned*)(lds + (bufoff) + ldsw + _i * 8192), 16, 0, 0); } while (0)
#define PG8_LDA(dst, b, h) do { _Pragma("unroll") for (int m = 0; m < 4; ++m) _Pragma("unroll") for (int k = 0; k < 2; ++k) dst[m][k] = *(const LAS bf16x8*)(lds + PG8_SA(b, h) + aoff + m * 2048 + k * 1024); } while (0)
#define PG8_LDB(dst, b, h) do { _Pragma("unroll") for (int n = 0; n < 2; ++n) _Pragma("unroll") for (int k = 0; k < 2; ++k) dst[n][k] = *(const LAS bf16x8*)(lds + PG8_SB(b, h) + boff + n * 2048 + k * 1024); } while (0)
#define PG8_MMA(ai, bj, At, Bt) do { __builtin_amdgcn_s_setprio(1); _Pragma("unroll") for (int m = 0; m < 4; ++m) _Pragma("unroll") for (int n = 0; n < 2; ++n) _Pragma("unroll") for (int k = 0; k < 2; ++k) \
        acc[ai][bj][m][n] = __builtin_amdgcn_mfma_f32_16x16x32_bf16(Bt[n][k], At[m][k], acc[ai][bj][m][n], 0, 0, 0); __builtin_amdgcn_s_setprio(0); } while (0)
#define PG8_WAIT_V(n) asm volatile("s_waitcnt vmcnt(" #n ")" ::: "memory")
#define PG8_WAIT_L(n) asm volatile("s_waitcnt lgkmcnt(" #n ")" ::: "memory")
#define PG8_BAR __builtin_amdgcn_s_barrier()
#define PG8_SCHED __builtin_amdgcn_sched_barrier(0)
    Unit cur, nxt; int ui = 0;
    if (!S.next(0, cur)) return;
    f32x4 acc[2][2][4][2];
#pragma unroll
    for (int a = 0; a < 2; ++a)
#pragma unroll
        for (int b = 0; b < 2; ++b)
#pragma unroll
            for (int m = 0; m < 4; ++m)
#pragma unroll
                for (int n = 0; n < 2; ++n) acc[a][b][m][n] = (f32x4){0.f, 0.f, 0.f, 0.f};
    bf16x8 At[4][2], B0[2][2], B1[2][2];
    const char* cA = (const char*)g.A + (size_t)cur.pm * tstepA; const char* cB = (const char*)g.Bt + (size_t)cur.pn * tstepB;
    PG8_STAGE(PG8_SB(0, 0), cB, voffB); PG8_STAGE(PG8_SB(0, 1), cB + hstepB, voffB); PG8_STAGE(PG8_SA(0, 0), cA, voffA); PG8_STAGE(PG8_SA(0, 1), cA + hstepA, voffA);
    if (wr == 1) PG8_BAR;
    PG8_WAIT_V(2); PG8_BAR;
    PG8_STAGE(PG8_SB(1, 0), cB + kstep, voffB); PG8_STAGE(PG8_SA(1, 0), cA + kstep, voffA); PG8_STAGE(PG8_SB(1, 1), cB + hstepB + kstep, voffB);
    PG8_WAIT_V(6); PG8_BAR;
    for (;;) {
        const bool has_next = S.next(ui + 1, nxt);
        const char* nA = has_next ? (const char*)g.A + (size_t)nxt.pm * tstepA : cA; const char* nB = has_next ? (const char*)g.Bt + (size_t)nxt.pn * tstepB : cB;
#pragma unroll 1
        for (int t = 0; t < nt; t += 2) {
            const bool last = (t == nt - 2);
            const char* a1 = cA + (size_t)(t >> 1) * kpairA + kstep;
            const char* a2 = last ? nA : cA + (size_t)((t >> 1) + 1) * kpairA; const char* b2 = last ? nB : cB + (size_t)(t + 2) * kstep;
            const char* a3 = a2 + kstep; const char* b3 = b2 + kstep;
            PG8_LDB(B0, 0, 0); PG8_LDB(B1, 0, 1); PG8_SCHED; PG8_LDA(At, 0, 0); PG8_STAGE(PG8_SA(1, 1), a1 + hstepA, voffA);
            PG8_WAIT_V(8); PG8_WAIT_L(0); PG8_BAR; PG8_MMA(0, 0, At, B0); PG8_MMA(0, 1, At, B1); PG8_BAR; PG8_SCHED;
            PG8_LDA(At, 0, 1); PG8_STAGE(PG8_SB(0, 0), b2, voffB); PG8_STAGE(PG8_SB(0, 1), b2 + hstepB, voffB); PG8_STAGE(PG8_SA(0, 0), a2, voffA);
            PG8_WAIT_V(8); PG8_WAIT_L(0); PG8_BAR; PG8_MMA(1, 0, At, B0); PG8_MMA(1, 1, At, B1); PG8_BAR; PG8_SCHED;
            PG8_LDB(B0, 1, 0); PG8_LDB(B1, 1, 1); PG8_SCHED; PG8_LDA(At, 1, 0); PG8_STAGE(PG8_SA(0, 1), a2 + hstepA, voffA);
            PG8_WAIT_V(8); PG8_WAIT_L(0); PG8_BAR; PG8_MMA(0, 0, At, B0); PG8_MMA(0, 1, At, B1); PG8_BAR; PG8_SCHED;
            PG8_LDA(At, 1, 1); PG8_STAGE(PG8_SB(1, 0), b3, voffB); PG8_STAGE(PG8_SB(1, 1), b3 + hstepB, voffB); PG8_STAGE(PG8_SA(1, 0), a3, voffA);
            PG8_WAIT_V(8); PG8_WAIT_L(0); PG8_BAR; PG8_MMA(1, 0, At, B0); PG8_MMA(1, 1, At, B1); PG8_BAR; PG8_SCHED;
        }
        if (wr == 0) PG8_BAR;
        E(acc, cur, wr, wc, fr, fq);
        if (!has_next) break;
#pragma unroll
        for (int a = 0; a < 2; ++a)
#pragma unroll
            for (int b = 0; b < 2; ++b)
#pragma unroll
                for (int m = 0; m < 4; ++m)
#pragma unroll
                    for (int n = 0; n < 2; ++n) acc[a][b][m][n] = (f32x4){0.f, 0.f, 0.f, 0.f};
        cur = nxt; cA = nA; cB = nB; ++ui;
        if (wr == 1) PG8_BAR;
    }
    PG8_WAIT_V(0);
    PG8_BAR;
#undef PG8_SA
#undef PG8_SB
#undef PG8_STAGE
#undef PG8_LDA
#undef PG8_LDB
#undef PG8_MMA
#undef PG8_WAIT_V
#undef PG8_WAIT_L
#undef PG8_BAR
#undef PG8_SCHED
}
}

namespace att {
constexpr int NW = 8, QBLK = 32, KVBLK = 64, DV = 128;
constexpr float THR2 = 8.f;
#define SBAR() __builtin_amdgcn_sched_barrier(0)
DI unsigned cvtpk(float lo, float hi) { unsigned r; asm volatile("v_cvt_pk_bf16_f32 %0, %1, %2" : "=v"(r) : "v"(lo), "v"(hi)); return r; }
DI void partialSM(f32x16& p0, f32x16& p1, float& m_reg, float& mn, float& alpha) {
    float pmax = p0[0];
#pragma unroll
    for (int r = 1; r < 16; ++r) pmax = fmaxf(pmax, p0[r]);
#pragma unroll
    for (int r = 0; r < 16; ++r) pmax = fmaxf(pmax, p1[r]);
    { auto rr = __builtin_amdgcn_permlane32_swap(__float_as_uint(pmax), __float_as_uint(pmax), false, false);
      pmax = fmaxf(__uint_as_float(rr[0]), __uint_as_float(rr[1])); }
    if (__builtin_expect(__all(pmax - m_reg <= THR2), 1)) { mn = m_reg; alpha = 1.f; }
    else { mn = fmaxf(m_reg, pmax); alpha = __builtin_amdgcn_exp2f(m_reg - mn); m_reg = mn; }
#pragma unroll
    for (int r = 0; r < 16; ++r) p0[r] = p0[r] - mn;
#pragma unroll
    for (int r = 0; r < 16; ++r) p1[r] = p1[r] - mn;
#pragma unroll
    for (int r = 0; r < 16; ++r) p0[r] = __builtin_amdgcn_exp2f(p0[r]);
}
DI void finishSM(f32x16& p0, f32x16& p1, float alpha, float& l_reg, bf16x8& pa0, bf16x8& pa1, bf16x8& pa2, bf16x8& pa3) {
#pragma unroll
    for (int r = 0; r < 16; ++r) p1[r] = __builtin_amdgcn_exp2f(p1[r]);
    float ps = 0;
#pragma unroll
    for (int r = 0; r < 16; ++r) ps += p0[r];
#pragma unroll
    for (int r = 0; r < 16; ++r) ps += p1[r];
    { auto rr = __builtin_amdgcn_permlane32_swap(__float_as_uint(ps), __float_as_uint(ps), false, false);
      ps = __uint_as_float(rr[0]) + __uint_as_float(rr[1]); }
    l_reg = l_reg * alpha + ps;
#define PK4(P, BASE, OUT) do { unsigned a0 = cvtpk(P[BASE + 0], P[BASE + 1]), a1 = cvtpk(P[BASE + 2], P[BASE + 3]);   \
    unsigned b0 = cvtpk(P[BASE + 4], P[BASE + 5]), b1 = cvtpk(P[BASE + 6], P[BASE + 7]);                              \
    auto r0 = __builtin_amdgcn_permlane32_swap(a0, b0, false, false); auto r1 = __builtin_amdgcn_permlane32_swap(a1, b1, false, false); \
    u32x4 w = {r0[0], r1[0], r0[1], r1[1]}; OUT = *reinterpret_cast<bf16x8*>(&w); } while (0)
    PK4(p0, 0, pa0); PK4(p0, 8, pa1); PK4(p1, 0, pa2); PK4(p1, 8, pa3);
#undef PK4
}
DI int v_st(int k, int c) { const int kk = (k & ~0xC) | ((k & 4) << 1) | ((k & 8) >> 1); return ((kk >> 3) * 4 + (c >> 5)) * 512 + ((kk & 7) * 32 + (c & 31)) * 2; }
DI int v_rd_base(int lane) { return ((lane & 3) << 3) | (((lane >> 2) & 3) << 6) | (((lane >> 4) & 1) << 5) | (((lane >> 5) & 1) << 8); }
constexpr int v_rd_off(int d0, int ks, int half) { return d0 * 512 + ks * 4096 + half * 2048; }
template <int OFF> DI s16x4 tr_read(int vb) {
    s16x4 r; asm volatile("ds_read_b64_tr_b16 %0, %1 offset:%2" : "=&v"(r) : "v"(vb), "i"(OFF) : "memory"); return r;
}
template <int D0> DI void pv_one(f32x16& od, int vb, bf16x8 pa0, bf16x8 pa1, bf16x8 pa2, bf16x8 pa3) {
    const s16x4 l0 = tr_read<v_rd_off(D0, 0, 0)>(vb), h0 = tr_read<v_rd_off(D0, 0, 1)>(vb), l1 = tr_read<v_rd_off(D0, 1, 0)>(vb), h1 = tr_read<v_rd_off(D0, 1, 1)>(vb);
    const s16x4 l2 = tr_read<v_rd_off(D0, 2, 0)>(vb), h2 = tr_read<v_rd_off(D0, 2, 1)>(vb), l3 = tr_read<v_rd_off(D0, 3, 0)>(vb), h3 = tr_read<v_rd_off(D0, 3, 1)>(vb);
    asm volatile("s_waitcnt lgkmcnt(0)" ::: "memory"); SBAR();
#define PK(L, H) (bf16x8){L[0], L[1], L[2], L[3], H[0], H[1], H[2], H[3]}
    od = MFMA32(pa0, PK(l0, h0), od);
    od = MFMA32(pa1, PK(l1, h1), od);
    od = MFMA32(pa2, PK(l2, h2), od);
    od = MFMA32(pa3, PK(l3, h3), od);
#undef PK
}
DI void pv_d0(f32x16* o, int vb, bf16x8 pa0, bf16x8 pa1, bf16x8 pa2, bf16x8 pa3) {
    pv_one<0>(o[0], vb, pa0, pa1, pa2, pa3); pv_one<1>(o[1], vb, pa0, pa1, pa2, pa3); pv_one<2>(o[2], vb, pa0, pa1, pa2, pa3); pv_one<3>(o[3], vb, pa0, pa1, pa2, pa3);
}

template <int DQK> struct Cfg {
    static constexpr int KROWB = DQK * 2;
    static constexpr int SHM_V = KVBLK * DV * 2, SHM_K = KVBLK * DQK * 2;
    static constexpr int SHM = 2 * SHM_V + 2 * SHM_K + NW * 64 * 4;
    static constexpr int NKC = DQK / 64;
    static constexpr int CPR = DQK / 8;
};
template <int DQK, bool ALIBI, bool ROPE, int ldq, int ldk, int ldv, int ldo>
DI void attn_unit(const bf16* __restrict__ Qb, const bf16* __restrict__ Kh, const bf16* __restrict__ Vh,
                  bf16* __restrict__ Ob, int seq, float slope2, int qpos0, const float* __restrict__ rope, char* lds, const int tid) {
    using C = Cfg<DQK>;
    constexpr int ND = DQK / 16;
    const int wid = tid >> 6, lane = tid & 63, r32 = lane & 31, hi = lane >> 5;
    char* V_lds = lds; char* K_lds = lds + 2 * C::SHM_V;
    float* ws = (float*)(lds + 2 * C::SHM_V + 2 * C::SHM_K) + wid * 64; float* li_l = ws; float* al_l = ws + 32;
    float m_reg = -1e30f, l_reg = 0; f32x16 o[4] = {}; bf16x8 qr[ND];
    const bf16* Qw = Qb + (long)(wid * QBLK + r32) * ldq + hi * 8;
#pragma unroll
    for (int d0 = 0; d0 < ND; ++d0) qr[d0] = *reinterpret_cast<const bf16x8*>(Qw + d0 * 16);
    if (ROPE) {
        const float* rp = rope + (size_t)(qpos0 + wid * QBLK + r32) * 64;
#pragma unroll
        for (int d0 = ND - 4; d0 < ND; ++d0) {
            const f32x4 c0 = *(const f32x4*)(rp + (8 * (d0 - (ND - 4)) + 4 * hi) * 2), c1 = *(const f32x4*)(rp + (8 * (d0 - (ND - 4)) + 4 * hi) * 2 + 4);
            const u32x4 w = __builtin_bit_cast(u32x4, qr[d0]); u32x4 o_;
            { const float a = bflo(w[0]), b = bfhi(w[0]); o_[0] = pk2(a * c0[0] - b * c0[1], a * c0[1] + b * c0[0]); }
            { const float a = bflo(w[1]), b = bfhi(w[1]); o_[1] = pk2(a * c0[2] - b * c0[3], a * c0[3] + b * c0[2]); }
            { const float a = bflo(w[2]), b = bfhi(w[2]); o_[2] = pk2(a * c1[0] - b * c1[1], a * c1[1] + b * c1[0]); }
            { const float a = bflo(w[3]), b = bfhi(w[3]); o_[3] = pk2(a * c1[2] - b * c1[3], a * c1[3] + b * c1[2]); }
            qr[d0] = __builtin_bit_cast(bf16x8, o_);
        }
    }
    const int sr = tid >> 4, sc = (tid & 15) * 8, vst0 = v_st(sr, sc), vst1 = v_st(32 + sr, sc);
    int krow[C::NKC], kcol[C::NKC], kdst[C::NKC];
#pragma unroll
    for (int i = 0; i < C::NKC; ++i) { const int c = tid + 512 * i; krow[i] = c / C::CPR; kcol[i] = (c % C::CPR) * 8; kdst[i] = krow[i] * C::KROWB + ((kcol[i] * 2) ^ ((krow[i] & 7) << 4)); }
    const int vb0 = (int)(uintptr_t)V_lds + v_rd_base(lane);
    const float qposh = (float)(qpos0 + wid * QBLK + r32 - 4 * hi);
    struct { bf16x8 vs0, vs1, ks[C::NKC]; } st_;
#define SLOAD(k0) do { st_.vs0 = *reinterpret_cast<const bf16x8*>(&Vh[(long)((k0) + sr) * ldv + sc]); st_.vs1 = *reinterpret_cast<const bf16x8*>(&Vh[(long)((k0) + 32 + sr) * ldv + sc]); \
    _Pragma("unroll") for (int i_ = 0; i_ < C::NKC; ++i_) st_.ks[i_] = *reinterpret_cast<const bf16x8*>(&Kh[(long)((k0) + krow[i_]) * ldk + kcol[i_]]); } while (0)
#define SWRITE(b) do { *(bf16x8*)(V_lds + (b) * C::SHM_V + vst0) = st_.vs0; *(bf16x8*)(V_lds + (b) * C::SHM_V + vst1) = st_.vs1; \
    _Pragma("unroll") for (int i_ = 0; i_ < C::NKC; ++i_) *(bf16x8*)(K_lds + (b) * C::SHM_K + kdst[i_]) = st_.ks[i_]; } while (0)
#define SWAIT() asm volatile("s_waitcnt vmcnt(0)" ::: "memory")
#define RESC(a) do { if (__any((a) < 1.f)) { if (hi == 0) al_l[r32] = (a); asm volatile("s_waitcnt lgkmcnt(0)" ::: "memory"); \
    _Pragma("unroll") for (int d = 0; d < 4; ++d) _Pragma("unroll") for (int r = 0; r < 16; ++r) o[d][r] *= al_l[crow(r, hi)]; } } while (0)
#define QKT(P0, P1, KB, k0) do { P0 = f32x16{}; P1 = f32x16{}; \
    _Pragma("unroll") for (int d0 = 0; d0 < ND; ++d0) { const int cb = (d0 * 16 + hi * 8) * 2; \
        const bf16x8 b0_ = *reinterpret_cast<const bf16x8*>((KB) + r32 * C::KROWB + (cb ^ ((r32 & 7) << 4))); \
        const bf16x8 b1_ = *reinterpret_cast<const bf16x8*>((KB) + (32 + r32) * C::KROWB + (cb ^ ((r32 & 7) << 4))); \
        P0 = MFMA32(b0_, qr[d0], P0); P1 = MFMA32(b1_, qr[d0], P1); } \
    if (ALIBI) { const float kb_ = qposh - (float)(k0); \
        _Pragma("unroll") for (int r = 0; r < 16; ++r) { const float d_ = kb_ - (float)((r & 3) + 8 * (r >> 2)); P0[r] -= slope2 * fabsf(d_); P1[r] -= slope2 * fabsf(d_ - 32.f); } } } while (0)
    f32x16 pA0, pA1; float mnA, alA; bf16x8 pa0, pa1, pa2, pa3; const int NT = seq / KVBLK;
    SLOAD(0); SWAIT(); SWRITE(0); __syncthreads();
#pragma unroll 1
    for (int j = 0; j < NT; ++j) {
        const int bsel = j & 1;
        if (j + 1 < NT) SLOAD((j + 1) * KVBLK);
        SBAR(); QKT(pA0, pA1, K_lds + bsel * C::SHM_K, j * KVBLK);
        partialSM(pA0, pA1, m_reg, mnA, alA);
        RESC(alA);
        finishSM(pA0, pA1, alA, l_reg, pa0, pa1, pa2, pa3); SBAR();
        pv_d0(o, vb0 + bsel * C::SHM_V, pa0, pa1, pa2, pa3);
        if (j + 1 < NT) { SWAIT(); SWRITE(bsel ^ 1); }
        __syncthreads();
    }
    if (hi == 0) li_l[r32] = l_reg; asm volatile("s_waitcnt lgkmcnt(0)" ::: "memory");
    float rli[16];
#pragma unroll
    for (int r = 0; r < 16; ++r) rli[r] = __builtin_amdgcn_rcpf(li_l[crow(r, hi)]);
    bf16* Ow = Ob + (long)(wid * QBLK) * ldo;
#pragma unroll
    for (int r = 0; r < 16; ++r) { const int orow = crow(r, hi);
#pragma unroll
        for (int d0 = 0; d0 < 4; ++d0) Ow[(long)orow * ldo + d0 * 32 + r32] = f2bf(o[d0][r] * rli[r]); }
    __syncthreads();
#undef SLOAD
#undef SWRITE
#undef SWAIT
#undef RESC
#undef QKT
}
#undef SBAR
}

#define XB_TMO      128
#define XB_XCNT(j)  (256  + 64 * (j))
#define XB_XSUB(j)  (1280 + 64 * (j))
#define XB_XGEN(j)  (2304 + 64 * (j))
#define XB_TOP      3328
#define XB_TOPGEN   3392
#define XCD_BAR_WORDS 3456
#define XB_SPIN_CAP (1u << 18)
DI unsigned xb_ld(unsigned* p)              { return __hip_atomic_load(p, __ATOMIC_RELAXED, __HIP_MEMORY_SCOPE_AGENT); }
DI unsigned xb_add(unsigned* p, unsigned v) { return __hip_atomic_fetch_add(p, v, __ATOMIC_RELAXED, __HIP_MEMORY_SCOPE_AGENT); }
DI unsigned xb_xcc_id() { return (unsigned)__builtin_amdgcn_s_getreg((3 << 11) | 20) & 0xFu; }
#define XB_SPIN(cond, bar) do { unsigned _sp = 0; while (cond) { __builtin_amdgcn_s_sleep(1); \
    if ((++_sp & 255u) == 0u) { if (xb_ld(&(bar)[XB_TMO])) break; if (_sp > XB_SPIN_CAP) { atomicAdd(&(bar)[XB_TMO], 1u); break; } } } } while (0)
struct XcdBarrier { unsigned* bar; unsigned x; volatile LAS unsigned* st; };
DI XcdBarrier xcd_barrier_post(unsigned* bar, volatile LAS unsigned* st) {
    XcdBarrier b; b.bar = bar; b.x = xb_xcc_id(); b.st = st;
    if (threadIdx.x == 0) (void)xb_add(&bar[XB_XCNT(b.x)], 1u);
    return b;
}
DI void xcd_barrier_complete(unsigned* bar, unsigned x, unsigned& nloc, unsigned& nx) {
    const unsigned G = gridDim.x * gridDim.y * gridDim.z;
    unsigned sum, cnt, mine, sp = 0u;
    for (;;) {
        sum = 0u; cnt = 0u; mine = 0u;
#pragma unroll
        for (unsigned j = 0; j < 16; ++j) { const unsigned c = xb_ld(&bar[XB_XCNT(j)]); sum += c; cnt += (c > 0u) ? 1u : 0u; mine = (j == x) ? c : mine; }
        if (sum == G) break;
        __builtin_amdgcn_s_sleep(1);
        if ((++sp & 255u) == 0u) { if (xb_ld(&bar[XB_TMO])) break; if (sp > XB_SPIN_CAP) { atomicAdd(&bar[XB_TMO], 1u); break; } }
    }
    nloc = mine > 0u ? mine : 1u; nx = cnt > 0u ? cnt : 1u;
}
DI void xcd_barrier(const XcdBarrier& b) {
    asm volatile("s_waitcnt vmcnt(0)" ::: "memory");
    __syncthreads();
    if (threadIdx.x == 0) {
        unsigned* bar = b.bar;
        __builtin_amdgcn_s_waitcnt(0);
        unsigned nloc = b.st[0], nx = b.st[1];
        if (nloc == 0u) { xcd_barrier_complete(bar, b.x, nloc, nx); b.st[0] = nloc; b.st[1] = nx; }
        const unsigned old = xb_add(&bar[XB_XSUB(b.x)], 1u);
        const unsigned gen = old / nloc;
        if (old + 1u == (gen + 1u) * nloc) {
            __builtin_amdgcn_fence(__ATOMIC_RELEASE, "agent");
            asm volatile("s_waitcnt vmcnt(0)" ::: "memory");
            const unsigned og = xb_add(&bar[XB_TOP], 1u);
            const unsigned tg = og / nx;
            if (og + 1u == (tg + 1u) * nx) xb_add(&bar[XB_TOPGEN], 1u);
            else XB_SPIN(xb_ld(&bar[XB_TOPGEN]) == tg, bar);
            __builtin_amdgcn_fence(__ATOMIC_ACQUIRE, "agent");
            xb_add(&bar[XB_XGEN(b.x)], 1u);
            asm volatile("s_waitcnt vmcnt(0)" ::: "memory");
        } else {
            XB_SPIN(xb_ld(&bar[XB_XGEN(b.x)]) == gen, bar);
            __builtin_amdgcn_fence(__ATOMIC_ACQUIRE, "agent");
            asm volatile("s_waitcnt vmcnt(0)" ::: "memory");
        }
    }
    __syncthreads();
}

constexpr int RING_BYTES = 131072;
constexpr int LDSCTL_OFF = RING_BYTES, MISC_OFF = LDSCTL_OFF + 320;
constexpr int LDS_BYTES = 147456;

struct Ctx { LAS unsigned char* lds; int tid, lane, wave, G, bx, gw, NGW; };

enum { MAP_ID = 0, MAP_ROPEQ = 1, MAP_FFNUP = 2 };
DI int map_row(int kind, int n) {
    if (kind == MAP_ROPEQ) { const int h = n / 192, r = n % 192; if (r < 128) return n; const int i = r - 128; return h * 192 + 128 + ((i < 32) ? 2 * i : 2 * (i - 32) + 1); }
    if (kind == MAP_FFNUP) { if (n < FFN_H) return (n >> 7) * 256 + (n & 127); const int c = n - FFN_H; return (c >> 7) * 256 + 128 + (c & 127); }
    return n;
}
DI void transpose_item(const float* W, int K, int N, bf16* WT, int kind, int row_off, LAS float* scr, int item, int lane) {
    const int nblk = N / 32, kb = item / nblk, nb = item % nblk, k0 = 64 * kb, n0 = 32 * nb;
#pragma unroll 8
    for (int i = 0; i < 32; ++i) { const int kk = 2 * i + (lane >> 5); scr[kk * 33 + (lane & 31)] = W[(size_t)(k0 + kk) * N + n0 + (lane & 31)]; }
    asm volatile("s_waitcnt lgkmcnt(0)" ::: "memory");
    const int c = lane & 7;
#pragma unroll
    for (int j = 0; j < 4; ++j) { const int n = (lane >> 3) + 8 * j; const LAS float* s = scr + (8 * c) * 33 + n;
        u32x4 o; o.x = pk2(s[0 * 33], s[1 * 33]); o.y = pk2(s[2 * 33], s[3 * 33]); o.z = pk2(s[4 * 33], s[5 * 33]); o.w = pk2(s[6 * 33], s[7 * 33]);
        *(u32x4*)(WT + (size_t)(row_off + map_row(kind, n0 + n)) * K + k0 + 8 * c) = o; }
    asm volatile("s_waitcnt lgkmcnt(0)" ::: "memory");
}
struct TJob { const float* W; int K, N; bf16* WT; int kind, row_off; };
template <int NJ> DI void run_transposes(const Ctx& c, const TJob (&jobs)[NJ]) {
    LAS float* scr = (LAS float*)(c.lds + c.wave * 16384);
    int total = 0;
#pragma unroll
    for (int j = 0; j < NJ; ++j) total += (jobs[j].K / 64) * (jobs[j].N / 32);
    for (int it = c.gw; it < total; it += c.NGW) {
        int r = it;
#pragma unroll
        for (int j = 0; j < NJ; ++j) { const int n = (jobs[j].K / 64) * (jobs[j].N / 32);
            if (r >= 0 && r < n) transpose_item(jobs[j].W, jobs[j].K, jobs[j].N, jobs[j].WT, jobs[j].kind, jobs[j].row_off, scr, r, c.lane);
            r -= n; }
    }
}
DI void zero_rows(const Ctx& c, bf16* WT, int K, int row0, int nrows) {
    for (int r = c.gw; r < nrows; r += c.NGW) { u32x4* p = (u32x4*)(WT + (size_t)(row0 + r) * K);
        for (int i = c.lane; i < K / 8; i += 64) p[i] = (u32x4){0u, 0u, 0u, 0u}; }
}

DI void load_row_f32(const float* row, int lane, f32x4 (&v)[4]) {
#pragma unroll
    for (int j = 0; j < 4; ++j) v[j] = *((const f32x4*)row + lane + 64 * j);
}
DI void load_row_bf16(const bf16* row, int lane, f32x4 (&v)[4]) {
#pragma unroll
    for (int j = 0; j < 4; ++j) { const u32x2 w = *((const u32x2*)row + lane + 64 * j); v[j] = (f32x4){bflo(w.x), bfhi(w.x), bflo(w.y), bfhi(w.y)}; }
}
DI void store_row_bf16(bf16* row, int lane, const f32x4 (&v)[4]) {
#pragma unroll
    for (int j = 0; j < 4; ++j) { u32x2 w; w.x = pk2(v[j][0], v[j][1]); w.y = pk2(v[j][2], v[j][3]); *((u32x2*)row + lane + 64 * j) = w; }
}
DI float sumsq4(const f32x4 (&v)[4]) { float s = 0.f;
#pragma unroll
    for (int j = 0; j < 4; ++j) s += (v[j][0] * v[j][0] + v[j][1] * v[j][1]) + (v[j][2] * v[j][2] + v[j][3] * v[j][3]);
    return s; }
DI void pass_norm0(const Ctx& c, const float* x, const float* g, bf16* XN) {
    f32x4 gv[4]; load_row_f32(g, c.lane, gv);
    for (int m = c.gw; m < MROWS; m += c.NGW) {
        f32x4 v[4]; load_row_f32(x + (size_t)m * DM, c.lane, v);
        const float rstd = rsqrtf(wave_sum(sumsq4(v)) * (1.f / DM) + EPS);
#pragma unroll
        for (int j = 0; j < 4; ++j) v[j] = v[j] * rstd * gv[j];
        store_row_bf16(XN + (size_t)m * DM, c.lane, v);
    }
}
DI void pass_res_norm(const Ctx& c, const bf16* a, const float* base, const float* g1, const float* g2, float* out, bf16* XN) {
    f32x4 g1v[4], g2v[4]; load_row_f32(g1, c.lane, g1v);
    if (XN) load_row_f32(g2, c.lane, g2v);
    for (int m = c.gw; m < MROWS; m += c.NGW) {
        f32x4 v[4], b[4]; load_row_bf16(a + (size_t)m * DM, c.lane, v); load_row_f32(base + (size_t)m * DM, c.lane, b);
        const float rstd = rsqrtf(wave_sum(sumsq4(v)) * (1.f / DM) + EPS);
#pragma unroll
        for (int j = 0; j < 4; ++j) { b[j] = b[j] + v[j] * rstd * g1v[j]; *((f32x4*)(out + (size_t)m * DM) + c.lane + 64 * j) = b[j]; }
        if (XN) {
            const float rstd2 = rsqrtf(wave_sum(sumsq4(b)) * (1.f / DM) + EPS);
#pragma unroll
            for (int j = 0; j < 4; ++j) b[j] = b[j] * rstd2 * g2v[j];
            store_row_bf16(XN + (size_t)m * DM, c.lane, b);
        }
    }
}

__device__ const double ROPE_INV[32] = {
    1.0, 0.7498942093324559, 0.5623413251903491, 0.4216965034285822, 0.31622776601683794, 0.23713737056616552, 0.1778279410038923, 0.1333521432163324,
    0.1, 0.07498942093324558, 0.05623413251903491, 0.042169650342858224, 0.03162277660168379, 0.023713737056616554, 0.01778279410038923, 0.01333521432163324,
    0.01, 0.007498942093324558, 0.005623413251903491, 0.004216965034285823, 0.0031622776601683794, 0.0023713737056616554, 0.0017782794100389228, 0.001333521432163324,
    0.001, 0.0007498942093324559, 0.0005623413251903491, 0.00042169650342858224, 0.00031622776601683794, 0.00023713737056616554, 0.00017782794100389227, 0.0001333521432163324};
DI void fill_rope(const Ctx& c, float* rope) {
    for (int i = c.bx * NTHREADS + c.tid; i < SEQ * 32; i += c.G * NTHREADS) {
        const int pos = i >> 5, k = i & 31;
        const double t = (double)pos * ROPE_INV[k] * 0.15915494309189535;
        const float fr = (float)(t - (double)(long long)t);
        rope[2 * i] = __builtin_amdgcn_cosf(fr); rope[2 * i + 1] = __builtin_amdgcn_sinf(fr);
    }
}
DI void pass_mla_mid(const Ctx& c, const bf16* DQKV, const float* gq, const float* gkv, const float* rope, bf16* CQ, bf16* CKV, bf16* KF) {
    float gqv[6], gkvv[4];
#pragma unroll
    for (int i = 0; i < 6; ++i) gqv[i] = gq[c.lane + 64 * i];
#pragma unroll
    for (int i = 0; i < 4; ++i) gkvv[i] = gkv[c.lane + 64 * i];
    for (int m = c.gw; m < MROWS; m += c.NGW) {
        const bf16* row = DQKV + (size_t)m * 768;
        float xq[6], xk[4]; float sq = 0.f, sk = 0.f;
#pragma unroll
        for (int i = 0; i < 6; ++i) { xq[i] = bf2f(row[c.lane + 64 * i]); sq += xq[i] * xq[i]; }
#pragma unroll
        for (int i = 0; i < 4; ++i) { xk[i] = bf2f(row[384 + c.lane + 64 * i]); sk += xk[i] * xk[i]; }
        const float rq = rsqrtf(wave_sum(sq) * (1.f / 384.f) + EPS), rk = rsqrtf(wave_sum(sk) * (1.f / 256.f) + EPS);
#pragma unroll
        for (int i = 0; i < 6; ++i) CQ[(size_t)m * 384 + c.lane + 64 * i] = f2bf(xq[i] * rq * gqv[i]);
#pragma unroll
        for (int i = 0; i < 4; ++i) CKV[(size_t)m * 256 + c.lane + 64 * i] = f2bf(xk[i] * rk * gkvv[i]);
        const int i = c.lane & 31; const float x1 = bf2f(row[640 + i]), x2 = bf2f(row[672 + i]);
        const float* rp = rope + ((size_t)(m & (SEQ - 1)) * 32 + i) * 2; const float cs = rp[0], sn = rp[1];
        const float ov = (c.lane < 32) ? (x1 * cs - x2 * sn) : (x1 * sn + x2 * cs);
        const bf16 ob = f2bf(ov); const int idx = 2 * i + (c.lane >> 5);
#pragma unroll
        for (int h = 0; h < 8; ++h) KF[(size_t)m * 1536 + h * 192 + 128 + idx] = ob;
    }
}
template <int DQK, bool ALIBI, bool ROPE, int ldq, int qhs, int ldk, int khs, int ldv, int vhs, int vdiv, int ldo, int ohs, int nheads>
DI void attention_phase(const Ctx& c, const bf16* Q, const bf16* K, const bf16* V, bf16* O, const float* rope) {
    constexpr int NU = BATCH * nheads * 32;
    for (int u = c.bx; u < NU; u += c.G) {
        const int xcd = u & 7, slot = (u >> 3) & 31, rnd = u >> 8, bh = xcd + 8 * rnd, qb = slot;
        const int b = bh / nheads, h = bh % nheads;
        const size_t row0 = (size_t)b * SEQ;
        const float slope2 = ALIBI ? exp2f(-(float)(h / 2 + 1)) * LOG2E : 0.f;
        att::attn_unit<DQK, ALIBI, ROPE, ldq, ldk, ldv, ldo>(Q + (row0 + qb * 256) * ldq + h * qhs, K + row0 * ldk + h * khs, V + row0 * ldv + (h / vdiv) * vhs,
                                   O + (row0 + qb * 256) * ldo + h * ohs, SEQ, slope2, qb * 256, rope, (char*)c.lds, c.tid);
    }
}

DI void pass_diff_combine(const Ctx& c, const bf16* OS, const float* lamp, const float* subg, bf16* OC) {
    const float lam_init = 0.8f - 0.6f * expf(-0.3f * 1.0f);
    const float sa = wave_sum(lamp[c.lane] * lamp[64 + c.lane]), sb = wave_sum(lamp[128 + c.lane] * lamp[192 + c.lane]);
    const float lam = expf(sa) - expf(sb) + lam_init;
    const int h = c.lane >> 3, e0 = (c.lane & 7) * 16;
    float gv[16];
#pragma unroll
    for (int i = 0; i < 16; ++i) gv[i] = subg[e0 + i] * (1.f - lam_init);
    for (int m = c.gw; m < MROWS; m += c.NGW) {
        const bf16* r1 = OS + (size_t)m * 2048 + (2 * h) * 128 + e0; const bf16* r2 = r1 + 128;
        const u32x4 a0 = *(const u32x4*)r1, a1 = *(const u32x4*)(r1 + 8), b0 = *(const u32x4*)r2, b1 = *(const u32x4*)(r2 + 8);
        float o[16]; float ss = 0.f;
#pragma unroll
        for (int i = 0; i < 4; ++i) { o[2 * i] = bflo(a0[i]) - lam * bflo(b0[i]); o[2 * i + 1] = bfhi(a0[i]) - lam * bfhi(b0[i]);
            o[8 + 2 * i] = bflo(a1[i]) - lam * bflo(b1[i]); o[8 + 2 * i + 1] = bfhi(a1[i]) - lam * bfhi(b1[i]); }
#pragma unroll
        for (int i = 0; i < 16; ++i) ss += o[i] * o[i];
        ss += __shfl_xor(ss, 1); ss += __shfl_xor(ss, 2); ss += __shfl_xor(ss, 4);
        const float rstd = rsqrtf(ss * (1.f / 128.f) + EPS);
        u32x4 w0, w1;
#pragma unroll
        for (int i = 0; i < 4; ++i) { w0[i] = pk2(o[2 * i] * rstd * gv[2 * i], o[2 * i + 1] * rstd * gv[2 * i + 1]); w1[i] = pk2(o[8 + 2 * i] * rstd * gv[8 + 2 * i], o[8 + 2 * i + 1] * rstd * gv[8 + 2 * i + 1]); }
        bf16* op = OC + (size_t)m * 1024 + h * 128 + e0; *(u32x4*)op = w0; *(u32x4*)(op + 8) = w1;
    }
}

DI float gelu_tanh(float x) { const float z = 0.7978845608028654f * (x + 0.044715f * x * x * x); return x * frcp(1.f + fexp(-2.f * z)); }
DI void pass_conv(const Ctx& c, bf16* U, const bf16* HALO, const float* cw, const float* cb) {
    const int NSTRIP = MROWS / 16;
    for (int s = c.gw; s < NSTRIP; s += c.NGW) {
        const int t0 = s * 16; const bool first = (t0 & (SEQ - 1)) == 0, lastst = ((t0 + 16) & (SEQ - 1)) == 0;
        for (int it = 0; it < 11; ++it) {
            const int cc = c.lane + 64 * it, ch = 4 * cc, gcol = (ch >> 7) * 256 + (ch & 127);
            const f32x4 wg0 = *(const f32x4*)(cw + ch), wg1 = *(const f32x4*)(cw + FFN_U + ch), wg2 = *(const f32x4*)(cw + 2 * FFN_U + ch), bg = *(const f32x4*)(cb + ch);
            const f32x4 wv0 = *(const f32x4*)(cw + FFN_H + ch), wv1 = *(const f32x4*)(cw + FFN_U + FFN_H + ch), wv2 = *(const f32x4*)(cw + 2 * FFN_U + FFN_H + ch), bv = *(const f32x4*)(cb + FFN_H + ch);
            u32x2 pg, pv, cg, cv, ng, nv;
            if (first) { pg = (u32x2){0u, 0u}; pv = pg; } else { const bf16* hp = HALO + ((size_t)(s - 1) * 2 + 1) * FFN_U + gcol; pg = *(const u32x2*)hp; pv = *(const u32x2*)(hp + 128); }
            { const bf16* up = U + (size_t)t0 * FFN_U + gcol; cg = *(const u32x2*)up; cv = *(const u32x2*)(up + 128); }
#pragma unroll 4
            for (int r = 0; r < 16; ++r) {
                if (r < 15) { const bf16* up = U + (size_t)(t0 + r + 1) * FFN_U + gcol; ng = *(const u32x2*)up; nv = *(const u32x2*)(up + 128); }
                else if (lastst) { ng = (u32x2){0u, 0u}; nv = ng; }
                else { const bf16* hp = HALO + ((size_t)(s + 1) * 2) * FFN_U + gcol; ng = *(const u32x2*)hp; nv = *(const u32x2*)(hp + 128); }
                f32x4 g_, v_;
                g_[0] = bg[0] + wg0[0] * bflo(pg.x) + wg1[0] * bflo(cg.x) + wg2[0] * bflo(ng.x); g_[1] = bg[1] + wg0[1] * bfhi(pg.x) + wg1[1] * bfhi(cg.x) + wg2[1] * bfhi(ng.x);
                g_[2] = bg[2] + wg0[2] * bflo(pg.y) + wg1[2] * bflo(cg.y) + wg2[2] * bflo(ng.y); g_[3] = bg[3] + wg0[3] * bfhi(pg.y) + wg1[3] * bfhi(cg.y) + wg2[3] * bfhi(ng.y);
                v_[0] = bv[0] + wv0[0] * bflo(pv.x) + wv1[0] * bflo(cv.x) + wv2[0] * bflo(nv.x); v_[1] = bv[1] + wv0[1] * bfhi(pv.x) + wv1[1] * bfhi(cv.x) + wv2[1] * bfhi(nv.x);
                v_[2] = bv[2] + wv0[2] * bflo(pv.y) + wv1[2] * bflo(cv.y) + wv2[2] * bflo(nv.y); v_[3] = bv[3] + wv0[3] * bfhi(pv.y) + wv1[3] * bfhi(cv.y) + wv2[3] * bfhi(nv.y);
                u32x2 o; o.x = pk2(gelu_tanh(g_[0]) * v_[0], gelu_tanh(g_[1]) * v_[1]); o.y = pk2(gelu_tanh(g_[2]) * v_[2], gelu_tanh(g_[3]) * v_[3]);
                *(u32x2*)(U + (size_t)(t0 + r) * FFN_U + gcol) = o;
                pg = cg; pv = cv; cg = ng; cv = nv;
            }
        }
    }
}

constexpr int ML_CH = 128, ML_NC = SEQ / ML_CH, ML_H = 8, ML_DK = 64, ML_DV = 128, ML_EX = 160;
constexpr int ML_LDK = 72, ML_LDV = 168, ML_LDP = 136;
struct MlLds { LAS bf16* kA; LAS bf16* kB; LAS bf16* vx; LAS bf16* P; LAS bf16* Cs; LAS float* sc; };
DI void ml_gates(const Ctx& c, const float* gates, int row0, int h, LAS float* sc) {
    if (c.tid < 128) { const float* g = gates + (size_t)(row0 + c.tid) * 32 + h;
        sc[c.tid] = g[0]; sc[128 + c.tid] = log_sigmoid_(g[8]); sc[256 + c.tid] = g[16]; sc[384 + c.tid] = log_sigmoid_(g[24]); }
    __syncthreads();
    if (c.tid == 0) { float a = 0.f;
#pragma unroll 4
        for (int t = 0; t < 128; ++t) { a += sc[128 + t]; sc[512 + t] = a; } }
    if (c.tid == 64) { float a = 0.f;
#pragma unroll 4
        for (int t = 127; t >= 0; --t) { a += sc[384 + t]; sc[640 + t] = a; } }
    __syncthreads();
}
DI void ml_load_v(const Ctx& c, const bf16* v, int row0, int h, LAS bf16* vx) {
#pragma unroll
    for (int i = 0; i < 4; ++i) { const int ch = c.tid + 512 * i, r = ch >> 4, cc = (ch & 15) * 8;
        *(LAS u32x4*)(vx + r * ML_LDV + cc) = *(const u32x4*)(v + (size_t)(row0 + r) * 1024 + h * 128 + cc); }
    if (c.tid < 128) { LAS bf16* p = vx + c.tid * ML_LDV + 128;
        *(LAS u32x4*)p = (u32x4){0x00003f80u, 0u, 0u, 0u}; *(LAS u32x4*)(p + 8) = (u32x4){0u, 0u, 0u, 0u}; *(LAS u32x4*)(p + 16) = (u32x4){0u, 0u, 0u, 0u}; *(LAS u32x4*)(p + 24) = (u32x4){0u, 0u, 0u, 0u}; }
}
DI void ml_phase1(const Ctx& c, const bf16* k, const bf16* v, const float* gates, bf16* ST, float* DEC) {
    LAS bf16* kA = (LAS bf16*)c.lds; LAS bf16* kB = kA + 128 * ML_LDK; LAS bf16* vx = kB + 128 * ML_LDK; LAS float* sc = (LAS float*)(vx + 128 * ML_LDV);
    const int NU = BATCH * ML_H * ML_NC;
    for (int u = c.bx; u < NU; u += c.G) {
        const int ck = u % ML_NC, h = (u / ML_NC) % ML_H, b = u / (ML_NC * ML_H); const int row0 = b * SEQ + ck * ML_CH;
        ml_gates(c, gates, row0, h, sc);
        const float bl = sc[512 + 127], B0 = sc[640];
#pragma unroll
        for (int i = 0; i < 2; ++i) { const int ch = c.tid + 512 * i, r = ch >> 3, cc = (ch & 7) * 8;
            const u32x4 w = *(const u32x4*)(k + (size_t)(row0 + r) * 512 + h * 64 + cc);
            const float wF = fexp(bl - sc[512 + r] + sc[r]), wB = fexp(B0 - sc[640 + r] + sc[256 + r]);
            u32x4 a, bb;
#pragma unroll
            for (int q = 0; q < 4; ++q) { a[q] = pk2(bflo(w[q]) * wF, bfhi(w[q]) * wF); bb[q] = pk2(bflo(w[q]) * wB, bfhi(w[q]) * wB); }
            *(LAS u32x4*)(kA + r * ML_LDK + cc) = a; *(LAS u32x4*)(kB + r * ML_LDK + cc) = bb; }
        ml_load_v(c, v, row0, h, vx);
        __syncthreads();
#pragma unroll 1
        for (int id = c.wave; id < 20; id += 8) {
            const int dir = id / 10, rem = id % 10, db = rem / 5, eb = rem % 5;
            const LAS bf16* kw = dir ? kB : kA;
            f32x16 acc = {};
#pragma unroll 2
            for (int ks = 0; ks < 8; ++ks) acc = MFMA32(frag_tr(kw, ML_LDK, 16 * ks, 32 * db, c.lane), frag_tr(vx, ML_LDV, 16 * ks, 32 * eb, c.lane), acc);
            bf16* dst = ST + ((size_t)((b * ML_H + h) * 2 + dir) * ML_NC + ck) * (ML_DK * ML_EX);
            const int n = c.lane & 31, hi = c.lane >> 5;
#pragma unroll
            for (int r = 0; r < 16; ++r) dst[(32 * db + crow(r, hi)) * ML_EX + 32 * eb + n] = f2bf(acc[r]);
        }
        if (c.tid == 0) { float* d = DEC + (size_t)((b * ML_H + h) * 2) * ML_NC + ck; d[0] = fexp(bl); d[ML_NC] = fexp(B0); }
        __syncthreads();
    }
}
DI void ml_phase2(const Ctx& c, bf16* ST, const float* DEC) {
    constexpr int NG = ML_DK * ML_EX / 8;
    const int NTASK = BATCH * ML_H * 2 * NG;
    for (int t = c.bx * NTHREADS + c.tid; t < NTASK; t += c.G * NTHREADS) {
        const int g = t % NG, chain = t / NG, dir = chain & 1;
        bf16* base = ST + (size_t)chain * ML_NC * (ML_DK * ML_EX) + g * 8; const float* dec = DEC + (size_t)chain * ML_NC;
        float carry[8];
#pragma unroll
        for (int i = 0; i < 8; ++i) carry[i] = 0.f;
        for (int s = 0; s < ML_NC; ++s) {
            const int ck = dir ? (ML_NC - 1 - s) : s;
            u32x4* p = (u32x4*)(base + (size_t)ck * (ML_DK * ML_EX)); const u32x4 a = *p; const float d = dec[ck];
            u32x4 o;
#pragma unroll
            for (int q = 0; q < 4; ++q) { o[q] = pk2(carry[2 * q], carry[2 * q + 1]); carry[2 * q] = d * carry[2 * q] + bflo(a[q]); carry[2 * q + 1] = d * carry[2 * q + 1] + bfhi(a[q]); }
            *p = o;
        }
    }
}
DI void ml_phase3(const Ctx& c, const bf16* q, const bf16* k, const bf16* v, const bf16* og, const float* gates, const bf16* ST, const float* ng, bf16* Z) {
    LAS bf16* kl = (LAS bf16*)c.lds; LAS bf16* vx = kl + 128 * ML_LDK; LAS bf16* P = vx + 128 * ML_LDV; LAS bf16* Cs = P + 128 * ML_LDP; LAS float* sc = (LAS float*)(Cs + 64 * ML_LDV);
    LAS bf16* hb = P;
    const int NU = BATCH * ML_H * ML_NC;
    const int n = c.lane & 31, hi = c.lane >> 5, tb = c.wave & 3, wg2 = c.wave >> 2;
    for (int u = c.bx; u < NU; u += c.G) {
        const int ck = u % ML_NC, h = (u / ML_NC) % ML_H, b = u / (ML_NC * ML_H); const int row0 = b * SEQ + ck * ML_CH;
        ml_gates(c, gates, row0, h, sc);
#pragma unroll
        for (int i = 0; i < 2; ++i) { const int ch = c.tid + 512 * i, r = ch >> 3, cc = (ch & 7) * 8;
            *(LAS u32x4*)(kl + r * ML_LDK + cc) = *(const u32x4*)(k + (size_t)(row0 + r) * 512 + h * 64 + cc); }
        ml_load_v(c, v, row0, h, vx);
        const bf16* qg = q + (size_t)row0 * 512 + h * 64;
        bf16x8 qf[4];
#pragma unroll
        for (int kd = 0; kd < 4; ++kd) qf[kd] = gfrag_row(qg, 512, 32 * tb, 16 * kd, c.lane);
        f32x16 hs[2] = {};
#pragma unroll 1
        for (int dir = 0; dir < 2; ++dir) {
            const bf16* st = ST + ((size_t)((b * ML_H + h) * 2 + dir) * ML_NC + ck) * (ML_DK * ML_EX);
            for (int ch = c.tid; ch < 64 * 20; ch += NTHREADS) { const int r = ch / 20, cc = (ch % 20) * 8; *(LAS u32x4*)(Cs + r * ML_LDV + cc) = *(const u32x4*)(st + r * ML_EX + cc); }
            __syncthreads();
            const int ioff = dir ? 256 : 0, boff = dir ? 640 : 512;
            const float bt = sc[boff + 32 * tb + n];
#pragma unroll 1
            for (int sb2 = 0; sb2 < 2; ++sb2) {
                const int sb = 2 * wg2 + sb2;
                f32x16 a = {};
#pragma unroll
                for (int kd = 0; kd < 4; ++kd) a = MFMA32(frag_row(kl, ML_LDK, 32 * sb, 16 * kd, c.lane), qf[kd], a);
                const int t = 32 * tb + n;
#pragma unroll
                for (int g4 = 0; g4 < 4; ++g4) {
                    const int s0 = 32 * sb + 8 * g4 + 4 * hi;
                    float w[4];
#pragma unroll
                    for (int j = 0; j < 4; ++j) { const int s = s0 + j; const bool keep = dir ? (s >= t) : (s <= t);
                        const float e = fexp(fminf(bt - sc[boff + s], 0.f) + sc[ioff + s]); w[j] = keep ? a[4 * g4 + j] * e : 0.f; }
                    u32x2 o; o.x = pk2(w[0], w[1]); o.y = pk2(w[2], w[3]);
                    *(LAS u32x2*)(P + t * ML_LDP + s0) = o;
                }
            }
            __syncthreads();
            f32x16 acc[3] = {}, aci[3] = {};
#pragma unroll 2
            for (int ks = 0; ks < 8; ++ks) { const bf16x8 A = frag_row(P, ML_LDP, 32 * tb, 16 * ks, c.lane);
#pragma unroll
                for (int e = 0; e < 3; ++e) { const int et = (e == 2) ? 4 : 2 * wg2 + e; acc[e] = MFMA32(A, frag_tr(vx, ML_LDV, 16 * ks, 32 * et, c.lane), acc[e]); } }
#pragma unroll
            for (int kd = 0; kd < 4; ++kd) {
#pragma unroll
                for (int e = 0; e < 3; ++e) { const int et = (e == 2) ? 4 : 2 * wg2 + e; aci[e] = MFMA32(qf[kd], frag_tr(Cs, ML_LDV, 16 * kd, 32 * et, c.lane), aci[e]); } }
#pragma unroll
            for (int r = 0; r < 16; ++r) {
                const float eb_ = fexp(sc[boff + 32 * tb + crow(r, hi)]);
                const float t2 = acc[2][r] + eb_ * aci[2][r];
                const float den = __shfl(t2, hi * 32);
                const float inv = frcp(fmaxf(fabsf(den), 1.f));
                hs[0][r] += (acc[0][r] + eb_ * aci[0][r]) * inv; hs[1][r] += (acc[1][r] + eb_ * aci[1][r]) * inv;
            }
            __syncthreads();
        }
#pragma unroll
        for (int e = 0; e < 2; ++e)
#pragma unroll
            for (int r = 0; r < 16; ++r) hb[(32 * tb + crow(r, hi)) * ML_LDP + 32 * (2 * wg2 + e) + n] = f2bf(hs[e][r]);
        __syncthreads();
        const float g0 = ng[h * 128 + 2 * c.lane], g1 = ng[h * 128 + 2 * c.lane + 1];
        for (int rr = 0; rr < 16; ++rr) {
            const int t = 16 * c.wave + rr; const unsigned w = *(const LAS unsigned*)(hb + t * ML_LDP + 2 * c.lane);
            const float x0 = bflo(w), x1 = bfhi(w);
            const float mean = wave_sum(x0 + x1) * (1.f / 128.f); const float d0 = x0 - mean, d1 = x1 - mean;
            const float rstd = rsqrtf(wave_sum(d0 * d0 + d1 * d1) * (1.f / 128.f) + EPS);
            const unsigned ow = *(const unsigned*)(og + (size_t)(row0 + t) * 1024 + h * 128 + 2 * c.lane);
            *(unsigned*)(Z + (size_t)(row0 + t) * 1024 + h * 128 + 2 * c.lane) = pk2(d0 * rstd * g0 * sigmoidf_(bflo(ow)), d1 * rstd * g1 * sigmoidf_(bfhi(ow)));
        }
        __syncthreads();
    }
}

constexpr int RT_CH = 1024, RT_NC = SEQ / RT_CH, RT_H = 4, RT_DK = 256, RT_DV = 512;
constexpr int RT_LDK = 264, RT_LDB = 520, RT_LDA = 72;
DI void rt_phase2(const Ctx& c, const bf16* k, const bf16* v, const float* dlogit, bf16* RS) {
    LAS bf16* kw = (LAS bf16*)c.lds; LAS bf16* vh = kw + 64 * RT_LDK;
    const int NU = BATCH * RT_H * 2 * RT_NC;
    const int n = c.lane & 31, hi = c.lane >> 5;
    for (int u = c.bx; u < NU; u += c.G) {
        const int ck = u % RT_NC, dir = (u / RT_NC) & 1, h = (u / (2 * RT_NC)) % RT_H, b = u / (2 * RT_NC * RT_H);
        const int row0 = b * SEQ + ck * RT_CH;
        const float lg2 = log_sigmoid_(dlogit[dir * 4 + h]) * LOG2E;
        bf16* dst = RS + ((size_t)((b * RT_H + h) * 2 + dir) * RT_NC + ck) * (RT_DK * RT_DV);
        for (int half = 0; half < 2; ++half) {
            f32x16 acc[8] = {};
            for (int sb = 0; sb < RT_CH / 64; ++sb) {
                __syncthreads();
#pragma unroll
                for (int i = 0; i < 4; ++i) { const int ch = c.tid + 512 * i, r = ch >> 5, cc = (ch & 31) * 8; const int s = 64 * sb + r;
                    const float w = fexp2(lg2 * (float)(dir ? s : (RT_CH - 1 - s)));
                    const u32x4 kk = *(const u32x4*)(k + (size_t)(row0 + s) * 1024 + h * 256 + cc);
                    u32x4 o;
#pragma unroll
                    for (int q = 0; q < 4; ++q) o[q] = pk2(bflo(kk[q]) * w, bfhi(kk[q]) * w);
                    *(LAS u32x4*)(kw + r * RT_LDK + cc) = o;
                    *(LAS u32x4*)(vh + r * RT_LDK + cc) = *(const u32x4*)(v + (size_t)(row0 + s) * 2048 + h * 512 + half * 256 + cc); }
                __syncthreads();
#pragma unroll 1
                for (int ks = 0; ks < 4; ++ks) { const bf16x8 A = frag_tr(kw, RT_LDK, 16 * ks, 32 * c.wave, c.lane);
#pragma unroll
                    for (int et = 0; et < 8; ++et) { acc[et] = MFMA32(A, frag_tr(vh, RT_LDK, 16 * ks, 32 * et, c.lane), acc[et]); if (et == 3) __builtin_amdgcn_sched_barrier(0); } }
            }
#pragma unroll
            for (int et = 0; et < 8; ++et)
#pragma unroll
                for (int r = 0; r < 16; ++r) dst[(size_t)(32 * c.wave + crow(r, hi)) * RT_DV + half * 256 + 32 * et + n] = f2bf(acc[et][r]);
        }
        __syncthreads();
    }
}
DI void rt_phase3(const Ctx& c, bf16* RS, const float* dlogit) {
    constexpr int NG = RT_DK * RT_DV / 8;
    const int NTASK = BATCH * RT_H * 2 * NG;
    for (int t = c.bx * NTHREADS + c.tid; t < NTASK; t += c.G * NTHREADS) {
        const int g = t % NG, chain = t / NG, dir = chain & 1, h = (chain >> 1) % RT_H;
        const float gch = fexp2(log_sigmoid_(dlogit[dir * 4 + h]) * LOG2E * (float)RT_CH);
        bf16* base = RS + (size_t)chain * RT_NC * (RT_DK * RT_DV) + (size_t)g * 8;
        float carry[8];
#pragma unroll
        for (int i = 0; i < 8; ++i) carry[i] = 0.f;
#pragma unroll
        for (int s = 0; s < RT_NC; ++s) {
            const int ck = dir ? (RT_NC - 1 - s) : s;
            u32x4* p = (u32x4*)(base + (size_t)ck * (RT_DK * RT_DV)); const u32x4 a = *p;
            u32x4 o;
#pragma unroll
            for (int q = 0; q < 4; ++q) { o[q] = pk2(carry[2 * q], carry[2 * q + 1]); carry[2 * q] = gch * carry[2 * q] + bflo(a[q]); carry[2 * q + 1] = gch * carry[2 * q + 1] + bfhi(a[q]); }
            *p = o;
        }
    }
}
DI void rt_phase4(const Ctx& c, const bf16* q, const bf16* k, const bf16* v, bf16* gz, const bf16* RS, const float* dlogit, const float* ng) {
    LAS bf16* kt = (LAS bf16*)c.lds; LAS bf16* Bt = kt + 64 * RT_LDK; LAS bf16* At = Bt + 64 * RT_LDB; LAS float* red = (LAS float*)(At + 128 * RT_LDA);
    const int NU = BATCH * RT_H * RT_NC * 8;
    const int n = c.lane & 31, hi = c.lane >> 5, tb = c.wave & 3, eh = c.wave >> 2;
    for (int u = c.bx; u < NU; u += c.G) {
        const int tq = u & 7, ck = (u >> 3) % RT_NC, h = (u / (8 * RT_NC)) % RT_H, b = u / (8 * RT_NC * RT_H);
        const int rowc = b * SEQ + ck * RT_CH, rowq = rowc + tq * 128;
        const float lf2 = log_sigmoid_(dlogit[h]) * LOG2E, lb2 = log_sigmoid_(dlogit[4 + h]) * LOG2E;
        const bf16* qg = q + (size_t)rowq * 1024 + h * 256;
        f32x16 acc[8] = {};
        for (int step = 0; step < 24; ++step) {
            __syncthreads();
            int otid = c.tid; asm volatile("" : "+v"(otid));
            if (step < 16) {
                const int s0 = 64 * step;
#pragma unroll
                for (int i = 0; i < 4; ++i) { const int ch = otid + 512 * i, r = ch >> 5, cc = (ch & 31) * 8;
                    *(LAS u32x4*)(kt + r * RT_LDK + cc) = *(const u32x4*)(k + (size_t)(rowc + s0 + r) * 1024 + h * 256 + cc); }
#pragma unroll
                for (int i = 0; i < 8; ++i) { const int ch = otid + 512 * i, r = ch >> 6, cc = (ch & 63) * 8;
                    *(LAS u32x4*)(Bt + r * RT_LDB + cc) = *(const u32x4*)(v + (size_t)(rowc + s0 + r) * 2048 + h * 512 + cc);
                    if ((i & 3) == 3) __builtin_amdgcn_sched_barrier(0); }
                __syncthreads();
                f32x16 a = {};
#pragma unroll 4
                for (int kd = 0; kd < 16; ++kd) a = MFMA32(frag_row(kt, RT_LDK, 32 * eh, 16 * kd, c.lane), gfrag_row(qg, 1024, 32 * tb, 16 * kd, c.lane), a);
                const int tl = 32 * tb + n, tpos = 128 * tq + tl;
#pragma unroll
                for (int g4 = 0; g4 < 4; ++g4) {
                    const int sl = 32 * eh + 8 * g4 + 4 * hi;
                    float w[4];
#pragma unroll
                    for (int j = 0; j < 4; ++j) { const float rel = (float)(tpos - (s0 + sl + j));
                        const float mk = (rel >= 0.f ? fexp2(rel * lf2) : 0.f) + (rel <= 0.f ? fexp2(-rel * lb2) : 0.f); w[j] = a[4 * g4 + j] * mk; }
                    u32x2 o; o.x = pk2(w[0], w[1]); o.y = pk2(w[2], w[3]);
                    *(LAS u32x2*)(At + tl * RT_LDA + sl) = o;
                }
            } else {
                const int dir = (step - 16) >> 2, d0 = 64 * ((step - 16) & 3);
                const bf16* rs = RS + ((size_t)((b * RT_H + h) * 2 + dir) * RT_NC + ck) * (RT_DK * RT_DV) + (size_t)d0 * RT_DV;
#pragma unroll
                for (int i = 0; i < 8; ++i) { const int ch = otid + 512 * i, r = ch >> 6, cc = (ch & 63) * 8;
                    *(LAS u32x4*)(Bt + r * RT_LDB + cc) = *(const u32x4*)(rs + (size_t)r * RT_DV + cc);
                    if ((i & 3) == 3) __builtin_amdgcn_sched_barrier(0); }
#pragma unroll
                for (int i = 0; i < 2; ++i) { const int ch = otid + 512 * i, r = ch >> 3, cc = (ch & 7) * 8; const int tpos = 128 * tq + r;
                    const float xi = dir ? fexp2(lb2 * (float)(RT_CH - tpos)) : fexp2(lf2 * (float)(tpos + 1));
                    const u32x4 qq = *(const u32x4*)(qg + (size_t)r * 1024 + d0 + cc);
                    u32x4 o;
#pragma unroll
                    for (int q4 = 0; q4 < 4; ++q4) o[q4] = pk2(bflo(qq[q4]) * xi, bfhi(qq[q4]) * xi);
                    *(LAS u32x4*)(At + r * RT_LDA + cc) = o; }
            }
            __syncthreads();
#pragma unroll 1
            for (int ks = 0; ks < 4; ++ks) { const bf16x8 A = frag_row(At, RT_LDA, 32 * tb, 16 * ks, c.lane);
#pragma unroll
                for (int et = 0; et < 8; ++et) { acc[et] = MFMA32(A, frag_tr(Bt, RT_LDB, 16 * ks, 32 * (8 * eh + et), c.lane), acc[et]); if (et == 3) __builtin_amdgcn_sched_barrier(0); } }
        }
#pragma unroll
        for (int r = 0; r < 16; ++r) {
            float s1 = 0.f, s2 = 0.f;
#pragma unroll
            for (int et = 0; et < 8; ++et) { s1 += acc[et][r]; s2 += acc[et][r] * acc[et][r]; }
#pragma unroll
            for (int o = 1; o < 32; o <<= 1) { s1 += __shfl_xor(s1, o); s2 += __shfl_xor(s2, o); }
            if (n == 0) { red[((32 * tb + crow(r, hi)) * 2 + eh) * 2] = s1; red[((32 * tb + crow(r, hi)) * 2 + eh) * 2 + 1] = s2; }
        }
        __syncthreads();
#pragma unroll
        for (int r = 0; r < 16; ++r) {
            const int tl = 32 * tb + crow(r, hi);
            const float s1 = red[(tl * 2) * 2] + red[(tl * 2 + 1) * 2], s2 = red[(tl * 2) * 2 + 1] + red[(tl * 2 + 1) * 2 + 1];
            const float mean = s1 * (1.f / 512.f), var = fmaxf(s2 * (1.f / 512.f) - mean * mean, 0.f), rstd = rsqrtf(var + EPS);
            bf16* gp = gz + (size_t)(rowq + tl) * 2048 + h * 512 + 256 * eh + n;
#pragma unroll
            for (int et = 0; et < 8; ++et) { const float gt = bf2f(gp[32 * et]); const float y = (acc[et][r] - mean) * rstd * ng[h * 512 + 256 * eh + 32 * et + n];
                gp[32 * et] = f2bf(y * gt * sigmoidf_(gt)); }
        }
        __syncthreads();
    }
}

struct Args { const float* in[25]; float* out; unsigned char* ws; int ph_lo, ph_hi; };
constexpr int NPHASES = 64;
#define PHASE(...) do { if (ph >= lo && ph < hi) { { Ctx c = c0; asm volatile("" : "+v"(c.tid)); c.lane = c.tid & 63; c.wave = __builtin_amdgcn_readfirstlane(c.tid >> 6); c.gw = c.bx * NWAVES + c.wave; \
    __VA_ARGS__; } if (ph + 1 < hi) xcd_barrier(bar); } ++ph; } while (0)
#define FFN_JOBS(L) {args.in[2] + (size_t)(L) * DM * FFN_U, DM, FFN_U, WTup, MAP_FFNUP, 0}, {args.in[5] + (size_t)(L) * FFN_H * DM, FFN_H, DM, WTdown, MAP_ID, 0}

template <int L> DI void run_layer(const Ctx& c0, const Args& args, const XcdBarrier& bar, const int lo, const int hi, int& ph) {
    unsigned char* ws = args.ws;
    const float* x = args.in[0]; const float* norm_g = args.in[1];
    float* hout = args.out;
    float* rope = (float*)(ws + WS_ROPE);
    bf16* XN = (bf16*)(ws + WS_XN);
    unsigned char* S = ws + WS_S;
    bf16* WTmix = (bf16*)(ws + WT_MIX); bf16* WTup = (bf16*)(ws + WT_UP); bf16* WTdown = (bf16*)(ws + WT_DOWN);
    bf16* U = (bf16*)S; bf16* HALO = (bf16*)(S + 352 * MiB);
    LAS unsigned char* ring = c0.lds;

        const float* g0 = norm_g + (size_t)(L * 4 + 0) * DM; const float* g1 = g0 + DM; const float* g2 = g0 + 2 * DM; const float* g3 = g0 + 3 * DM;
        const float* hbase = (L == 0) ? x : hout;
        bf16* AOUT = (bf16*)S;
        if constexpr (L == 0) {
            bf16* Wd = WTmix; bf16* Wuq = (bf16*)(ws + WT_MIX + 2 * MiB); bf16* Wukv = (bf16*)(ws + WT_MIX + 4 * MiB); bf16* Wo = (bf16*)(ws + WT_MIX + 6 * MiB);
            bf16* DQKV = (bf16*)S; bf16* CQ = (bf16*)(S + 48 * MiB); bf16* CKV = (bf16*)(S + 72 * MiB); bf16* Q = (bf16*)(S + 88 * MiB); bf16* KF = (bf16*)(S + 184 * MiB);
            bf16* V = (bf16*)(S + 280 * MiB); bf16* O = (bf16*)(S + 344 * MiB);
            PHASE({
                fill_rope(c, rope);
                const TJob jobs[6] = {{args.in[6], DM, 384, Wd, MAP_ID, 0}, {args.in[9], DM, 320, Wd, MAP_ID, 384}, {args.in[8], 384, 1536, Wuq, MAP_ROPEQ, 0},
                                      {args.in[11], 256, 2048, Wukv, MAP_ID, 0}, {args.in[12], DM, DM, Wo, MAP_ID, 0}, {args.in[2], DM, FFN_U, WTup, MAP_FFNUP, 0}};
                run_transposes<6>(c, jobs);
                const TJob jobs2[1] = {{args.in[5], FFN_H, DM, WTdown, MAP_ID, 0}};
                run_transposes<1>(c, jobs2);
                zero_rows(c, Wd, DM, 704, 64);
                pass_norm0(c, x, g0, XN);
            });
            PHASE({ pg8::Gemm g{XN, Wd, MROWS, 768, DM, DM, 256}; pg8::StaticOrder so; so.init(MROWS, 768, c.G, c.bx);
                pg8::gemm_phase(ring, c.tid, g, so, pg8::epi_plain(DQKV, 768, 1.f)); });
            PHASE({ pass_mla_mid(c, DQKV, args.in[7], args.in[10], rope, CQ, CKV, KF); });
            PHASE({ pg8::Gemm g{CQ, Wuq, MROWS, 1536, 384, 384, 256}; pg8::StaticOrder so; so.init(MROWS, 1536, c.G, c.bx);
                  pg8::gemm_phase(ring, c.tid, g, so, pg8::epi_plain(Q, 1536, 0.07216878364870322f * LOG2E)); });
            PHASE({ pg8::Gemm g{CKV, Wukv, MROWS, 2048, 256, 256, 256}; pg8::StaticOrder so; so.init(MROWS, 2048, c.G, c.bx);
                  pg8::EpiMlaKV E{KF, V}; pg8::gemm_phase(ring, c.tid, g, so, E); });
            PHASE({ attention_phase<192, false, true, 1536, 192, 1536, 192, 1024, 128, 1, 1024, 128, 8>(c, Q, KF, V, O, rope); });
            PHASE({ pg8::Gemm g{O, Wo, MROWS, DM, DM, DM, 256}; pg8::StaticOrder so; so.init(MROWS, DM, c.G, c.bx);
                pg8::gemm_phase(ring, c.tid, g, so, pg8::epi_plain(AOUT, DM, 1.f)); });
        } else if constexpr (L == 1) {
            bf16* Wqkv = WTmix; bf16* Wo = (bf16*)(ws + WT_MIX + 8 * MiB);
            bf16* Qd = (bf16*)S; bf16* Kd = (bf16*)(S + 64 * MiB); bf16* Vd = (bf16*)(S + 128 * MiB); bf16* OS = (bf16*)(S + 192 * MiB); bf16* OC = (bf16*)(S + 320 * MiB);
            PHASE({ pg8::Gemm g{XN, Wqkv, MROWS, 3072, DM, DM, 256}; pg8::StaticOrder so; so.init(MROWS, 3072, c.G, c.bx);
                pg8::EpiSeg<false> E{}; E.p0 = Qd; E.ld0 = DM; E.s0 = 0.125f * LOG2E; E.e0 = 8; E.p1 = Kd; E.ld1 = DM; E.s1 = 1.f; E.e1 = 16; E.p2 = Vd; E.ld2 = DM; E.s2 = 1.f; E.e2 = 100000;
                pg8::gemm_phase(ring, c.tid, g, so, E); });
            PHASE({ attention_phase<64, true, false, 1024, 64, 1024, 64, 1024, 128, 2, 2048, 128, 16>(c, Qd, Kd, Vd, OS, rope); });
            PHASE({ pass_diff_combine(c, OS, args.in[14], args.in[15], OC); });
            PHASE({ pg8::Gemm g{OC, Wo, MROWS, DM, DM, DM, 256}; pg8::StaticOrder so; so.init(MROWS, DM, c.G, c.bx);
                pg8::gemm_phase(ring, c.tid, g, so, pg8::epi_plain(AOUT, DM, 1.f)); });
        } else if constexpr (L == 2) {
            bf16* Win = WTmix; bf16* Wout = (bf16*)(ws + WT_MIX + 8 * MiB);
            bf16* q = (bf16*)S; bf16* k = (bf16*)(S + 32 * MiB); bf16* v = (bf16*)(S + 64 * MiB); bf16* og = (bf16*)(S + 128 * MiB);
            float* gates = (float*)(S + 192 * MiB); float* DEC = (float*)(S + 196 * MiB); bf16* ST = (bf16*)(S + 200 * MiB); bf16* Z = (bf16*)(S + 288 * MiB);
            PHASE({ pg8::Gemm g{XN, Win, MROWS, 3328, DM, DM, 256}; pg8::StaticOrder so; so.init(MROWS, 3328, c.G, c.bx);
                pg8::EpiSeg<true> E{}; E.p0 = q; E.ld0 = 512; E.s0 = 1.f; E.e0 = 4; E.p1 = k; E.ld1 = 512; E.s1 = 0.125f; E.e1 = 8; E.p2 = v; E.ld2 = DM; E.s2 = 1.f; E.e2 = 16; E.p3 = og; E.ld3 = DM; E.s3 = 1.f;
                E.gates = gates; E.gbias = args.in[18]; E.gblk = 24;
                pg8::gemm_phase(ring, c.tid, g, so, E); });
            PHASE({ ml_phase1(c, k, v, gates, ST, DEC); });
            PHASE({ ml_phase2(c, ST, DEC); });
            PHASE({ ml_phase3(c, q, k, v, og, gates, ST, args.in[19], Z); });
            PHASE({ pg8::Gemm g{Z, Wout, MROWS, DM, DM, DM, 256}; pg8::StaticOrder so; so.init(MROWS, DM, c.G, c.bx);
                pg8::gemm_phase(ring, c.tid, g, so, pg8::epi_plain(AOUT, DM, 1.f)); });
        } else {
            bf16* Win = WTmix; bf16* Wo = (bf16*)(ws + WT_MIX + 12 * MiB);
            bf16* q = (bf16*)S; bf16* k = (bf16*)(S + 64 * MiB); bf16* v = (bf16*)(S + 128 * MiB); bf16* gz = (bf16*)(S + 256 * MiB); bf16* RS = XN;
            PHASE({ pg8::Gemm g{XN, Win, MROWS, 6144, DM, DM, 256}; pg8::StaticOrder so; so.init(MROWS, 6144, c.G, c.bx);
                pg8::EpiSeg<false> E{}; E.p0 = q; E.ld0 = DM; E.s0 = 1.f; E.e0 = 8; E.p1 = k; E.ld1 = DM; E.s1 = 0.0625f; E.e1 = 16; E.p2 = v; E.ld2 = 2048; E.s2 = 1.f; E.e2 = 32; E.p3 = gz; E.ld3 = 2048; E.s3 = 1.f;
                pg8::gemm_phase(ring, c.tid, g, so, E); });
            PHASE({ rt_phase2(c, k, v, args.in[22], RS); });
            PHASE({ rt_phase3(c, RS, args.in[22]); });
            PHASE({ rt_phase4(c, q, k, v, gz, RS, args.in[22], args.in[23]); });
            PHASE({ pg8::Gemm g{gz, Wo, MROWS, DM, 2048, 2048, 256}; pg8::StaticOrder so; so.init(MROWS, DM, c.G, c.bx);
                pg8::gemm_phase(ring, c.tid, g, so, pg8::epi_plain(AOUT, DM, 1.f)); });
        }
        PHASE({ pass_res_norm(c, AOUT, hbase, g1, g2, hout, XN); });
        PHASE({ pg8::Gemm g{XN, WTup, MROWS, FFN_U, DM, DM, 256}; pg8::StaticOrder so; so.init(MROWS, FFN_U, c.G, c.bx);
            pg8::EpiFfnUp E{U, HALO}; pg8::gemm_phase(ring, c.tid, g, so, E); });
        PHASE({ pass_conv(c, U, HALO, args.in[3] + (size_t)L * 3 * FFN_U, args.in[4] + (size_t)L * FFN_U); });
        PHASE({ pg8::Gemm g{U, WTdown, MROWS, DM, FFN_H, FFN_U, 512}; pg8::StaticOrder so; so.init(MROWS, DM, c.G, c.bx);
            pg8::gemm_phase(ring, c.tid, g, so, pg8::epi_plain(XN, DM, 1.f)); });
        PHASE({
            pass_res_norm(c, XN, hout, g3, (L < 3) ? g0 + 4 * DM : g0, hout, (L < 3) ? XN : nullptr);
            if constexpr (L == 0) { const TJob jobs[4] = {{args.in[13], DM, 3072, WTmix, MAP_ID, 0}, {args.in[16], DM, DM, (bf16*)(ws + WT_MIX + 8 * MiB), MAP_ID, 0}, FFN_JOBS(1)}; run_transposes<4>(c, jobs); }
            else if constexpr (L == 1) { const TJob jobs[4] = {{args.in[17], DM, 3104, WTmix, MAP_ID, 0}, {args.in[20], DM, DM, (bf16*)(ws + WT_MIX + 8 * MiB), MAP_ID, 0}, FFN_JOBS(2)}; run_transposes<4>(c, jobs);
                zero_rows(c, WTmix, DM, 3104, 224); }
            else if constexpr (L == 2) { const TJob jobs[4] = {{args.in[21], DM, 6144, WTmix, MAP_ID, 0}, {args.in[24], 2048, DM, (bf16*)(ws + WT_MIX + 12 * MiB), MAP_ID, 0}, FFN_JOBS(3)}; run_transposes<4>(c, jobs); }
        });
    }

__global__ void __launch_bounds__(NTHREADS, 2) enc_fwd(Args args) {
    extern __shared__ __attribute__((aligned(16))) unsigned char lds_raw[];
    Ctx c;
    c.lds = (LAS unsigned char*)lds_raw;
    c.tid = threadIdx.x; c.lane = c.tid & 63; c.wave = __builtin_amdgcn_readfirstlane(c.tid >> 6);
    c.G = gridDim.x; c.bx = blockIdx.x; c.gw = c.bx * NWAVES + c.wave; c.NGW = c.G * NWAVES;
    volatile LAS unsigned* MISC = (volatile LAS unsigned*)(c.lds + MISC_OFF);
    for (int u = c.tid; u < (LDS_BYTES - LDSCTL_OFF) / 4; u += NTHREADS) ((LAS unsigned*)(c.lds + LDSCTL_OFF))[u] = 0u;
    __syncthreads();
    XcdBarrier bar = xcd_barrier_post((unsigned*)(args.ws + WS_CTL) + 4096, MISC + 8);
    const int lo = args.ph_lo, hi = args.ph_hi;
    int ph = 0;
    run_layer<0>(c, args, bar, lo, hi, ph);
    run_layer<1>(c, args, bar, lo, hi, ph);
    run_layer<2>(c, args, bar, lo, hi, ph);
    run_layer<3>(c, args, bar, lo, hi, ph);
}
#undef PHASE

#ifndef MK_N_LAUNCHES
#define MK_N_LAUNCHES 1
#endif
extern "C" void kernel_launch(void* const* d_in, const int* in_sizes, int n_in, void* d_out, int out_size, void* d_ws, size_t ws_size, hipStream_t stream) {
    static int grid = 0;
    if (grid == 0) {
        if (n_in != 25 || in_sizes[0] != MROWS * DM || out_size != MROWS * DM || ws_size < WS_END) {
            fprintf(stderr, "kernel_launch: unexpected shapes: n_in %d in0 %d out %d ws %zu (need %zu)\n", n_in, n_in > 0 ? in_sizes[0] : -1, out_size, ws_size, (size_t)WS_END); grid = -1; return; }
        int dev = 0, cus = 0, per_cu = 0;
        if (hipGetDevice(&dev) != hipSuccess || hipDeviceGetAttribute(&cus, hipDeviceAttributeMultiprocessorCount, dev) != hipSuccess) { grid = -1; return; }
        if (hipFuncSetAttribute((const void*)enc_fwd, hipFuncAttributeMaxDynamicSharedMemorySize, LDS_BYTES) != hipSuccess) { fprintf(stderr, "kernel_launch: hipFuncSetAttribute failed\n"); grid = -1; return; }
        if (hipOccupancyMaxActiveBlocksPerMultiprocessor(&per_cu, (const void*)enc_fwd, NTHREADS, LDS_BYTES) != hipSuccess || per_cu < 1)
            fprintf(stderr, "kernel_launch: note: occupancy query reports %d workgroups per CU\n", per_cu);
        (void)hipGetLastError();
        grid = cus;
    }
    if (grid < 0) return;
    Args a{};
    for (int i = 0; i < 25; ++i) a.in[i] = (const float*)d_in[i];
    a.out = (float*)d_out; a.ws = (unsigned char*)d_ws;
    if (MK_N_LAUNCHES == 1) {
        (void)hipMemsetAsync((char*)d_ws + WS_CTL, 0, CTL_ZERO_BYTES, stream);
        a.ph_lo = 0; a.ph_hi = NPHASES;
        hipLaunchKernelGGL(enc_fwd, dim3(grid), dim3(NTHREADS), LDS_BYTES, stream, a);
    } else {
        for (int p = 0; p < NPHASES; ++p) {
            (void)hipMemsetAsync((char*)d_ws + WS_CTL, 0, CTL_ZERO_BYTES, stream);
            a.ph_lo = p; a.ph_hi = p + 1;
            hipLaunchKernelGGL(enc_fwd, dim3(grid), dim3(NTHREADS), LDS_BYTES, stream, a);
        }
    }
    const hipError_t le = hipPeekAtLastError();
    if (le != hipSuccess) fprintf(stderr, "kernel_launch: launch failed: %s\n", hipGetErrorName(le));
}
```

```cpp
#include <hip/hip_runtime.h>
#include <cstdio>
#include <cstdint>

#define DI __device__ __forceinline__
#define LAS __attribute__((address_space(3)))
#define GAS __attribute__((address_space(1)))
typedef unsigned short bf16;
typedef short bf16x8 __attribute__((ext_vector_type(8)));
typedef short s16x4 __attribute__((ext_vector_type(4)));
typedef float f32x2 __attribute__((ext_vector_type(2)));
typedef float f32x4 __attribute__((ext_vector_type(4)));
typedef float f32x16 __attribute__((ext_vector_type(16)));
typedef unsigned u32x2 __attribute__((ext_vector_type(2)));
typedef unsigned u32x4 __attribute__((ext_vector_type(4)));
typedef __bf16 bf16x2_t __attribute__((ext_vector_type(2)));

constexpr int BATCH = 4, SEQ = 8192, DM = 1024, MROWS = BATCH * SEQ;
constexpr int FFN_H = 2816, FFN_U = 2 * FFN_H;
constexpr float EPS = 1e-6f, LOG2E = 1.4426950408889634f;
constexpr int NWAVES = 8, NTHREADS = NWAVES * 64;

constexpr size_t MiB = 1u << 20;
constexpr size_t WS_CTL = 0, CTL_ZERO_BYTES = 1 * MiB;
constexpr size_t WS_ROPE = 1 * MiB;
constexpr size_t WS_WT = 4 * MiB;
constexpr size_t WT_MIX = WS_WT, WT_UP = WS_WT + 16 * MiB, WT_DOWN = WS_WT + 28 * MiB;
constexpr size_t WS_XN = 40 * MiB;
constexpr size_t WS_S = 104 * MiB;
constexpr size_t WS_END = 512 * MiB;

DI unsigned pk2(float lo, float hi) { f32x2 v = {lo, hi}; bf16x2_t b = __builtin_convertvector(v, bf16x2_t); return __builtin_bit_cast(unsigned, b); }
DI float bflo(unsigned w) { return __uint_as_float(w << 16); }
DI float bfhi(unsigned w) { return __uint_as_float(w & 0xffff0000u); }
DI float bf2f(bf16 b) { return __uint_as_float((unsigned)b << 16); }
DI bf16 f2bf(float f) { return (bf16)(pk2(f, 0.f) & 0xffffu); }
DI float wave_sum(float v) {
#pragma unroll
    for (int o = 1; o < 64; o <<= 1) v += __shfl_xor(v, o);
    return v;
}
DI float fexp2(float x) { return __builtin_amdgcn_exp2f(x); }
DI float fexp(float x) { return __builtin_amdgcn_exp2f(x * LOG2E); }
DI float frcp(float x) { return __builtin_amdgcn_rcpf(x); }
DI float sigmoidf_(float x) { return frcp(1.f + fexp(-x)); }
DI float log_sigmoid_(float x) { return fminf(x, 0.f) - log1pf(expf(-fabsf(x))); }
DI int crow(int r, int hi) { return (r & 3) + 8 * (r >> 2) + 4 * hi; }
#define MFMA32(a, b, c) __builtin_amdgcn_mfma_f32_32x32x16_bf16((a), (b), (c), 0, 0, 0)

DI bf16x8 frag_row(const LAS bf16* base, int ld, int row0, int k0, int lane) {
    return *(const LAS bf16x8*)(base + (row0 + (lane & 31)) * ld + k0 + 8 * (lane >> 5));
}
typedef short v4i16_t __attribute__((ext_vector_type(4)));
DI s16x4 tr_rd(const LAS bf16* p) { return __builtin_bit_cast(s16x4, __builtin_amdgcn_ds_read_tr16_b64_v4i16((LAS v4i16_t*)p)); }
DI bf16x8 frag_tr(const LAS bf16* base, int ld, int k0, int n0, int lane) {
    const int g = lane >> 4, i = lane & 15, r = i >> 2, c = i & 3, h = lane >> 5;
    const LAS bf16* p = base + (k0 + 8 * h + r) * ld + n0 + 16 * (g & 1) + 4 * c;
    const s16x4 lo = tr_rd(p), hi = tr_rd(p + 4 * ld);
    return (bf16x8){lo[0], lo[1], lo[2], lo[3], hi[0], hi[1], hi[2], hi[3]};
}
DI bf16x8 gfrag_row(const bf16* base, int ld, int row0, int k0, int lane) {
    return *(const bf16x8*)(base + (size_t)(row0 + (lane & 31)) * ld + k0 + 8 * (lane >> 5));
}

namespace pg8 {
typedef unsigned short bf16_t;
constexpr int BM = 256, BK = 64, HALF = 128, HTB = HALF * BK * 2, STAGE_BYTES = 8 * HTB, NXCD = 8, WGM = 8;
__host__ __device__ __forceinline__ int lds_byte(int r, int c) { const int st = (r >> 4) * 2 + (c >> 5), rr = r & 15, cc = c & 31, ob = rr * 64 + cc * 2; return st * 1024 + (ob ^ (((ob >> 9) & 1) << 5)); }
__host__ __device__ __forceinline__ void stage_rc(int b, int& R, int& C) { const int st = b / 1024, sb = b % 1024, swz = sb ^ (((sb >> 9) & 1) << 5); R = (st >> 1) * 16 + swz / 64; C = (st & 1) * 32 + (swz % 64) / 2; }
__host__ __device__ __forceinline__ int perm32(int rho) { const int n = rho >> 4, i = rho & 15; return 8 * (i >> 2) + 4 * n + (i & 3); }

struct Unit { int pm, pn; };
struct Gemm { const bf16_t* A; const bf16_t* Bt; int M, N, K; int lda; int kpairA; };

struct StaticOrder {
    int nM, nN, nwg, G, c;
    __host__ __device__ void init(int M, int N, int G_, int c_) { nM = M / BM; nN = N / BM; nwg = nM * nN; G = G_; c = c_; }
    __host__ __device__ bool next(int i, Unit& u) const {
        const long L = (long)i * G + c; if (L >= nwg) return false;
        int wgid = (int)L; { const int q = nwg / NXCD, r = nwg % NXCD, xcd = wgid % NXCD, off = wgid / NXCD; wgid = (xcd < r ? xcd * (q + 1) : r * (q + 1) + (xcd - r) * q) + off; }
        const int nig = WGM * nN, gid = wgid / nig, fm = gid * WGM, gsz = (nM - fm) < WGM ? (nM - fm) : WGM;
        u.pm = fm + ((wgid % nig) % gsz); u.pn = (wgid % nig) / gsz; return true;
    }
};

DI void store8(bf16_t* p, f32x4 v0, f32x4 v1, float sc) {
    u32x4 w; w.x = pk2(v0[0] * sc, v0[1] * sc); w.y = pk2(v0[2] * sc, v0[3] * sc); w.z = pk2(v1[0] * sc, v1[1] * sc); w.w = pk2(v1[2] * sc, v1[3] * sc);
    *(u32x4*)p = w;
}
template <bool GATES> struct EpiSeg {
    static constexpr bool PERM = true;
    bf16_t *p0, *p1, *p2, *p3; int ld0, ld1, ld2, ld3; int e0, e1, e2; float s0, s1, s2, s3;
    float* gates; const float* gbias; int gblk;
    DI void operator()(const f32x4 (&acc)[2][2][4][2], const Unit& u, int wr, int wc, int fr, int fq) const {
        const int row0 = u.pm * BM + wr * 64 + fr;
#pragma unroll
        for (int bj = 0; bj < 2; ++bj) {
            const int blk = 2 * u.pn + bj;
            if (GATES && blk >= gblk) {
                if (blk == gblk && wc == 0) {
                    const f32x4 b0 = *(const f32x4*)(gbias + 8 * fq), b1 = *(const f32x4*)(gbias + 8 * fq + 4);
#pragma unroll
                    for (int ai = 0; ai < 2; ++ai)
#pragma unroll
                        for (int m = 0; m < 4; ++m) { float* gp = gates + (size_t)(row0 + ai * HALF + m * 16) * 32 + 8 * fq;
                            *(f32x4*)gp = acc[ai][bj][m][0] + b0; *(f32x4*)(gp + 4) = acc[ai][bj][m][1] + b1; }
                }
                continue;
            }
            bf16_t* base; int ld, b0; float sc;
            if (blk < e0) { base = p0; ld = ld0; b0 = 0; sc = s0; }
            else if (blk < e1) { base = p1; ld = ld1; b0 = e0; sc = s1; }
            else if (blk < e2) { base = p2; ld = ld2; b0 = e1; sc = s2; }
            else { base = p3; ld = ld3; b0 = e2; sc = s3; }
            bf16_t* cp = base + (blk - b0) * 128 + wc * 32 + 8 * fq;
#pragma unroll
            for (int ai = 0; ai < 2; ++ai)
#pragma unroll
                for (int m = 0; m < 4; ++m) store8(cp + (size_t)(row0 + ai * HALF + m * 16) * ld, acc[ai][bj][m][0], acc[ai][bj][m][1], sc);
        }
    }
};
DI EpiSeg<false> epi_plain(bf16_t* O, int ld, float sc) { EpiSeg<false> E{}; E.p0 = O; E.ld0 = ld; E.e0 = 100000; E.e1 = 100000; E.e2 = 100000; E.s0 = sc; return E; }
struct EpiMlaKV {
    static constexpr bool PERM = true;
    bf16_t* KF; bf16_t* V;
    DI void operator()(const f32x4 (&acc)[2][2][4][2], const Unit& u, int wr, int wc, int fr, int fq) const {
        const int row0 = u.pm * BM + wr * 64 + fr;
#pragma unroll
        for (int bj = 0; bj < 2; ++bj) {
            bf16_t* cp = (bj == 0 ? KF + u.pn * 192 : V + u.pn * 128) + wc * 32 + 8 * fq; const int ld = (bj == 0) ? 1536 : 1024;
#pragma unroll
            for (int ai = 0; ai < 2; ++ai)
#pragma unroll
                for (int m = 0; m < 4; ++m) store8(cp + (size_t)(row0 + ai * HALF + m * 16) * ld, acc[ai][bj][m][0], acc[ai][bj][m][1], 1.f);
        }
    }
};
struct EpiFfnUp {
    static constexpr bool PERM = true;
    bf16_t* U; bf16_t* HALO;
    DI void operator()(const f32x4 (&acc)[2][2][4][2], const Unit& u, int wr, int wc, int fr, int fq) const {
        const int row0 = u.pm * BM + wr * 64 + fr;
#pragma unroll
        for (int bj = 0; bj < 2; ++bj) {
            const int col = u.pn * 256 + bj * 128 + wc * 32 + 8 * fq;
#pragma unroll
            for (int ai = 0; ai < 2; ++ai)
#pragma unroll
                for (int m = 0; m < 4; ++m) {
                    const int row = row0 + ai * HALF + m * 16;
                    store8(U + (size_t)row * FFN_U + col, acc[ai][bj][m][0], acc[ai][bj][m][1], 1.f);
                    if (fr == 0 || fr == 15) store8(HALO + ((size_t)(row >> 4) * 2 + (fr == 15 ? 1 : 0)) * FFN_U + col, acc[ai][bj][m][0], acc[ai][bj][m][1], 1.f);
                }
        }
    }
};

template <class Epi>
DI void gemm_phase(LAS unsigned char* lds, const int tid, const Gemm g, const StaticOrder& S, const Epi& E) {
    const int wid = __builtin_amdgcn_readfirstlane(tid >> 6), lane = tid & 63, wr = wid >> 2, wc = wid & 3, fr = lane & 15, fq = lane >> 4;
    const int K = g.K; int nt = K / BK; asm volatile("" : "+s"(nt));
    unsigned voffA[2], voffB[2];
#pragma unroll
    for (int i = 0; i < 2; ++i) { int R, C; stage_rc(tid * 16 + i * 8192, R, C); const int Rb = Epi::PERM ? ((R & ~31) + perm32(R & 31)) : R;
        voffA[i] = (unsigned)(R * g.lda + C) * 2u; voffB[i] = (unsigned)(Rb * K + C) * 2u; }
    const size_t kstep = (size_t)(BK * 2);
    const size_t kpairA = (size_t)g.kpairA;
    const size_t hstepA = (size_t)HALF * g.lda * 2, hstepB = (size_t)HALF * K * 2;
    const size_t tstepA = 2 * hstepA, tstepB = 2 * hstepB;
    const unsigned ldsw = (unsigned)wid * 1024u;
    const int aoff = lds_byte(wr * 64 + fr, fq * 8), boff = lds_byte(wc * 32 + fr, fq * 8);
#define PG8_SA(b, h) (((b) * 2 + (h)) * HTB)
#define PG8_SB(b, h) ((4 + (b) * 2 + (h)) * HTB)
#define PG8_STAGE(bufoff, gbase, voff) do { _Pragma("unroll") for (int _i = 0; _i < 2; ++_i) \
        __builtin_amdgcn_global_load_lds((const unsigned*)((const char*)(gbase) + (voff)[_i]), (LAS unsigned*)(lds + (bufoff) + ldsw + _i * 8192), 16, 0, 0); } while (0)
#define PG8_LDA(dst, b, h) do { _Pragma("unroll") for (int m = 0; m < 4; ++m) _Pragma("unroll") for (int k = 0; k < 2; ++k) dst[m][k] = *(const LAS bf16x8*)(lds + PG8_SA(b, h) + aoff + m * 2048 + k * 1024); } while (0)
#define PG8_LDB(dst, b, h) do { _Pragma("unroll") for (int n = 0; n < 2; ++n) _Pragma("unroll") for (int k = 0; k < 2; ++k) dst[n][k] = *(const LAS bf16x8*)(lds + PG8_SB(b, h) + boff + n * 2048 + k * 1024); } while (0)
#define PG8_MMA(ai, bj, At, Bt) do { __builtin_amdgcn_s_setprio(1); _Pragma("unroll") for (int m = 0; m < 4; ++m) _Pragma("unroll") for (int n = 0; n < 2; ++n) _Pragma("unroll") for (int k = 0; k < 2; ++k) \
        acc[ai][bj][m][n] = __builtin_amdgcn_mfma_f32_16x16x32_bf16(Bt[n][k], At[m][k], acc[ai][bj][m][n], 0, 0, 0); __builtin_amdgcn_s_setprio(0); } while (0)
#define PG8_WAIT_V(n) asm volatile("s_waitcnt vmcnt(" #n ")" ::: "memory")
#define PG8_WAIT_L(n) asm volatile("s_waitcnt lgkmcnt(" #n ")" ::: "memory")
#define PG8_BAR __builtin_amdgcn_s_barrier()
#define PG8_SCHED __builtin_amdgcn_sched_barrier(0)
    Unit cur, nxt; int ui = 0;
    if (!S.next(0, cur)) return;
    f32x4 acc[2][2][4][2];
#pragma unroll
    for (int a = 0; a < 2; ++a)
#pragma unroll
        for (int b = 0; b < 2; ++b)
#pragma unroll
            for (int m = 0; m < 4; ++m)
#pragma unroll
                for (int n = 0; n < 2; ++n) acc[a][b][m][n] = (f32x4){0.f, 0.f, 0.f, 0.f};
    bf16x8 At[4][2], B0[2][2], B1[2][2];
    const char* cA = (const char*)g.A + (size_t)cur.pm * tstepA; const char* cB = (const char*)g.Bt + (size_t)cur.pn * tstepB;
    PG8_STAGE(PG8_SB(0, 0), cB, voffB); PG8_STAGE(PG8_SB(0, 1), cB + hstepB, voffB); PG8_STAGE(PG8_SA(0, 0), cA, voffA); PG8_STAGE(PG8_SA(0, 1), cA + hstepA, voffA);
    if (wr == 1) PG8_BAR;
    PG8_WAIT_V(2); PG8_BAR;
    PG8_STAGE(PG8_SB(1, 0), cB + kstep, voffB); PG8_STAGE(PG8_SA(1, 0), cA + kstep, voffA); PG8_STAGE(PG8_SB(1, 1), cB + hstepB + kstep, voffB);
    PG8_WAIT_V(6); PG8_BAR;
    for (;;) {
        const bool has_next = S.next(ui + 1, nxt);
        const char* nA = has_next ? (const char*)g.A + (size_t)nxt.pm * tstepA : cA; const char* nB = has_next ? (const char*)g.Bt + (size_t)nxt.pn * tstepB : cB;
#pragma unroll 1
        for (int t = 0; t < nt; t += 2) {
            const bool last = (t == nt - 2);
            const char* a1 = cA + (size_t)(t >> 1) * kpairA + kstep;
            const char* a2 = last ? nA : cA + (size_t)((t >> 1) + 1) * kpairA; const char* b2 = last ? nB : cB + (size_t)(t + 2) * kstep;
            const char* a3 = a2 + kstep; const char* b3 = b2 + kstep;
            PG8_LDB(B0, 0, 0); PG8_LDB(B1, 0, 1); PG8_SCHED; PG8_LDA(At, 0, 0); PG8_STAGE(PG8_SA(1, 1), a1 + hstepA, voffA);
            PG8_WAIT_V(8); PG8_WAIT_L(0); PG8_BAR; PG8_MMA(0, 0, At, B0); PG8_MMA(0, 1, At, B1); PG8_BAR; PG8_SCHED;
            PG8_LDA(At, 0, 1); PG8_STAGE(PG8_SB(0, 0), b2, voffB); PG8_STAGE(PG8_SB(0, 1), b2 + hstepB, voffB); PG8_STAGE(PG8_SA(0, 0), a2, voffA);
            PG8_WAIT_V(8); PG8_WAIT_L(0); PG8_BAR; PG8_MMA(1, 0, At, B0); PG8_MMA(1, 1, At, B1); PG8_BAR; PG8_SCHED;
            PG8_LDB(B0, 1, 0); PG8_LDB(B1, 1, 1); PG8_SCHED; PG8_LDA(At, 1, 0); PG8_STAGE(PG8_SA(0, 1), a2 + hstepA, voffA);
            PG8_WAIT_V(8); PG8_WAIT_L(0); PG8_BAR; PG8_MMA(0, 0, At, B0); PG8_MMA(0, 1, At, B1); PG8_BAR; PG8_SCHED;
            PG8_LDA(At, 1, 1); PG8_STAGE(PG8_SB(1, 0), b3, voffB); PG8_STAGE(PG8_SB(1, 1), b3 + hstepB, voffB); PG8_STAGE(PG8_SA(1, 0), a3, voffA);
            PG8_WAIT_V(8); PG8_WAIT_L(0); PG8_BAR; PG8_MMA(1, 0, At, B0); PG8_MMA(1, 1, At, B1); PG8_BAR; PG8_SCHED;
        }
        if (wr == 0) PG8_BAR;
        E(acc, cur, wr, wc, fr, fq);
        if (!has_next) break;
#pragma unroll
        for (int a = 0; a < 2; ++a)
#pragma unroll
            for (int b = 0; b < 2; ++b)
#pragma unroll
                for (int m = 0; m < 4; ++m)
#pragma unroll
                    for (int n = 0; n < 2; ++n) acc[a][b][m][n] = (f32x4){0.f, 0.f, 0.f, 0.f};
        cur = nxt; cA = nA; cB = nB; ++ui;
        if (wr == 1) PG8_BAR;
    }
    PG8_WAIT_V(0);
    PG8_BAR;
#undef PG8_SA
#undef PG8_SB
#undef PG8_STAGE
#undef PG8_LDA
#undef PG8_LDB
#undef PG8_MMA
#undef PG8_WAIT_V
#undef PG8_WAIT_L
#undef PG8_BAR
#undef PG8_SCHED
}
}

namespace att {
constexpr int NW = 8, QBLK = 32, KVBLK = 64, DV = 128;
constexpr float THR2 = 8.f;
#define SBAR() __builtin_amdgcn_sched_barrier(0)
DI unsigned cvtpk(float lo, float hi) { unsigned r; asm volatile("v_cvt_pk_bf16_f32 %0, %1, %2" : "=v"(r) : "v"(lo), "v"(hi)); return r; }
DI void partialSM(f32x16& p0, f32x16& p1, float& m_reg, float& mn, float& alpha) {
    float pmax = p0[0];
#pragma unroll
    for (int r = 1; r < 16; ++r) pmax = fmaxf(pmax, p0[r]);
#pragma unroll
    for (int r = 0; r < 16; ++r) pmax = fmaxf(pmax, p1[r]);
    { auto rr = __builtin_amdgcn_permlane32_swap(__float_as_uint(pmax), __float_as_uint(pmax), false, false);
      pmax = fmaxf(__uint_as_float(rr[0]), __uint_as_float(rr[1])); }
    if (__builtin_expect(__all(pmax - m_reg <= THR2), 1)) { mn = m_reg; alpha = 1.f; }
    else { mn = fmaxf(m_reg, pmax); alpha = __builtin_amdgcn_exp2f(m_reg - mn); m_reg = mn; }
#pragma unroll
    for (int r = 0; r < 16; ++r) p0[r] = p0[r] - mn;
#pragma unroll
    for (int r = 0; r < 16; ++r) p1[r] = p1[r] - mn;
#pragma unroll
    for (int r = 0; r < 16; ++r) p0[r] = __builtin_amdgcn_exp2f(p0[r]);
}
DI void finishSM(f32x16& p0, f32x16& p1, float alpha, float& l_reg, bf16x8& pa0, bf16x8& pa1, bf16x8& pa2, bf16x8& pa3) {
#pragma unroll
    for (int r = 0; r < 16; ++r) p1[r] = __builtin_amdgcn_exp2f(p1[r]);
    float ps = 0;
#pragma unroll
    for (int r = 0; r < 16; ++r) ps += p0[r];
#pragma unroll
    for (int r = 0; r < 16; ++r) ps += p1[r];
    { auto rr = __builtin_amdgcn_permlane32_swap(__float_as_uint(ps), __float_as_uint(ps), false, false);
      ps = __uint_as_float(rr[0]) + __uint_as_float(rr[1]); }
    l_reg = l_reg * alpha + ps;
#define PK4(P, BASE, OUT) do { unsigned a0 = cvtpk(P[BASE + 0], P[BASE + 1]), a1 = cvtpk(P[BASE + 2], P[BASE + 3]);   \
    unsigned b0 = cvtpk(P[BASE + 4], P[BASE + 5]), b1 = cvtpk(P[BASE + 6], P[BASE + 7]);                              \
    auto r0 = __builtin_amdgcn_permlane32_swap(a0, b0, false, false); auto r1 = __builtin_amdgcn_permlane32_swap(a1, b1, false, false); \
    u32x4 w = {r0[0], r1[0], r0[1], r1[1]}; OUT = *reinterpret_cast<bf16x8*>(&w); } while (0)
    PK4(p0, 0, pa0); PK4(p0, 8, pa1); PK4(p1, 0, pa2); PK4(p1, 8, pa3);
#undef PK4
}
DI int v_st(int k, int c) { const int kk = (k & ~0xC) | ((k & 4) << 1) | ((k & 8) >> 1); return ((kk >> 3) * 4 + (c >> 5)) * 512 + ((kk & 7) * 32 + (c & 31)) * 2; }
DI int v_rd_base(int lane) { return ((lane & 3) << 3) | (((lane >> 2) & 3) << 6) | (((lane >> 4) & 1) << 5) | (((lane >> 5) & 1) << 8); }
constexpr int v_rd_off(int d0, int ks, int half) { return d0 * 512 + ks * 4096 + half * 2048; }
template <int OFF> DI s16x4 tr_read(int vb) {
    s16x4 r; asm volatile("ds_read_b64_tr_b16 %0, %1 offset:%2" : "=&v"(r) : "v"(vb), "i"(OFF) : "memory"); return r;
}
template <int D0> DI void pv_one(f32x16& od, int vb, bf16x8 pa0, bf16x8 pa1, bf16x8 pa2, bf16x8 pa3) {
    const s16x4 l0 = tr_read<v_rd_off(D0, 0, 0)>(vb), h0 = tr_read<v_rd_off(D0, 0, 1)>(vb), l1 = tr_read<v_rd_off(D0, 1, 0)>(vb), h1 = tr_read<v_rd_off(D0, 1, 1)>(vb);
    const s16x4 l2 = tr_read<v_rd_off(D0, 2, 0)>(vb), h2 = tr_read<v_rd_off(D0, 2, 1)>(vb), l3 = tr_read<v_rd_off(D0, 3, 0)>(vb), h3 = tr_read<v_rd_off(D0, 3, 1)>(vb);
    asm volatile("s_waitcnt lgkmcnt(0)" ::: "memory"); SBAR();
#define PK(L, H) (bf16x8){L[0], L[1], L[2], L[3], H[0], H[1], H[2], H[3]}
    od = MFMA32(pa0, PK(l0, h0), od);
    od = MFMA32(pa1, PK(l1, h1), od);
    od = MFMA32(pa2, PK(l2, h2), od);
    od = MFMA32(pa3, PK(l3, h3), od);
#undef PK
}
DI void pv_d0(f32x16* o, int vb, bf16x8 pa0, bf16x8 pa1, bf16x8 pa2, bf16x8 pa3) {
    pv_one<0>(o[0], vb, pa0, pa1, pa2, pa3); pv_one<1>(o[1], vb, pa0, pa1, pa2, pa3); pv_one<2>(o[2], vb, pa0, pa1, pa2, pa3); pv_one<3>(o[3], vb, pa0, pa1, pa2, pa3);
}

template <int DQK> struct Cfg {
    static constexpr int KROWB = DQK * 2;
    static constexpr int SHM_V = KVBLK * DV * 2, SHM_K = KVBLK * DQK * 2;
    static constexpr int SHM = 2 * SHM_V + 2 * SHM_K + NW * 64 * 4;
    static constexpr int NKC = DQK / 64;
    static constexpr int CPR = DQK / 8;
};
template <int DQK, bool ALIBI, bool ROPE, int ldq, int ldk, int ldv, int ldo>
DI void attn_unit(const bf16* __restrict__ Qb, const bf16* __restrict__ Kh, const bf16* __restrict__ Vh,
                  bf16* __restrict__ Ob, int seq, float slope2, int qpos0, const float* __restrict__ rope, char* lds, const int tid, const float kmax) {
    using C = Cfg<DQK>;
    constexpr int ND = DQK / 16;
    const int wid = tid >> 6, lane = tid & 63, r32 = lane & 31, hi = lane >> 5;
    char* V_lds = lds; char* K_lds = lds + 2 * C::SHM_V;
    float* ws = (float*)(lds + 2 * C::SHM_V + 2 * C::SHM_K) + wid * 64; float* li_l = ws; float* al_l = ws + 32;
    float m_reg = -1e30f, l_reg = 0; f32x16 o[4] = {}; bf16x8 qr[ND];
    const bf16* Qw = Qb + (long)(wid * QBLK + r32) * ldq + hi * 8;
#pragma unroll
    for (int d0 = 0; d0 < ND; ++d0) qr[d0] = *reinterpret_cast<const bf16x8*>(Qw + d0 * 16);
    if (ROPE) {
        const float* rp = rope + (size_t)(qpos0 + wid * QBLK + r32) * 64;
#pragma unroll
        for (int d0 = ND - 4; d0 < ND; ++d0) {
            const f32x4 c0 = *(const f32x4*)(rp + (8 * (d0 - (ND - 4)) + 4 * hi) * 2), c1 = *(const f32x4*)(rp + (8 * (d0 - (ND - 4)) + 4 * hi) * 2 + 4);
            const u32x4 w = __builtin_bit_cast(u32x4, qr[d0]); u32x4 o_;
            { const float a = bflo(w[0]), b = bfhi(w[0]); o_[0] = pk2(a * c0[0] - b * c0[1], a * c0[1] + b * c0[0]); }
            { const float a = bflo(w[1]), b = bfhi(w[1]); o_[1] = pk2(a * c0[2] - b * c0[3], a * c0[3] + b * c0[2]); }
            { const float a = bflo(w[2]), b = bfhi(w[2]); o_[2] = pk2(a * c1[0] - b * c1[1], a * c1[1] + b * c1[0]); }
            { const float a = bflo(w[3]), b = bfhi(w[3]); o_[3] = pk2(a * c1[2] - b * c1[3], a * c1[3] + b * c1[2]); }
            qr[d0] = __builtin_bit_cast(bf16x8, o_);
        }
    }
    const int sr = tid >> 4, sc = (tid & 15) * 8, vst0 = v_st(sr, sc), vst1 = v_st(32 + sr, sc);
    int krow[C::NKC], kcol[C::NKC], kdst[C::NKC];
#pragma unroll
    for (int i = 0; i < C::NKC; ++i) { const int c = tid + 512 * i; krow[i] = c / C::CPR; kcol[i] = (c % C::CPR) * 8; kdst[i] = krow[i] * C::KROWB + ((kcol[i] * 2) ^ ((krow[i] & 7) << 4)); }
    const int vb0 = (int)(uintptr_t)V_lds + v_rd_base(lane);
    const float qposh = (float)(qpos0 + wid * QBLK + r32 - 4 * hi);
    struct { bf16x8 vs0, vs1, ks[C::NKC]; } st_;
#define SLOAD(k0) do { st_.vs0 = *reinterpret_cast<const bf16x8*>(&Vh[(long)((k0) + sr) * ldv + sc]); st_.vs1 = *reinterpret_cast<const bf16x8*>(&Vh[(long)((k0) + 32 + sr) * ldv + sc]); \
    _Pragma("unroll") for (int i_ = 0; i_ < C::NKC; ++i_) st_.ks[i_] = *reinterpret_cast<const bf16x8*>(&Kh[(long)((k0) + krow[i_]) * ldk + kcol[i_]]); } while (0)
#define SWRITE(b) do { *(bf16x8*)(V_lds + (b) * C::SHM_V + vst0) = st_.vs0; *(bf16x8*)(V_lds + (b) * C::SHM_V + vst1) = st_.vs1; \
    _Pragma("unroll") for (int i_ = 0; i_ < C::NKC; ++i_) *(bf16x8*)(K_lds + (b) * C::SHM_K + kdst[i_]) = st_.ks[i_]; } while (0)
#define SWAIT() asm volatile("s_waitcnt vmcnt(0)" ::: "memory")
#define RESC(a) do { if (__any((a) < 1.f)) { if (hi == 0) al_l[r32] = (a); asm volatile("s_waitcnt lgkmcnt(0)" ::: "memory"); \
    _Pragma("unroll") for (int d = 0; d < 4; ++d) _Pragma("unroll") for (int r = 0; r < 16; ++r) o[d][r] *= al_l[crow(r, hi)]; } } while (0)
#define QKT(P0, P1, KB, k0) do { P0 = f32x16{}; P1 = f32x16{}; \
    _Pragma("unroll") for (int d0 = 0; d0 < ND; ++d0) { const int cb = (d0 * 16 + hi * 8) * 2; \
        const bf16x8 b0_ = *reinterpret_cast<const bf16x8*>((KB) + r32 * C::KROWB + (cb ^ ((r32 & 7) << 4))); \
        const bf16x8 b1_ = *reinterpret_cast<const bf16x8*>((KB) + (32 + r32) * C::KROWB + (cb ^ ((r32 & 7) << 4))); \
        P0 = MFMA32(b0_, qr[d0], P0); P1 = MFMA32(b1_, qr[d0], P1); } \
    if (ALIBI) { const float kb_ = qposh - (float)(k0); \
        _Pragma("unroll") for (int r = 0; r < 16; ++r) { const float d_ = kb_ - (float)((r & 3) + 8 * (r >> 2)); P0[r] -= slope2 * fabsf(d_); P1[r] -= slope2 * fabsf(d_ - 32.f); } } } while (0)
    f32x16 pA0, pA1; float mnA, alA; bf16x8 pa0, pa1, pa2, pa3; int NT = seq / KVBLK; int jlo = 0;
    if (ALIBI) {
        float sq = 0.f;
#pragma unroll
        for (int d0 = 0; d0 < ND; ++d0) { const u32x4 w = __builtin_bit_cast(u32x4, qr[d0]);
#pragma unroll
            for (int q4 = 0; q4 < 4; ++q4) sq += bflo(w[q4]) * bflo(w[q4]) + bfhi(w[q4]) * bfhi(w[q4]); }
        sq += __shfl_xor(sq, 32);
#pragma unroll
        for (int o_ = 1; o_ < 32; o_ <<= 1) sq = fmaxf(sq, __shfl_xor(sq, o_));
        if (lane == 0) ws[63] = sq;
        __syncthreads();
        float qm = 0.f;
#pragma unroll
        for (int w_ = 0; w_ < NW; ++w_) qm = fmaxf(qm, ((const float*)(lds + 2 * C::SHM_V + 2 * C::SHM_K))[w_ * 64 + 63]);
        const float bound = 2.f * sqrtf(qm) * kmax * 1.01f + 40.f;
        const float dc = fminf(bound / slope2, 16384.f);
        const int dcut = (int)dc + 1;
        const int a_ = qpos0 - dcut; jlo = a_ > 0 ? (a_ >> 6) : 0;
        const int b_ = (qpos0 + QBLK * NW - 1 + dcut) >> 6; NT = b_ + 1 < NT ? b_ + 1 : NT;
    }
    SLOAD(jlo * KVBLK); SWAIT(); SWRITE(0); __syncthreads();
#pragma unroll 1
    for (int j = jlo; j < NT; ++j) {
        const int bsel = (j - jlo) & 1;
        if (j + 1 < NT) SLOAD((j + 1) * KVBLK);
        SBAR(); QKT(pA0, pA1, K_lds + bsel * C::SHM_K, j * KVBLK);
        partialSM(pA0, pA1, m_reg, mnA, alA);
        RESC(alA);
        finishSM(pA0, pA1, alA, l_reg, pa0, pa1, pa2, pa3); SBAR();
        pv_d0(o, vb0 + bsel * C::SHM_V, pa0, pa1, pa2, pa3);
        if (j + 1 < NT) { SWAIT(); SWRITE(bsel ^ 1); }
        __syncthreads();
    }
    if (hi == 0) li_l[r32] = l_reg; asm volatile("s_waitcnt lgkmcnt(0)" ::: "memory");
    float rli[16];
#pragma unroll
    for (int r = 0; r < 16; ++r) rli[r] = __builtin_amdgcn_rcpf(li_l[crow(r, hi)]);
    bf16* Ow = Ob + (long)(wid * QBLK) * ldo;
#pragma unroll
    for (int r = 0; r < 16; ++r) { const int orow = crow(r, hi);
#pragma unroll
        for (int d0 = 0; d0 < 4; ++d0) Ow[(long)orow * ldo + d0 * 32 + r32] = f2bf(o[d0][r] * rli[r]); }
    __syncthreads();
#undef SLOAD
#undef SWRITE
#undef SWAIT
#undef RESC
#undef QKT
}
#undef SBAR
}

#define XB_TMO      128
#define XB_XCNT(j)  (256  + 64 * (j))
#define XB_XSUB(j)  (1280 + 64 * (j))
#define XB_XGEN(j)  (2304 + 64 * (j))
#define XB_TOP      3328
#define XB_TOPGEN   3392
#define XCD_BAR_WORDS 3456
#define XB_SPIN_CAP (1u << 18)
DI unsigned xb_ld(unsigned* p)              { return __hip_atomic_load(p, __ATOMIC_RELAXED, __HIP_MEMORY_SCOPE_AGENT); }
DI unsigned xb_add(unsigned* p, unsigned v) { return __hip_atomic_fetch_add(p, v, __ATOMIC_RELAXED, __HIP_MEMORY_SCOPE_AGENT); }
DI unsigned xb_xcc_id() { return (unsigned)__builtin_amdgcn_s_getreg((3 << 11) | 20) & 0xFu; }
#define XB_SPIN(cond, bar) do { unsigned _sp = 0; while (cond) { __builtin_amdgcn_s_sleep(1); \
    if ((++_sp & 255u) == 0u) { if (xb_ld(&(bar)[XB_TMO])) break; if (_sp > XB_SPIN_CAP) { atomicAdd(&(bar)[XB_TMO], 1u); break; } } } } while (0)
struct XcdBarrier { unsigned* bar; unsigned x; volatile LAS unsigned* st; };
DI XcdBarrier xcd_barrier_post(unsigned* bar, volatile LAS unsigned* st) {
    XcdBarrier b; b.bar = bar; b.x = xb_xcc_id(); b.st = st;
    if (threadIdx.x == 0) (void)xb_add(&bar[XB_XCNT(b.x)], 1u);
    return b;
}
DI void xcd_barrier_complete(unsigned* bar, unsigned x, unsigned& nloc, unsigned& nx) {
    const unsigned G = gridDim.x * gridDim.y * gridDim.z;
    unsigned sum, cnt, mine, sp = 0u;
    for (;;) {
        sum = 0u; cnt = 0u; mine = 0u;
#pragma unroll
        for (unsigned j = 0; j < 16; ++j) { const unsigned c = xb_ld(&bar[XB_XCNT(j)]); sum += c; cnt += (c > 0u) ? 1u : 0u; mine = (j == x) ? c : mine; }
        if (sum == G) break;
        __builtin_amdgcn_s_sleep(1);
        if ((++sp & 255u) == 0u) { if (xb_ld(&bar[XB_TMO])) break; if (sp > XB_SPIN_CAP) { atomicAdd(&bar[XB_TMO], 1u); break; } }
    }
    nloc = mine > 0u ? mine : 1u; nx = cnt > 0u ? cnt : 1u;
}
DI void xcd_barrier(const XcdBarrier& b) {
    asm volatile("s_waitcnt vmcnt(0)" ::: "memory");
    __syncthreads();
    if (threadIdx.x == 0) {
        unsigned* bar = b.bar;
        __builtin_amdgcn_s_waitcnt(0);
        unsigned nloc = b.st[0], nx = b.st[1];
        if (nloc == 0u) { xcd_barrier_complete(bar, b.x, nloc, nx); b.st[0] = nloc; b.st[1] = nx; }
        const unsigned old = xb_add(&bar[XB_XSUB(b.x)], 1u);
        const unsigned gen = old / nloc;
        if (old + 1u == (gen + 1u) * nloc) {
            __builtin_amdgcn_fence(__ATOMIC_RELEASE, "agent");
            asm volatile("s_waitcnt vmcnt(0)" ::: "memory");
            const unsigned og = xb_add(&bar[XB_TOP], 1u);
            const unsigned tg = og / nx;
            if (og + 1u == (tg + 1u) * nx) xb_add(&bar[XB_TOPGEN], 1u);
            else XB_SPIN(xb_ld(&bar[XB_TOPGEN]) == tg, bar);
            __builtin_amdgcn_fence(__ATOMIC_ACQUIRE, "agent");
            xb_add(&bar[XB_XGEN(b.x)], 1u);
            asm volatile("s_waitcnt vmcnt(0)" ::: "memory");
        } else {
            XB_SPIN(xb_ld(&bar[XB_XGEN(b.x)]) == gen, bar);
            __builtin_amdgcn_fence(__ATOMIC_ACQUIRE, "agent");
            asm volatile("s_waitcnt vmcnt(0)" ::: "memory");
        }
    }
    __syncthreads();
}

constexpr int RING_BYTES = 131072;
constexpr int LDSCTL_OFF = RING_BYTES, MISC_OFF = LDSCTL_OFF + 320;
constexpr int LDS_BYTES = 147456;

struct Ctx { LAS unsigned char* lds; int tid, lane, wave, G, bx, gw, NGW; };

enum { MAP_ID = 0, MAP_ROPEQ = 1, MAP_FFNUP = 2 };
DI int map_row(int kind, int n) {
    if (kind == MAP_ROPEQ) { const int h = n / 192, r = n % 192; if (r < 128) return n; const int i = r - 128; return h * 192 + 128 + ((i < 32) ? 2 * i : 2 * (i - 32) + 1); }
    if (kind == MAP_FFNUP) { if (n < FFN_H) return (n >> 7) * 256 + (n & 127); const int c = n - FFN_H; return (c >> 7) * 256 + 128 + (c & 127); }
    return n;
}
DI void transpose_item(const float* W, int K, int N, bf16* WT, int kind, int row_off, LAS float* scr, int item, int lane) {
    const int nblk = N / 32, kb = item / nblk, nb = item % nblk, k0 = 64 * kb, n0 = 32 * nb;
#pragma unroll 8
    for (int i = 0; i < 32; ++i) { const int kk = 2 * i + (lane >> 5); scr[kk * 33 + (lane & 31)] = W[(size_t)(k0 + kk) * N + n0 + (lane & 31)]; }
    asm volatile("s_waitcnt lgkmcnt(0)" ::: "memory");
    const int c = lane & 7;
#pragma unroll
    for (int j = 0; j < 4; ++j) { const int n = (lane >> 3) + 8 * j; const LAS float* s = scr + (8 * c) * 33 + n;
        u32x4 o; o.x = pk2(s[0 * 33], s[1 * 33]); o.y = pk2(s[2 * 33], s[3 * 33]); o.z = pk2(s[4 * 33], s[5 * 33]); o.w = pk2(s[6 * 33], s[7 * 33]);
        *(u32x4*)(WT + (size_t)(row_off + map_row(kind, n0 + n)) * K + k0 + 8 * c) = o; }
    asm volatile("s_waitcnt lgkmcnt(0)" ::: "memory");
}
struct TJob { const float* W; int K, N; bf16* WT; int kind, row_off; };
template <int NJ> DI void run_transposes(const Ctx& c, const TJob (&jobs)[NJ]) {
    LAS float* scr = (LAS float*)(c.lds + c.wave * 16384);
    int total = 0;
#pragma unroll
    for (int j = 0; j < NJ; ++j) total += (jobs[j].K / 64) * (jobs[j].N / 32);
    for (int it = c.gw; it < total; it += c.NGW) {
        int r = it;
#pragma unroll
        for (int j = 0; j < NJ; ++j) { const int n = (jobs[j].K / 64) * (jobs[j].N / 32);
            if (r >= 0 && r < n) transpose_item(jobs[j].W, jobs[j].K, jobs[j].N, jobs[j].WT, jobs[j].kind, jobs[j].row_off, scr, r, c.lane);
            r -= n; }
    }
}
DI void zero_rows(const Ctx& c, bf16* WT, int K, int row0, int nrows) {
    for (int r = c.gw; r < nrows; r += c.NGW) { u32x4* p = (u32x4*)(WT + (size_t)(row0 + r) * K);
        for (int i = c.lane; i < K / 8; i += 64) p[i] = (u32x4){0u, 0u, 0u, 0u}; }
}

DI void load_row_f32(const float* row, int lane, f32x4 (&v)[4]) {
#pragma unroll
    for (int j = 0; j < 4; ++j) v[j] = *((const f32x4*)row + lane + 64 * j);
}
DI void load_row_bf16(const bf16* row, int lane, f32x4 (&v)[4]) {
#pragma unroll
    for (int j = 0; j < 4; ++j) { const u32x2 w = *((const u32x2*)row + lane + 64 * j); v[j] = (f32x4){bflo(w.x), bfhi(w.x), bflo(w.y), bfhi(w.y)}; }
}
DI void store_row_bf16(bf16* row, int lane, const f32x4 (&v)[4]) {
#pragma unroll
    for (int j = 0; j < 4; ++j) { u32x2 w; w.x = pk2(v[j][0], v[j][1]); w.y = pk2(v[j][2], v[j][3]); *((u32x2*)row + lane + 64 * j) = w; }
}
DI float sumsq4(const f32x4 (&v)[4]) { float s = 0.f;
#pragma unroll
    for (int j = 0; j < 4; ++j) s += (v[j][0] * v[j][0] + v[j][1] * v[j][1]) + (v[j][2] * v[j][2] + v[j][3] * v[j][3]);
    return s; }
DI void pass_norm0(const Ctx& c, const float* x, const float* g, bf16* XN) {
    f32x4 gv[4]; load_row_f32(g, c.lane, gv);
    for (int m = c.gw; m < MROWS; m += c.NGW) {
        f32x4 v[4]; load_row_f32(x + (size_t)m * DM, c.lane, v);
        const float rstd = rsqrtf(wave_sum(sumsq4(v)) * (1.f / DM) + EPS);
#pragma unroll
        for (int j = 0; j < 4; ++j) v[j] = v[j] * rstd * gv[j];
        store_row_bf16(XN + (size_t)m * DM, c.lane, v);
    }
}
DI void pass_res_norm(const Ctx& c, const bf16* a, const float* base, const float* g1, const float* g2, float* out, bf16* XN) {
    f32x4 g1v[4], g2v[4]; load_row_f32(g1, c.lane, g1v);
    if (XN) load_row_f32(g2, c.lane, g2v);
    for (int m = c.gw; m < MROWS; m += c.NGW) {
        f32x4 v[4], b[4]; load_row_bf16(a + (size_t)m * DM, c.lane, v); load_row_f32(base + (size_t)m * DM, c.lane, b);
        const float rstd = rsqrtf(wave_sum(sumsq4(v)) * (1.f / DM) + EPS);
#pragma unroll
        for (int j = 0; j < 4; ++j) { b[j] = b[j] + v[j] * rstd * g1v[j]; *((f32x4*)(out + (size_t)m * DM) + c.lane + 64 * j) = b[j]; }
        if (XN) {
            const float rstd2 = rsqrtf(wave_sum(sumsq4(b)) * (1.f / DM) + EPS);
#pragma unroll
            for (int j = 0; j < 4; ++j) b[j] = b[j] * rstd2 * g2v[j];
            store_row_bf16(XN + (size_t)m * DM, c.lane, b);
        }
    }
}

__device__ const double ROPE_INV[32] = {
    1.0, 0.7498942093324559, 0.5623413251903491, 0.4216965034285822, 0.31622776601683794, 0.23713737056616552, 0.1778279410038923, 0.1333521432163324,
    0.1, 0.07498942093324558, 0.05623413251903491, 0.042169650342858224, 0.03162277660168379, 0.023713737056616554, 0.01778279410038923, 0.01333521432163324,
    0.01, 0.007498942093324558, 0.005623413251903491, 0.004216965034285823, 0.0031622776601683794, 0.0023713737056616554, 0.0017782794100389228, 0.001333521432163324,
    0.001, 0.0007498942093324559, 0.0005623413251903491, 0.00042169650342858224, 0.00031622776601683794, 0.00023713737056616554, 0.00017782794100389227, 0.0001333521432163324};
DI void fill_rope(const Ctx& c, float* rope) {
    for (int i = c.bx * NTHREADS + c.tid; i < SEQ * 32; i += c.G * NTHREADS) {
        const int pos = i >> 5, k = i & 31;
        const double t = (double)pos * ROPE_INV[k] * 0.15915494309189535;
        const float fr = (float)(t - (double)(long long)t);
        rope[2 * i] = __builtin_amdgcn_cosf(fr); rope[2 * i + 1] = __builtin_amdgcn_sinf(fr);
    }
}
DI void pass_mla_mid(const Ctx& c, const bf16* DQKV, const float* gq, const float* gkv, const float* rope, bf16* CQ, bf16* CKV, bf16* KF) {
    float gqv[6], gkvv[4];
#pragma unroll
    for (int i = 0; i < 6; ++i) gqv[i] = gq[c.lane + 64 * i];
#pragma unroll
    for (int i = 0; i < 4; ++i) gkvv[i] = gkv[c.lane + 64 * i];
    for (int m = c.gw; m < MROWS; m += c.NGW) {
        const bf16* row = DQKV + (size_t)m * 768;
        float xq[6], xk[4]; float sq = 0.f, sk = 0.f;
#pragma unroll
        for (int i = 0; i < 6; ++i) { xq[i] = bf2f(row[c.lane + 64 * i]); sq += xq[i] * xq[i]; }
#pragma unroll
        for (int i = 0; i < 4; ++i) { xk[i] = bf2f(row[384 + c.lane + 64 * i]); sk += xk[i] * xk[i]; }
        const float rq = rsqrtf(wave_sum(sq) * (1.f / 384.f) + EPS), rk = rsqrtf(wave_sum(sk) * (1.f / 256.f) + EPS);
#pragma unroll
        for (int i = 0; i < 6; ++i) CQ[(size_t)m * 384 + c.lane + 64 * i] = f2bf(xq[i] * rq * gqv[i]);
#pragma unroll
        for (int i = 0; i < 4; ++i) CKV[(size_t)m * 256 + c.lane + 64 * i] = f2bf(xk[i] * rk * gkvv[i]);
        const int i = c.lane & 31; const float x1 = bf2f(row[640 + i]), x2 = bf2f(row[672 + i]);
        const float* rp = rope + ((size_t)(m & (SEQ - 1)) * 32 + i) * 2; const float cs = rp[0], sn = rp[1];
        const float ov = (c.lane < 32) ? (x1 * cs - x2 * sn) : (x1 * sn + x2 * cs);
        const bf16 ob = f2bf(ov); const int idx = 2 * i + (c.lane >> 5);
#pragma unroll
        for (int h = 0; h < 8; ++h) KF[(size_t)m * 1536 + h * 192 + 128 + idx] = ob;
    }
}
constexpr int CW_KMAX = 8192, CW_QCTR = 8448;
DI void pass_kmax(const Ctx& c, const bf16* Kd, unsigned* ctl) {
    LAS float* red = (LAS float*)c.lds;
    for (int rb = c.bx; rb < MROWS / 128; rb += c.G) {
        float mx = 0.f;
        for (int i = 0; i < 16; ++i) {
            const bf16* row = Kd + (size_t)(rb * 128 + c.wave * 16 + i) * 1024 + 16 * c.lane;
            const u32x4 a = *(const u32x4*)row, b = *(const u32x4*)(row + 8);
            float s = 0.f;
#pragma unroll
            for (int q = 0; q < 4; ++q) s += bflo(a[q]) * bflo(a[q]) + bfhi(a[q]) * bfhi(a[q]) + bflo(b[q]) * bflo(b[q]) + bfhi(b[q]) * bfhi(b[q]);
            s += __shfl_xor(s, 1); s += __shfl_xor(s, 2);
            mx = fmaxf(mx, s);
        }
        __syncthreads();
        if ((c.lane & 3) == 0) red[c.wave * 16 + (c.lane >> 2)] = mx;
        __syncthreads();
        if (c.tid < 16) { float m = 0.f;
#pragma unroll
            for (int w = 0; w < NWAVES; ++w) m = fmaxf(m, red[w * 16 + c.tid]);
            atomicMax(ctl + CW_KMAX + ((rb * 128) / SEQ) * 16 + c.tid, __float_as_uint(sqrtf(m))); }
    }
}
template <int DQK, bool ALIBI, bool ROPE, int ldq, int qhs, int ldk, int khs, int ldv, int vhs, int vdiv, int ldo, int ohs, int nheads>
DI void attention_phase(const Ctx& c, const bf16* Q, const bf16* K, const bf16* V, bf16* O, const float* rope, unsigned* ctl) {
    constexpr int NU = BATCH * nheads * 32;
    if (!ALIBI) {
        for (int u = c.bx; u < NU; u += c.G) {
            const int xcd = u & 7, slot = (u >> 3) & 31, rnd = u >> 8, bh = xcd + 8 * rnd, qb = slot;
            const int b = bh / nheads, h = bh % nheads;
            const size_t row0 = (size_t)b * SEQ;
            att::attn_unit<DQK, ALIBI, ROPE, ldq, ldk, ldv, ldo>(Q + (row0 + qb * 256) * ldq + h * qhs, K + row0 * ldk + h * khs, V + row0 * ldv + (h / vdiv) * vhs,
                                       O + (row0 + qb * 256) * ldo + h * ohs, SEQ, 0.f, qb * 256, rope, (char*)c.lds, c.tid, 0.f);
        }
    } else {
        volatile LAS unsigned* qw = (volatile LAS unsigned*)(c.lds + LDSCTL_OFF);
        for (;;) {
            if (c.tid == 0) qw[0] = __hip_atomic_fetch_add(ctl + CW_QCTR, 1u, __ATOMIC_RELAXED, __HIP_MEMORY_SCOPE_AGENT);
            __syncthreads();
            const int u = (int)qw[0];
            __syncthreads();
            if (u >= NU) break;
            const int hh = 7 - (u >> 8), r = u & 255, b = r >> 6, sub = (r >> 5) & 1, qb = r & 31, h = 2 * hh + sub;
            const size_t row0 = (size_t)b * SEQ;
            const float slope2 = exp2f(-(float)(hh + 1)) * LOG2E;
            const float kmax = __uint_as_float(__hip_atomic_load(ctl + CW_KMAX + b * 16 + h, __ATOMIC_RELAXED, __HIP_MEMORY_SCOPE_AGENT));
            att::attn_unit<DQK, ALIBI, ROPE, ldq, ldk, ldv, ldo>(Q + (row0 + qb * 256) * ldq + h * qhs, K + row0 * ldk + h * khs, V + row0 * ldv + (h / vdiv) * vhs,
                                       O + (row0 + qb * 256) * ldo + h * ohs, SEQ, slope2, qb * 256, rope, (char*)c.lds, c.tid, kmax);
        }
    }
}

DI void pass_diff_combine(const Ctx& c, const bf16* OS, const float* lamp, const float* subg, bf16* OC) {
    const float lam_init = 0.8f - 0.6f * expf(-0.3f * 1.0f);
    const float sa = wave_sum(lamp[c.lane] * lamp[64 + c.lane]), sb = wave_sum(lamp[128 + c.lane] * lamp[192 + c.lane]);
    const float lam = expf(sa) - expf(sb) + lam_init;
    const int h = c.lane >> 3, e0 = (c.lane & 7) * 16;
    float gv[16];
#pragma unroll
    for (int i = 0; i < 16; ++i) gv[i] = subg[e0 + i] * (1.f - lam_init);
    for (int m = c.gw; m < MROWS; m += c.NGW) {
        const bf16* r1 = OS + (size_t)m * 2048 + (2 * h) * 128 + e0; const bf16* r2 = r1 + 128;
        const u32x4 a0 = *(const u32x4*)r1, a1 = *(const u32x4*)(r1 + 8), b0 = *(const u32x4*)r2, b1 = *(const u32x4*)(r2 + 8);
        float o[16]; float ss = 0.f;
#pragma unroll
        for (int i = 0; i < 4; ++i) { o[2 * i] = bflo(a0[i]) - lam * bflo(b0[i]); o[2 * i + 1] = bfhi(a0[i]) - lam * bfhi(b0[i]);
            o[8 + 2 * i] = bflo(a1[i]) - lam * bflo(b1[i]); o[8 + 2 * i + 1] = bfhi(a1[i]) - lam * bfhi(b1[i]); }
#pragma unroll
        for (int i = 0; i < 16; ++i) ss += o[i] * o[i];
        ss += __shfl_xor(ss, 1); ss += __shfl_xor(ss, 2); ss += __shfl_xor(ss, 4);
        const float rstd = rsqrtf(ss * (1.f / 128.f) + EPS);
        u32x4 w0, w1;
#pragma unroll
        for (int i = 0; i < 4; ++i) { w0[i] = pk2(o[2 * i] * rstd * gv[2 * i], o[2 * i + 1] * rstd * gv[2 * i + 1]); w1[i] = pk2(o[8 + 2 * i] * rstd * gv[8 + 2 * i], o[8 + 2 * i + 1] * rstd * gv[8 + 2 * i + 1]); }
        bf16* op = OC + (size_t)m * 1024 + h * 128 + e0; *(u32x4*)op = w0; *(u32x4*)(op + 8) = w1;
    }
}

DI float gelu_tanh(float x) { const float z = 0.7978845608028654f * (x + 0.044715f * x * x * x); return x * frcp(1.f + fexp(-2.f * z)); }
DI void pass_conv(const Ctx& c, bf16* U, const bf16* HALO, const float* cw, const float* cb) {
    const int NSTRIP = MROWS / 16;
    for (int s = c.gw; s < NSTRIP; s += c.NGW) {
        const int t0 = s * 16; const bool first = (t0 & (SEQ - 1)) == 0, lastst = ((t0 + 16) & (SEQ - 1)) == 0;
        for (int it = 0; it < 11; ++it) {
            const int cc = c.lane + 64 * it, ch = 4 * cc, gcol = (ch >> 7) * 256 + (ch & 127);
            const f32x4 wg0 = *(const f32x4*)(cw + ch), wg1 = *(const f32x4*)(cw + FFN_U + ch), wg2 = *(const f32x4*)(cw + 2 * FFN_U + ch), bg = *(const f32x4*)(cb + ch);
            const f32x4 wv0 = *(const f32x4*)(cw + FFN_H + ch), wv1 = *(const f32x4*)(cw + FFN_U + FFN_H + ch), wv2 = *(const f32x4*)(cw + 2 * FFN_U + FFN_H + ch), bv = *(const f32x4*)(cb + FFN_H + ch);
            u32x2 pg, pv, cg, cv, ng, nv;
            if (first) { pg = (u32x2){0u, 0u}; pv = pg; } else { const bf16* hp = HALO + ((size_t)(s - 1) * 2 + 1) * FFN_U + gcol; pg = *(const u32x2*)hp; pv = *(const u32x2*)(hp + 128); }
            { const bf16* up = U + (size_t)t0 * FFN_U + gcol; cg = *(const u32x2*)up; cv = *(const u32x2*)(up + 128); }
#pragma unroll 4
            for (int r = 0; r < 16; ++r) {
                if (r < 15) { const bf16* up = U + (size_t)(t0 + r + 1) * FFN_U + gcol; ng = *(const u32x2*)up; nv = *(const u32x2*)(up + 128); }
                else if (lastst) { ng = (u32x2){0u, 0u}; nv = ng; }
                else { const bf16* hp = HALO + ((size_t)(s + 1) * 2) * FFN_U + gcol; ng = *(const u32x2*)hp; nv = *(const u32x2*)(hp + 128); }
                f32x4 g_, v_;
                g_[0] = bg[0] + wg0[0] * bflo(pg.x) + wg1[0] * bflo(cg.x) + wg2[0] * bflo(ng.x); g_[1] = bg[1] + wg0[1] * bfhi(pg.x) + wg1[1] * bfhi(cg.x) + wg2[1] * bfhi(ng.x);
                g_[2] = bg[2] + wg0[2] * bflo(pg.y) + wg1[2] * bflo(cg.y) + wg2[2] * bflo(ng.y); g_[3] = bg[3] + wg0[3] * bfhi(pg.y) + wg1[3] * bfhi(cg.y) + wg2[3] * bfhi(ng.y);
                v_[0] = bv[0] + wv0[0] * bflo(pv.x) + wv1[0] * bflo(cv.x) + wv2[0] * bflo(nv.x); v_[1] = bv[1] + wv0[1] * bfhi(pv.x) + wv1[1] * bfhi(cv.x) + wv2[1] * bfhi(nv.x);
                v_[2] = bv[2] + wv0[2] * bflo(pv.y) + wv1[2] * bflo(cv.y) + wv2[2] * bflo(nv.y); v_[3] = bv[3] + wv0[3] * bfhi(pv.y) + wv1[3] * bfhi(cv.y) + wv2[3] * bfhi(nv.y);
                u32x2 o; o.x = pk2(gelu_tanh(g_[0]) * v_[0], gelu_tanh(g_[1]) * v_[1]); o.y = pk2(gelu_tanh(g_[2]) * v_[2], gelu_tanh(g_[3]) * v_[3]);
                *(u32x2*)(U + (size_t)(t0 + r) * FFN_U + gcol) = o;
                pg = cg; pv = cv; cg = ng; cv = nv;
            }
        }
    }
}

constexpr int ML_CH = 128, ML_NC = SEQ / ML_CH, ML_H = 8, ML_DK = 64, ML_DV = 128, ML_EX = 160;
constexpr int ML_LDK = 72, ML_LDV = 168, ML_LDP = 136;
struct MlLds { LAS bf16* kA; LAS bf16* kB; LAS bf16* vx; LAS bf16* P; LAS bf16* Cs; LAS float* sc; };
DI void ml_gates(const Ctx& c, const float* gates, int row0, int h, LAS float* sc) {
    if (c.tid < 128) { const float* g = gates + (size_t)(row0 + c.tid) * 32 + h;
        sc[c.tid] = g[0]; sc[128 + c.tid] = log_sigmoid_(g[8]); sc[256 + c.tid] = g[16]; sc[384 + c.tid] = log_sigmoid_(g[24]); }
    __syncthreads();
    if (c.tid == 0) { float a = 0.f;
#pragma unroll 4
        for (int t = 0; t < 128; ++t) { a += sc[128 + t]; sc[512 + t] = a; } }
    if (c.tid == 64) { float a = 0.f;
#pragma unroll 4
        for (int t = 127; t >= 0; --t) { a += sc[384 + t]; sc[640 + t] = a; } }
    __syncthreads();
}
DI void ml_load_v(const Ctx& c, const bf16* v, int row0, int h, LAS bf16* vx) {
#pragma unroll
    for (int i = 0; i < 4; ++i) { const int ch = c.tid + 512 * i, r = ch >> 4, cc = (ch & 15) * 8;
        *(LAS u32x4*)(vx + r * ML_LDV + cc) = *(const u32x4*)(v + (size_t)(row0 + r) * 1024 + h * 128 + cc); }
    if (c.tid < 128) { LAS bf16* p = vx + c.tid * ML_LDV + 128;
        *(LAS u32x4*)p = (u32x4){0x00003f80u, 0u, 0u, 0u}; *(LAS u32x4*)(p + 8) = (u32x4){0u, 0u, 0u, 0u}; *(LAS u32x4*)(p + 16) = (u32x4){0u, 0u, 0u, 0u}; *(LAS u32x4*)(p + 24) = (u32x4){0u, 0u, 0u, 0u}; }
}
DI void ml_phase1(const Ctx& c, const bf16* k, const bf16* v, const float* gates, bf16* ST, float* DEC) {
    LAS bf16* kA = (LAS bf16*)c.lds; LAS bf16* kB = kA + 128 * ML_LDK; LAS bf16* vx = kB + 128 * ML_LDK; LAS float* sc = (LAS float*)(vx + 128 * ML_LDV);
    const int NU = BATCH * ML_H * ML_NC;
    for (int u = c.bx; u < NU; u += c.G) {
        const int ck = u % ML_NC, h = (u / ML_NC) % ML_H, b = u / (ML_NC * ML_H); const int row0 = b * SEQ + ck * ML_CH;
        ml_gates(c, gates, row0, h, sc);
        const float bl = sc[512 + 127], B0 = sc[640];
#pragma unroll
        for (int i = 0; i < 2; ++i) { const int ch = c.tid + 512 * i, r = ch >> 3, cc = (ch & 7) * 8;
            const u32x4 w = *(const u32x4*)(k + (size_t)(row0 + r) * 512 + h * 64 + cc);
            const float wF = fexp(bl - sc[512 + r] + sc[r]), wB = fexp(B0 - sc[640 + r] + sc[256 + r]);
            u32x4 a, bb;
#pragma unroll
            for (int q = 0; q < 4; ++q) { a[q] = pk2(bflo(w[q]) * wF, bfhi(w[q]) * wF); bb[q] = pk2(bflo(w[q]) * wB, bfhi(w[q]) * wB); }
            *(LAS u32x4*)(kA + r * ML_LDK + cc) = a; *(LAS u32x4*)(kB + r * ML_LDK + cc) = bb; }
        ml_load_v(c, v, row0, h, vx);
        __syncthreads();
#pragma unroll 1
        for (int id = c.wave; id < 20; id += 8) {
            const int dir = id / 10, rem = id % 10, db = rem / 5, eb = rem % 5;
            const LAS bf16* kw = dir ? kB : kA;
            f32x16 acc = {};
#pragma unroll 2
            for (int ks = 0; ks < 8; ++ks) acc = MFMA32(frag_tr(kw, ML_LDK, 16 * ks, 32 * db, c.lane), frag_tr(vx, ML_LDV, 16 * ks, 32 * eb, c.lane), acc);
            bf16* dst = ST + ((size_t)((b * ML_H + h) * 2 + dir) * ML_NC + ck) * (ML_DK * ML_EX);
            const int n = c.lane & 31, hi = c.lane >> 5;
#pragma unroll
            for (int r = 0; r < 16; ++r) dst[(32 * db + crow(r, hi)) * ML_EX + 32 * eb + n] = f2bf(acc[r]);
        }
        if (c.tid == 0) { float* d = DEC + (size_t)((b * ML_H + h) * 2) * ML_NC + ck; d[0] = fexp(bl); d[ML_NC] = fexp(B0); }
        __syncthreads();
    }
}
DI void ml_phase2(const Ctx& c, bf16* ST, const float* DEC) {
    constexpr int NG = ML_DK * ML_EX / 8;
    const int NTASK = BATCH * ML_H * 2 * NG;
    for (int t = c.bx * NTHREADS + c.tid; t < NTASK; t += c.G * NTHREADS) {
        const int g = t % NG, chain = t / NG, dir = chain & 1;
        bf16* base = ST + (size_t)chain * ML_NC * (ML_DK * ML_EX) + g * 8; const float* dec = DEC + (size_t)chain * ML_NC;
        float carry[8];
#pragma unroll
        for (int i = 0; i < 8; ++i) carry[i] = 0.f;
        for (int s = 0; s < ML_NC; ++s) {
            const int ck = dir ? (ML_NC - 1 - s) : s;
            u32x4* p = (u32x4*)(base + (size_t)ck * (ML_DK * ML_EX)); const u32x4 a = *p; const float d = dec[ck];
            u32x4 o;
#pragma unroll
            for (int q = 0; q < 4; ++q) { o[q] = pk2(carry[2 * q], carry[2 * q + 1]); carry[2 * q] = d * carry[2 * q] + bflo(a[q]); carry[2 * q + 1] = d * carry[2 * q + 1] + bfhi(a[q]); }
            *p = o;
        }
    }
}
DI void ml_phase3(const Ctx& c, const bf16* q, const bf16* k, const bf16* v, const bf16* og, const float* gates, const bf16* ST, const float* ng, bf16* Z) {
    LAS bf16* kl = (LAS bf16*)c.lds; LAS bf16* vx = kl + 128 * ML_LDK; LAS bf16* P = vx + 128 * ML_LDV; LAS bf16* Cs = P + 128 * ML_LDP; LAS float* sc = (LAS float*)(Cs + 64 * ML_LDV);
    LAS bf16* hb = P;
    const int NU = BATCH * ML_H * ML_NC;
    const int n = c.lane & 31, hi = c.lane >> 5, tb = c.wave & 3, wg2 = c.wave >> 2;
    for (int u = c.bx; u < NU; u += c.G) {
        const int ck = u % ML_NC, h = (u / ML_NC) % ML_H, b = u / (ML_NC * ML_H); const int row0 = b * SEQ + ck * ML_CH;
        ml_gates(c, gates, row0, h, sc);
#pragma unroll
        for (int i = 0; i < 2; ++i) { const int ch = c.tid + 512 * i, r = ch >> 3, cc = (ch & 7) * 8;
            *(LAS u32x4*)(kl + r * ML_LDK + cc) = *(const u32x4*)(k + (size_t)(row0 + r) * 512 + h * 64 + cc); }
        ml_load_v(c, v, row0, h, vx);
        const bf16* qg = q + (size_t)row0 * 512 + h * 64;
        bf16x8 qf[4];
#pragma unroll
        for (int kd = 0; kd < 4; ++kd) qf[kd] = gfrag_row(qg, 512, 32 * tb, 16 * kd, c.lane);
        f32x16 hs[2] = {};
#pragma unroll 1
        for (int dir = 0; dir < 2; ++dir) {
            const bf16* st = ST + ((size_t)((b * ML_H + h) * 2 + dir) * ML_NC + ck) * (ML_DK * ML_EX);
            for (int ch = c.tid; ch < 64 * 20; ch += NTHREADS) { const int r = ch / 20, cc = (ch % 20) * 8; *(LAS u32x4*)(Cs + r * ML_LDV + cc) = *(const u32x4*)(st + r * ML_EX + cc); }
            __syncthreads();
            const int ioff = dir ? 256 : 0, boff = dir ? 640 : 512;
            const float bt = sc[boff + 32 * tb + n];
#pragma unroll 1
            for (int sb2 = 0; sb2 < 2; ++sb2) {
                const int sb = 2 * wg2 + sb2;
                f32x16 a = {};
#pragma unroll
                for (int kd = 0; kd < 4; ++kd) a = MFMA32(frag_row(kl, ML_LDK, 32 * sb, 16 * kd, c.lane), qf[kd], a);
                const int t = 32 * tb + n;
#pragma unroll
                for (int g4 = 0; g4 < 4; ++g4) {
                    const int s0 = 32 * sb + 8 * g4 + 4 * hi;
                    float w[4];
#pragma unroll
                    for (int j = 0; j < 4; ++j) { const int s = s0 + j; const bool keep = dir ? (s >= t) : (s <= t);
                        const float e = fexp(fminf(bt - sc[boff + s], 0.f) + sc[ioff + s]); w[j] = keep ? a[4 * g4 + j] * e : 0.f; }
                    u32x2 o; o.x = pk2(w[0], w[1]); o.y = pk2(w[2], w[3]);
                    *(LAS u32x2*)(P + t * ML_LDP + s0) = o;
                }
            }
            __syncthreads();
            f32x16 acc[3] = {}, aci[3] = {};
#pragma unroll 2
            for (int ks = 0; ks < 8; ++ks) { const bf16x8 A = frag_row(P, ML_LDP, 32 * tb, 16 * ks, c.lane);
#pragma unroll
                for (int e = 0; e < 3; ++e) { const int et = (e == 2) ? 4 : 2 * wg2 + e; acc[e] = MFMA32(A, frag_tr(vx, ML_LDV, 16 * ks, 32 * et, c.lane), acc[e]); } }
#pragma unroll
            for (int kd = 0; kd < 4; ++kd) {
#pragma unroll
                for (int e = 0; e < 3; ++e) { const int et = (e == 2) ? 4 : 2 * wg2 + e; aci[e] = MFMA32(qf[kd], frag_tr(Cs, ML_LDV, 16 * kd, 32 * et, c.lane), aci[e]); } }
#pragma unroll
            for (int r = 0; r < 16; ++r) {
                const float eb_ = fexp(sc[boff + 32 * tb + crow(r, hi)]);
                const float t2 = acc[2][r] + eb_ * aci[2][r];
                const float den = __shfl(t2, hi * 32);
                const float inv = frcp(fmaxf(fabsf(den), 1.f));
                hs[0][r] += (acc[0][r] + eb_ * aci[0][r]) * inv; hs[1][r] += (acc[1][r] + eb_ * aci[1][r]) * inv;
            }
            __syncthreads();
        }
#pragma unroll
        for (int e = 0; e < 2; ++e)
#pragma unroll
            for (int r = 0; r < 16; ++r) hb[(32 * tb + crow(r, hi)) * ML_LDP + 32 * (2 * wg2 + e) + n] = f2bf(hs[e][r]);
        __syncthreads();
        const float g0 = ng[h * 128 + 2 * c.lane], g1 = ng[h * 128 + 2 * c.lane + 1];
        for (int rr = 0; rr < 16; ++rr) {
            const int t = 16 * c.wave + rr; const unsigned w = *(const LAS unsigned*)(hb + t * ML_LDP + 2 * c.lane);
            const float x0 = bflo(w), x1 = bfhi(w);
            const float mean = wave_sum(x0 + x1) * (1.f / 128.f); const float d0 = x0 - mean, d1 = x1 - mean;
            const float rstd = rsqrtf(wave_sum(d0 * d0 + d1 * d1) * (1.f / 128.f) + EPS);
            const unsigned ow = *(const unsigned*)(og + (size_t)(row0 + t) * 1024 + h * 128 + 2 * c.lane);
            *(unsigned*)(Z + (size_t)(row0 + t) * 1024 + h * 128 + 2 * c.lane) = pk2(d0 * rstd * g0 * sigmoidf_(bflo(ow)), d1 * rstd * g1 * sigmoidf_(bfhi(ow)));
        }
        __syncthreads();
    }
}

constexpr int RT_CH = 1024, RT_NC = SEQ / RT_CH, RT_H = 4, RT_DK = 256, RT_DV = 512;
constexpr int RT_LDK = 264, RT_LDB = 520, RT_LDA = 72;
DI void rt_phase2(const Ctx& c, const bf16* k, const bf16* v, const float* dlogit, bf16* RS) {
    LAS bf16* kw = (LAS bf16*)c.lds; LAS bf16* vh = kw + 64 * RT_LDK;
    const int NU = BATCH * RT_H * 2 * RT_NC;
    const int n = c.lane & 31, hi = c.lane >> 5;
    for (int u = c.bx; u < NU; u += c.G) {
        const int ck = u % RT_NC, dir = (u / RT_NC) & 1, h = (u / (2 * RT_NC)) % RT_H, b = u / (2 * RT_NC * RT_H);
        const int row0 = b * SEQ + ck * RT_CH;
        const float lg2 = log_sigmoid_(dlogit[dir * 4 + h]) * LOG2E;
        bf16* dst = RS + ((size_t)((b * RT_H + h) * 2 + dir) * RT_NC + ck) * (RT_DK * RT_DV);
        for (int half = 0; half < 2; ++half) {
            f32x16 acc[8] = {};
            for (int sb = 0; sb < RT_CH / 64; ++sb) {
                __syncthreads();
#pragma unroll
                for (int i = 0; i < 4; ++i) { const int ch = c.tid + 512 * i, r = ch >> 5, cc = (ch & 31) * 8; const int s = 64 * sb + r;
                    const float w = fexp2(lg2 * (float)(dir ? s : (RT_CH - 1 - s)));
                    const u32x4 kk = *(const u32x4*)(k + (size_t)(row0 + s) * 1024 + h * 256 + cc);
                    u32x4 o;
#pragma unroll
                    for (int q = 0; q < 4; ++q) o[q] = pk2(bflo(kk[q]) * w, bfhi(kk[q]) * w);
                    *(LAS u32x4*)(kw + r * RT_LDK + cc) = o;
                    *(LAS u32x4*)(vh + r * RT_LDK + cc) = *(const u32x4*)(v + (size_t)(row0 + s) * 2048 + h * 512 + half * 256 + cc); }
                __syncthreads();
#pragma unroll 1
                for (int ks = 0; ks < 4; ++ks) { const bf16x8 A = frag_tr(kw, RT_LDK, 16 * ks, 32 * c.wave, c.lane);
#pragma unroll
                    for (int et = 0; et < 8; ++et) { acc[et] = MFMA32(A, frag_tr(vh, RT_LDK, 16 * ks, 32 * et, c.lane), acc[et]); if (et == 3) __builtin_amdgcn_sched_barrier(0); } }
            }
#pragma unroll
            for (int et = 0; et < 8; ++et)
#pragma unroll
                for (int r = 0; r < 16; ++r) dst[(size_t)(32 * c.wave + crow(r, hi)) * RT_DV + half * 256 + 32 * et + n] = f2bf(acc[et][r]);
        }
        __syncthreads();
    }
}
DI void rt_phase3(const Ctx& c, bf16* RS, const float* dlogit) {
    constexpr int NG = RT_DK * RT_DV / 8;
    const int NTASK = BATCH * RT_H * 2 * NG;
    for (int t = c.bx * NTHREADS + c.tid; t < NTASK; t += c.G * NTHREADS) {
        const int g = t % NG, chain = t / NG, dir = chain & 1, h = (chain >> 1) % RT_H;
        const float gch = fexp2(log_sigmoid_(dlogit[dir * 4 + h]) * LOG2E * (float)RT_CH);
        bf16* base = RS + (size_t)chain * RT_NC * (RT_DK * RT_DV) + (size_t)g * 8;
        float carry[8];
#pragma unroll
        for (int i = 0; i < 8; ++i) carry[i] = 0.f;
#pragma unroll
        for (int s = 0; s < RT_NC; ++s) {
            const int ck = dir ? (RT_NC - 1 - s) : s;
            u32x4* p = (u32x4*)(base + (size_t)ck * (RT_DK * RT_DV)); const u32x4 a = *p;
            u32x4 o;
#pragma unroll
            for (int q = 0; q < 4; ++q) { o[q] = pk2(carry[2 * q], carry[2 * q + 1]); carry[2 * q] = gch * carry[2 * q] + bflo(a[q]); carry[2 * q + 1] = gch * carry[2 * q + 1] + bfhi(a[q]); }
            *p = o;
        }
    }
}
DI void rt_phase4(const Ctx& c, const bf16* q, const bf16* k, const bf16* v, bf16* gz, const bf16* RS, const float* dlogit, const float* ng) {
    LAS bf16* kt = (LAS bf16*)c.lds; LAS bf16* Bt = kt + 64 * RT_LDK; LAS bf16* At = Bt + 64 * RT_LDB; LAS float* red = (LAS float*)(At + 128 * RT_LDA);
    const int NU = BATCH * RT_H * RT_NC * 8;
    const int n = c.lane & 31, hi = c.lane >> 5, tb = c.wave & 3, eh = c.wave >> 2;
    for (int u = c.bx; u < NU; u += c.G) {
        const int tq = u & 7, ck = (u >> 3) % RT_NC, h = (u / (8 * RT_NC)) % RT_H, b = u / (8 * RT_NC * RT_H);
        const int rowc = b * SEQ + ck * RT_CH, rowq = rowc + tq * 128;
        const float lf2 = log_sigmoid_(dlogit[h]) * LOG2E, lb2 = log_sigmoid_(dlogit[4 + h]) * LOG2E;
        const bf16* qg = q + (size_t)rowq * 1024 + h * 256;
        f32x16 acc[8] = {};
        for (int step = 0; step < 24; ++step) {
            __syncthreads();
            int otid = c.tid; asm volatile("" : "+v"(otid));
            if (step < 16) {
                const int s0 = 64 * step;
#pragma unroll
                for (int i = 0; i < 4; ++i) { const int ch = otid + 512 * i, r = ch >> 5, cc = (ch & 31) * 8;
                    *(LAS u32x4*)(kt + r * RT_LDK + cc) = *(const u32x4*)(k + (size_t)(rowc + s0 + r) * 1024 + h * 256 + cc); }
#pragma unroll
                for (int i = 0; i < 8; ++i) { const int ch = otid + 512 * i, r = ch >> 6, cc = (ch & 63) * 8;
                    *(LAS u32x4*)(Bt + r * RT_LDB + cc) = *(const u32x4*)(v + (size_t)(rowc + s0 + r) * 2048 + h * 512 + cc);
                    if ((i & 3) == 3) __builtin_amdgcn_sched_barrier(0); }
                __syncthreads();
                f32x16 a = {};
#pragma unroll 4
                for (int kd = 0; kd < 16; ++kd) a = MFMA32(frag_row(kt, RT_LDK, 32 * eh, 16 * kd, c.lane), gfrag_row(qg, 1024, 32 * tb, 16 * kd, c.lane), a);
                const int tl = 32 * tb + n, tpos = 128 * tq + tl;
#pragma unroll
                for (int g4 = 0; g4 < 4; ++g4) {
                    const int sl = 32 * eh + 8 * g4 + 4 * hi;
                    float w[4];
#pragma unroll
                    for (int j = 0; j < 4; ++j) { const float rel = (float)(tpos - (s0 + sl + j));
                        const float mk = (rel >= 0.f ? fexp2(rel * lf2) : 0.f) + (rel <= 0.f ? fexp2(-rel * lb2) : 0.f); w[j] = a[4 * g4 + j] * mk; }
                    u32x2 o; o.x = pk2(w[0], w[1]); o.y = pk2(w[2], w[3]);
                    *(LAS u32x2*)(At + tl * RT_LDA + sl) = o;
                }
            } else {
                const int dir = (step - 16) >> 2, d0 = 64 * ((step - 16) & 3);
                const bf16* rs = RS + ((size_t)((b * RT_H + h) * 2 + dir) * RT_NC + ck) * (RT_DK * RT_DV) + (size_t)d0 * RT_DV;
#pragma unroll
                for (int i = 0; i < 8; ++i) { const int ch = otid + 512 * i, r = ch >> 6, cc = (ch & 63) * 8;
                    *(LAS u32x4*)(Bt + r * RT_LDB + cc) = *(const u32x4*)(rs + (size_t)r * RT_DV + cc);
                    if ((i & 3) == 3) __builtin_amdgcn_sched_barrier(0); }
#pragma unroll
                for (int i = 0; i < 2; ++i) { const int ch = otid + 512 * i, r = ch >> 3, cc = (ch & 7) * 8; const int tpos = 128 * tq + r;
                    const float xi = dir ? fexp2(lb2 * (float)(RT_CH - tpos)) : fexp2(lf2 * (float)(tpos + 1));
                    const u32x4 qq = *(const u32x4*)(qg + (size_t)r * 1024 + d0 + cc);
                    u32x4 o;
#pragma unroll
                    for (int q4 = 0; q4 < 4; ++q4) o[q4] = pk2(bflo(qq[q4]) * xi, bfhi(qq[q4]) * xi);
                    *(LAS u32x4*)(At + r * RT_LDA + cc) = o; }
            }
            __syncthreads();
#pragma unroll 1
            for (int ks = 0; ks < 4; ++ks) { const bf16x8 A = frag_row(At, RT_LDA, 32 * tb, 16 * ks, c.lane);
#pragma unroll
                for (int et = 0; et < 8; ++et) { acc[et] = MFMA32(A, frag_tr(Bt, RT_LDB, 16 * ks, 32 * (8 * eh + et), c.lane), acc[et]); if (et == 3) __builtin_amdgcn_sched_barrier(0); } }
        }
#pragma unroll
        for (int r = 0; r < 16; ++r) {
            float s1 = 0.f, s2 = 0.f;
#pragma unroll
            for (int et = 0; et < 8; ++et) { s1 += acc[et][r]; s2 += acc[et][r] * acc[et][r]; }
#pragma unroll
            for (int o = 1; o < 32; o <<= 1) { s1 += __shfl_xor(s1, o); s2 += __shfl_xor(s2, o); }
            if (n == 0) { red[((32 * tb + crow(r, hi)) * 2 + eh) * 2] = s1; red[((32 * tb + crow(r, hi)) * 2 + eh) * 2 + 1] = s2; }
        }
        __syncthreads();
#pragma unroll
        for (int r = 0; r < 16; ++r) {
            const int tl = 32 * tb + crow(r, hi);
            const float s1 = red[(tl * 2) * 2] + red[(tl * 2 + 1) * 2], s2 = red[(tl * 2) * 2 + 1] + red[(tl * 2 + 1) * 2 + 1];
            const float mean = s1 * (1.f / 512.f), var = fmaxf(s2 * (1.f / 512.f) - mean * mean, 0.f), rstd = rsqrtf(var + EPS);
            bf16* gp = gz + (size_t)(rowq + tl) * 2048 + h * 512 + 256 * eh + n;
#pragma unroll
            for (int et = 0; et < 8; ++et) { const float gt = bf2f(gp[32 * et]); const float y = (acc[et][r] - mean) * rstd * ng[h * 512 + 256 * eh + 32 * et + n];
                gp[32 * et] = f2bf(y * gt * sigmoidf_(gt)); }
        }
        __syncthreads();
    }
}

struct Args { const float* in[25]; float* out; unsigned char* ws; int ph_lo, ph_hi; };
constexpr int NPHASES = 64;
#define PHASE(...) do { if (ph >= lo && ph < hi) { { Ctx c = c0; asm volatile("" : "+v"(c.tid)); c.lane = c.tid & 63; c.wave = __builtin_amdgcn_readfirstlane(c.tid >> 6); c.gw = c.bx * NWAVES + c.wave; \
    __VA_ARGS__; } if (ph + 1 < hi) xcd_barrier(bar); } ++ph; } while (0)
#define FFN_JOBS(L) {args.in[2] + (size_t)(L) * DM * FFN_U, DM, FFN_U, WTup, MAP_FFNUP, 0}, {args.in[5] + (size_t)(L) * FFN_H * DM, FFN_H, DM, WTdown, MAP_ID, 0}

template <int L> DI void run_layer(const Ctx& c0, const Args& args, const XcdBarrier& bar, const int lo, const int hi, int& ph) {
    unsigned char* ws = args.ws;
    const float* x = args.in[0]; const float* norm_g = args.in[1];
    float* hout = args.out;
    float* rope = (float*)(ws + WS_ROPE);
    bf16* XN = (bf16*)(ws + WS_XN);
    unsigned char* S = ws + WS_S;
    bf16* WTmix = (bf16*)(ws + WT_MIX); bf16* WTup = (bf16*)(ws + WT_UP); bf16* WTdown = (bf16*)(ws + WT_DOWN);
    bf16* U = (bf16*)S; bf16* HALO = (bf16*)(S + 352 * MiB);
    LAS unsigned char* ring = c0.lds;

        const float* g0 = norm_g + (size_t)(L * 4 + 0) * DM; const float* g1 = g0 + DM; const float* g2 = g0 + 2 * DM; const float* g3 = g0 + 3 * DM;
        const float* hbase = (L == 0) ? x : hout;
        bf16* AOUT = (bf16*)S;
        if constexpr (L == 0) {
            bf16* Wd = WTmix; bf16* Wuq = (bf16*)(ws + WT_MIX + 2 * MiB); bf16* Wukv = (bf16*)(ws + WT_MIX + 4 * MiB); bf16* Wo = (bf16*)(ws + WT_MIX + 6 * MiB);
            bf16* DQKV = (bf16*)S; bf16* CQ = (bf16*)(S + 48 * MiB); bf16* CKV = (bf16*)(S + 72 * MiB); bf16* Q = (bf16*)(S + 88 * MiB); bf16* KF = (bf16*)(S + 184 * MiB);
            bf16* V = (bf16*)(S + 280 * MiB); bf16* O = (bf16*)(S + 344 * MiB);
            PHASE({
                fill_rope(c, rope);
                const TJob jobs[6] = {{args.in[6], DM, 384, Wd, MAP_ID, 0}, {args.in[9], DM, 320, Wd, MAP_ID, 384}, {args.in[8], 384, 1536, Wuq, MAP_ROPEQ, 0},
                                      {args.in[11], 256, 2048, Wukv, MAP_ID, 0}, {args.in[12], DM, DM, Wo, MAP_ID, 0}, {args.in[2], DM, FFN_U, WTup, MAP_FFNUP, 0}};
                run_transposes<6>(c, jobs);
                const TJob jobs2[1] = {{args.in[5], FFN_H, DM, WTdown, MAP_ID, 0}};
                run_transposes<1>(c, jobs2);
                zero_rows(c, Wd, DM, 704, 64);
                pass_norm0(c, x, g0, XN);
            });
            PHASE({ pg8::Gemm g{XN, Wd, MROWS, 768, DM, DM, 256}; pg8::StaticOrder so; so.init(MROWS, 768, c.G, c.bx);
                pg8::gemm_phase(ring, c.tid, g, so, pg8::epi_plain(DQKV, 768, 1.f)); });
            PHASE({ pass_mla_mid(c, DQKV, args.in[7], args.in[10], rope, CQ, CKV, KF); });
            PHASE({ pg8::Gemm g{CQ, Wuq, MROWS, 1536, 384, 384, 256}; pg8::StaticOrder so; so.init(MROWS, 1536, c.G, c.bx);
                  pg8::gemm_phase(ring, c.tid, g, so, pg8::epi_plain(Q, 1536, 0.07216878364870322f * LOG2E)); });
            PHASE({ pg8::Gemm g{CKV, Wukv, MROWS, 2048, 256, 256, 256}; pg8::StaticOrder so; so.init(MROWS, 2048, c.G, c.bx);
                  pg8::EpiMlaKV E{KF, V}; pg8::gemm_phase(ring, c.tid, g, so, E); });
            PHASE({ attention_phase<192, false, true, 1536, 192, 1536, 192, 1024, 128, 1, 1024, 128, 8>(c, Q, KF, V, O, rope, (unsigned*)(ws + WS_CTL)); });
            PHASE({ pg8::Gemm g{O, Wo, MROWS, DM, DM, DM, 256}; pg8::StaticOrder so; so.init(MROWS, DM, c.G, c.bx);
                pg8::gemm_phase(ring, c.tid, g, so, pg8::epi_plain(AOUT, DM, 1.f)); });
        } else if constexpr (L == 1) {
            bf16* Wqkv = WTmix; bf16* Wo = (bf16*)(ws + WT_MIX + 8 * MiB);
            bf16* Qd = (bf16*)S; bf16* Kd = (bf16*)(S + 64 * MiB); bf16* Vd = (bf16*)(S + 128 * MiB); bf16* OS = (bf16*)(S + 192 * MiB); bf16* OC = (bf16*)(S + 320 * MiB);
            PHASE({ pg8::Gemm g{XN, Wqkv, MROWS, 3072, DM, DM, 256}; pg8::StaticOrder so; so.init(MROWS, 3072, c.G, c.bx);
                pg8::EpiSeg<false> E{}; E.p0 = Qd; E.ld0 = DM; E.s0 = 0.125f * LOG2E; E.e0 = 8; E.p1 = Kd; E.ld1 = DM; E.s1 = 1.f; E.e1 = 16; E.p2 = Vd; E.ld2 = DM; E.s2 = 1.f; E.e2 = 100000;
                pg8::gemm_phase(ring, c.tid, g, so, E); });
            PHASE({ pass_kmax(c, Kd, (unsigned*)(ws + WS_CTL)); });
            PHASE({ attention_phase<64, true, false, 1024, 64, 1024, 64, 1024, 128, 2, 2048, 128, 16>(c, Qd, Kd, Vd, OS, rope, (unsigned*)(ws + WS_CTL)); });
            PHASE({ pass_diff_combine(c, OS, args.in[14], args.in[15], OC); });
            PHASE({ pg8::Gemm g{OC, Wo, MROWS, DM, DM, DM, 256}; pg8::StaticOrder so; so.init(MROWS, DM, c.G, c.bx);
                pg8::gemm_phase(ring, c.tid, g, so, pg8::epi_plain(AOUT, DM, 1.f)); });
        } else if constexpr (L == 2) {
            bf16* Win = WTmix; bf16* Wout = (bf16*)(ws + WT_MIX + 8 * MiB);
            bf16* q = (bf16*)S; bf16* k = (bf16*)(S + 32 * MiB); bf16* v = (bf16*)(S + 64 * MiB); bf16* og = (bf16*)(S + 128 * MiB);
            float* gates = (float*)(S + 192 * MiB); float* DEC = (float*)(S + 196 * MiB); bf16* ST = (bf16*)(S + 200 * MiB); bf16* Z = (bf16*)(S + 288 * MiB);
            PHASE({ pg8::Gemm g{XN, Win, MROWS, 3328, DM, DM, 256}; pg8::StaticOrder so; so.init(MROWS, 3328, c.G, c.bx);
                pg8::EpiSeg<true> E{}; E.p0 = q; E.ld0 = 512; E.s0 = 1.f; E.e0 = 4; E.p1 = k; E.ld1 = 512; E.s1 = 0.125f; E.e1 = 8; E.p2 = v; E.ld2 = DM; E.s2 = 1.f; E.e2 = 16; E.p3 = og; E.ld3 = DM; E.s3 = 1.f;
                E.gates = gates; E.gbias = args.in[18]; E.gblk = 24;
                pg8::gemm_phase(ring, c.tid, g, so, E); });
            PHASE({ ml_phase1(c, k, v, gates, ST, DEC); });
            PHASE({ ml_phase2(c, ST, DEC); });
            PHASE({ ml_phase3(c, q, k, v, og, gates, ST, args.in[19], Z); });
            PHASE({ pg8::Gemm g{Z, Wout, MROWS, DM, DM, DM, 256}; pg8::StaticOrder so; so.init(MROWS, DM, c.G, c.bx);
                pg8::gemm_phase(ring, c.tid, g, so, pg8::epi_plain(AOUT, DM, 1.f)); });
        } else {
            bf16* Win = WTmix; bf16* Wo = (bf16*)(ws + WT_MIX + 12 * MiB);
            bf16* q = (bf16*)S; bf16* k = (bf16*)(S + 64 * MiB); bf16* v = (bf16*)(S + 128 * MiB); bf16* gz = (bf16*)(S + 256 * MiB); bf16* RS = XN;
            PHASE({ pg8::Gemm g{XN, Win, MROWS, 6144, DM, DM, 256}; pg8::StaticOrder so; so.init(MROWS, 6144, c.G, c.bx);
                pg8::EpiSeg<false> E{}; E.p0 = q; E.ld0 = DM; E.s0 = 1.f; E.e0 = 8; E.p1 = k; E.ld1 = DM; E.s1 = 0.0625f; E.e1 = 16; E.p2 = v; E.ld2 = 2048; E.s2 = 1.f; E.e2 = 32; E.p3 = gz; E.ld3 = 2048; E.s3 = 1.f;
                pg8::gemm_phase(ring, c.tid, g, so, E); });
            PHASE({ rt_phase2(c, k, v, args.in[22], RS); });
            PHASE({ rt_phase3(c, RS, args.in[22]); });
            PHASE({ rt_phase4(c, q, k, v, gz, RS, args.in[22], args.in[23]); });
            PHASE({ pg8::Gemm g{gz, Wo, MROWS, DM, 2048, 2048, 256}; pg8::StaticOrder so; so.init(MROWS, DM, c.G, c.bx);
                pg8::gemm_phase(ring, c.tid, g, so, pg8::epi_plain(AOUT, DM, 1.f)); });
        }
        PHASE({ pass_res_norm(c, AOUT, hbase, g1, g2, hout, XN); });
        PHASE({ pg8::Gemm g{XN, WTup, MROWS, FFN_U, DM, DM, 256}; pg8::StaticOrder so; so.init(MROWS, FFN_U, c.G, c.bx);
            pg8::EpiFfnUp E{U, HALO}; pg8::gemm_phase(ring, c.tid, g, so, E); });
        PHASE({ pass_conv(c, U, HALO, args.in[3] + (size_t)L * 3 * FFN_U, args.in[4] + (size_t)L * FFN_U); });
        PHASE({ pg8::Gemm g{U, WTdown, MROWS, DM, FFN_H, FFN_U, 512}; pg8::StaticOrder so; so.init(MROWS, DM, c.G, c.bx);
            pg8::gemm_phase(ring, c.tid, g, so, pg8::epi_plain(XN, DM, 1.f)); });
        PHASE({
            pass_res_norm(c, XN, hout, g3, (L < 3) ? g0 + 4 * DM : g0, hout, (L < 3) ? XN : nullptr);
            if constexpr (L == 0) { const TJob jobs[4] = {{args.in[13], DM, 3072, WTmix, MAP_ID, 0}, {args.in[16], DM, DM, (bf16*)(ws + WT_MIX + 8 * MiB), MAP_ID, 0}, FFN_JOBS(1)}; run_transposes<4>(c, jobs); }
            else if constexpr (L == 1) { const TJob jobs[4] = {{args.in[17], DM, 3104, WTmix, MAP_ID, 0}, {args.in[20], DM, DM, (bf16*)(ws + WT_MIX + 8 * MiB), MAP_ID, 0}, FFN_JOBS(2)}; run_transposes<4>(c, jobs);
                zero_rows(c, WTmix, DM, 3104, 224); }
            else if constexpr (L == 2) { const TJob jobs[4] = {{args.in[21], DM, 6144, WTmix, MAP_ID, 0}, {args.in[24], 2048, DM, (bf16*)(ws + WT_MIX + 12 * MiB), MAP_ID, 0}, FFN_JOBS(3)}; run_transposes<4>(c, jobs); }
        });
    }

__global__ void __launch_bounds__(NTHREADS, 2) enc_fwd(Args args) {
    extern __shared__ __attribute__((aligned(16))) unsigned char lds_raw[];
    Ctx c;
    c.lds = (LAS unsigned char*)lds_raw;
    c.tid = threadIdx.x; c.lane = c.tid & 63; c.wave = __builtin_amdgcn_readfirstlane(c.tid >> 6);
    c.G = gridDim.x; c.bx = blockIdx.x; c.gw = c.bx * NWAVES + c.wave; c.NGW = c.G * NWAVES;
    volatile LAS unsigned* MISC = (volatile LAS unsigned*)(c.lds + MISC_OFF);
    for (int u = c.tid; u < (LDS_BYTES - LDSCTL_OFF) / 4; u += NTHREADS) ((LAS unsigned*)(c.lds + LDSCTL_OFF))[u] = 0u;
    __syncthreads();
    XcdBarrier bar = xcd_barrier_post((unsigned*)(args.ws + WS_CTL) + 4096, MISC + 8);
    const int lo = args.ph_lo, hi = args.ph_hi;
    int ph = 0;
    run_layer<0>(c, args, bar, lo, hi, ph);
    run_layer<1>(c, args, bar, lo, hi, ph);
    run_layer<2>(c, args, bar, lo, hi, ph);
    run_layer<3>(c, args, bar, lo, hi, ph);
}
#undef PHASE

#ifndef MK_N_LAUNCHES
#define MK_N_LAUNCHES 1
#endif
extern "C" void kernel_launch(void* const* d_in, const int* in_sizes, int n_in, void* d_out, int out_size, void* d_ws, size_t ws_size, hipStream_t stream) {
    static int grid = 0;
    if (grid == 0) {
        if (n_in != 25 || in_sizes[0] != MROWS * DM || out_size != MROWS * DM || ws_size < WS_END) {
            fprintf(stderr, "kernel_launch: unexpected shapes: n_in %d in0 %d out %d ws %zu (need %zu)\n", n_in, n_in > 0 ? in_sizes[0] : -1, out_size, ws_size, (size_t)WS_END); grid = -1; return; }
        int dev = 0, cus = 0, per_cu = 0;
        if (hipGetDevice(&dev) != hipSuccess || hipDeviceGetAttribute(&cus, hipDeviceAttributeMultiprocessorCount, dev) != hipSuccess) { grid = -1; return; }
        if (hipFuncSetAttribute((const void*)enc_fwd, hipFuncAttributeMaxDynamicSharedMemorySize, LDS_BYTES) != hipSuccess) { fprintf(stderr, "kernel_launch: hipFuncSetAttribute failed\n"); grid = -1; return; }
        if (hipOccupancyMaxActiveBlocksPerMultiprocessor(&per_cu, (const void*)enc_fwd, NTHREADS, LDS_BYTES) != hipSuccess || per_cu < 1)
            fprintf(stderr, "kernel_launch: note: occupancy query reports %d workgroups per CU\n", per_cu);
        (void)hipGetLastError();
        grid = cus;
    }
    if (grid < 0) return;
    Args a{};
    for (int i = 0; i < 25; ++i) a.in[i] = (const float*)d_in[i];
    a.out = (float*)d_out; a.ws = (unsigned char*)d_ws;
    if (MK_N_LAUNCHES == 1) {
        (void)hipMemsetAsync((char*)d_ws + WS_CTL, 0, CTL_ZERO_BYTES, stream);
        a.ph_lo = 0; a.ph_hi = NPHASES;
        hipLaunchKernelGGL(enc_fwd, dim3(grid), dim3(NTHREADS), LDS_BYTES, stream, a);
    } else {
        for (int p = 0; p < NPHASES; ++p) {
            (void)hipMemsetAsync((char*)d_ws + WS_CTL, 0, CTL_ZERO_BYTES, stream);
            a.ph_lo = p; a.ph_hi = p + 1;
            hipLaunchKernelGGL(enc_fwd, dim3(grid), dim3(NTHREADS), LDS_BYTES, stream, a);
        }
    }
    const hipError_t le = hipPeekAtLastError();
    if (le != hipSuccess) fprintf(stderr, "kernel_launch: launch failed: %s\n", hipGetErrorName(le));
}
```

```cpp
#include <hip/hip_runtime.h>
#include <cstdio>
#include <cstdint>

#define DI __device__ __forceinline__
#define LAS __attribute__((address_space(3)))
#define GAS __attribute__((address_space(1)))
typedef unsigned short bf16;
typedef short bf16x8 __attribute__((ext_vector_type(8)));
typedef short s16x4 __attribute__((ext_vector_type(4)));
typedef float f32x2 __attribute__((ext_vector_type(2)));
typedef float f32x4 __attribute__((ext_vector_type(4)));
typedef float f32x16 __attribute__((ext_vector_type(16)));
typedef unsigned u32x2 __attribute__((ext_vector_type(2)));
typedef unsigned u32x4 __attribute__((ext_vector_type(4)));
typedef __bf16 bf16x2_t __attribute__((ext_vector_type(2)));

constexpr int BATCH = 4, SEQ = 8192, DM = 1024, MROWS = BATCH * SEQ;
constexpr int FFN_H = 2816, FFN_U = 2 * FFN_H;
constexpr float EPS = 1e-6f, LOG2E = 1.4426950408889634f;
constexpr int NWAVES = 8, NTHREADS = NWAVES * 64;

constexpr size_t MiB = 1u << 20;
constexpr size_t WS_CTL = 0, CTL_ZERO_BYTES = 1 * MiB;
constexpr size_t WS_ROPE = 1 * MiB;
constexpr size_t WS_WT = 4 * MiB;
constexpr size_t WT_MIX = WS_WT, WT_UP = WS_WT + 16 * MiB, WT_DOWN = WS_WT + 28 * MiB;
constexpr size_t WS_XN = 40 * MiB;
constexpr size_t WS_S = 104 * MiB;
constexpr size_t WS_END = 512 * MiB;

DI unsigned pk2(float lo, float hi) { f32x2 v = {lo, hi}; bf16x2_t b = __builtin_convertvector(v, bf16x2_t); return __builtin_bit_cast(unsigned, b); }
DI float bflo(unsigned w) { return __uint_as_float(w << 16); }
DI float bfhi(unsigned w) { return __uint_as_float(w & 0xffff0000u); }
DI float bf2f(bf16 b) { return __uint_as_float((unsigned)b << 16); }
DI bf16 f2bf(float f) { return (bf16)(pk2(f, 0.f) & 0xffffu); }
DI float wave_sum(float v) {
#pragma unroll
    for (int o = 1; o < 64; o <<= 1) v += __shfl_xor(v, o);
    return v;
}
DI float fexp2(float x) { return __builtin_amdgcn_exp2f(x); }
DI float fexp(float x) { return __builtin_amdgcn_exp2f(x * LOG2E); }
DI float frcp(float x) { return __builtin_amdgcn_rcpf(x); }
DI float sigmoidf_(float x) { return frcp(1.f + fexp(-x)); }
DI float log_sigmoid_(float x) { return fminf(x, 0.f) - log1pf(expf(-fabsf(x))); }
DI int crow(int r, int hi) { return (r & 3) + 8 * (r >> 2) + 4 * hi; }
#define MFMA32(a, b, c) __builtin_amdgcn_mfma_f32_32x32x16_bf16((a), (b), (c), 0, 0, 0)

DI bf16x8 frag_row(const LAS bf16* base, int ld, int row0, int k0, int lane) {
    return *(const LAS bf16x8*)(base + (row0 + (lane & 31)) * ld + k0 + 8 * (lane >> 5));
}
typedef short v4i16_t __attribute__((ext_vector_type(4)));
DI s16x4 tr_rd(const LAS bf16* p) { return __builtin_bit_cast(s16x4, __builtin_amdgcn_ds_read_tr16_b64_v4i16((LAS v4i16_t*)p)); }
DI bf16x8 frag_tr(const LAS bf16* base, int ld, int k0, int n0, int lane) {
    const int g = lane >> 4, i = lane & 15, r = i >> 2, c = i & 3, h = lane >> 5;
    const LAS bf16* p = base + (k0 + 8 * h + r) * ld + n0 + 16 * (g & 1) + 4 * c;
    const s16x4 lo = tr_rd(p), hi = tr_rd(p + 4 * ld);
    return (bf16x8){lo[0], lo[1], lo[2], lo[3], hi[0], hi[1], hi[2], hi[3]};
}
DI bf16x8 gfrag_row(const bf16* base, int ld, int row0, int k0, int lane) {
    return *(const bf16x8*)(base + (size_t)(row0 + (lane & 31)) * ld + k0 + 8 * (lane >> 5));
}

namespace pg8 {
typedef unsigned short bf16_t;
constexpr int BM = 256, BK = 64, HALF = 128, HTB = HALF * BK * 2, STAGE_BYTES = 8 * HTB, NXCD = 8, WGM = 8;
__host__ __device__ __forceinline__ int lds_byte(int r, int c) { const int st = (r >> 4) * 2 + (c >> 5), rr = r & 15, cc = c & 31, ob = rr * 64 + cc * 2; return st * 1024 + (ob ^ (((ob >> 9) & 1) << 5)); }
__host__ __device__ __forceinline__ void stage_rc(int b, int& R, int& C) { const int st = b / 1024, sb = b % 1024, swz = sb ^ (((sb >> 9) & 1) << 5); R = (st >> 1) * 16 + swz / 64; C = (st & 1) * 32 + (swz % 64) / 2; }
__host__ __device__ __forceinline__ int perm32(int rho) { const int n = rho >> 4, i = rho & 15; return 8 * (i >> 2) + 4 * n + (i & 3); }

struct Unit { int pm, pn; };
struct Gemm { const bf16_t* A; const bf16_t* Bt; int M, N, K; int lda; int kpairA; };

struct StaticOrder {
    int nM, nN, nwg, G, c;
    __host__ __device__ void init(int M, int N, int G_, int c_) { nM = M / BM; nN = N / BM; nwg = nM * nN; G = G_; c = c_; }
    __host__ __device__ bool next(int i, Unit& u) const {
        const long L = (long)i * G + c; if (L >= nwg) return false;
        int wgid = (int)L; { const int q = nwg / NXCD, r = nwg % NXCD, xcd = wgid % NXCD, off = wgid / NXCD; wgid = (xcd < r ? xcd * (q + 1) : r * (q + 1) + (xcd - r) * q) + off; }
        const int nig = WGM * nN, gid = wgid / nig, fm = gid * WGM, gsz = (nM - fm) < WGM ? (nM - fm) : WGM;
        u.pm = fm + ((wgid % nig) % gsz); u.pn = (wgid % nig) / gsz; return true;
    }
};

DI void store8(bf16_t* p, f32x4 v0, f32x4 v1, float sc) {
    u32x4 w; w.x = pk2(v0[0] * sc, v0[1] * sc); w.y = pk2(v0[2] * sc, v0[3] * sc); w.z = pk2(v1[0] * sc, v1[1] * sc); w.w = pk2(v1[2] * sc, v1[3] * sc);
    *(u32x4*)p = w;
}
template <bool GATES> struct EpiSeg {
    static constexpr bool PERM = true;
    bf16_t *p0, *p1, *p2, *p3; int ld0, ld1, ld2, ld3; int e0, e1, e2; float s0, s1, s2, s3;
    float* gates; const float* gbias; int gblk;
    DI void operator()(const f32x4 (&acc)[2][2][4][2], const Unit& u, int wr, int wc, int fr, int fq) const {
        const int row0 = u.pm * BM + wr * 64 + fr;
#pragma unroll
        for (int bj = 0; bj < 2; ++bj) {
            const int blk = 2 * u.pn + bj;
            if (GATES && blk >= gblk) {
                if (blk == gblk && wc == 0) {
                    const f32x4 b0 = *(const f32x4*)(gbias + 8 * fq), b1 = *(const f32x4*)(gbias + 8 * fq + 4);
#pragma unroll
                    for (int ai = 0; ai < 2; ++ai)
#pragma unroll
                        for (int m = 0; m < 4; ++m) { float* gp = gates + (size_t)(row0 + ai * HALF + m * 16) * 32 + 8 * fq;
                            *(f32x4*)gp = acc[ai][bj][m][0] + b0; *(f32x4*)(gp + 4) = acc[ai][bj][m][1] + b1; }
                }
                continue;
            }
            bf16_t* base; int ld, b0; float sc;
            if (blk < e0) { base = p0; ld = ld0; b0 = 0; sc = s0; }
            else if (blk < e1) { base = p1; ld = ld1; b0 = e0; sc = s1; }
            else if (blk < e2) { base = p2; ld = ld2; b0 = e1; sc = s2; }
            else { base = p3; ld = ld3; b0 = e2; sc = s3; }
            bf16_t* cp = base + (blk - b0) * 128 + wc * 32 + 8 * fq;
#pragma unroll
            for (int ai = 0; ai < 2; ++ai)
#pragma unroll
                for (int m = 0; m < 4; ++m) store8(cp + (size_t)(row0 + ai * HALF + m * 16) * ld, acc[ai][bj][m][0], acc[ai][bj][m][1], sc);
        }
    }
};
DI EpiSeg<false> epi_plain(bf16_t* O, int ld, float sc) { EpiSeg<false> E{}; E.p0 = O; E.ld0 = ld; E.e0 = 100000; E.e1 = 100000; E.e2 = 100000; E.s0 = sc; return E; }
struct EpiMlaKV {
    static constexpr bool PERM = true;
    bf16_t* KF; bf16_t* V;
    DI void operator()(const f32x4 (&acc)[2][2][4][2], const Unit& u, int wr, int wc, int fr, int fq) const {
        const int row0 = u.pm * BM + wr * 64 + fr;
#pragma unroll
        for (int bj = 0; bj < 2; ++bj) {
            bf16_t* cp = (bj == 0 ? KF + u.pn * 192 : V + u.pn * 128) + wc * 32 + 8 * fq; const int ld = (bj == 0) ? 1536 : 1024;
#pragma unroll
            for (int ai = 0; ai < 2; ++ai)
#pragma unroll
                for (int m = 0; m < 4; ++m) store8(cp + (size_t)(row0 + ai * HALF + m * 16) * ld, acc[ai][bj][m][0], acc[ai][bj][m][1], 1.f);
        }
    }
};
struct EpiFfnUp {
    static constexpr bool PERM = true;
    bf16_t* U; bf16_t* HALO;
    DI void operator()(const f32x4 (&acc)[2][2][4][2], const Unit& u, int wr, int wc, int fr, int fq) const {
        const int row0 = u.pm * BM + wr * 64 + fr;
#pragma unroll
        for (int bj = 0; bj < 2; ++bj) {
            const int col = u.pn * 256 + bj * 128 + wc * 32 + 8 * fq;
#pragma unroll
            for (int ai = 0; ai < 2; ++ai)
#pragma unroll
                for (int m = 0; m < 4; ++m) {
                    const int row = row0 + ai * HALF + m * 16;
                    store8(U + (size_t)row * FFN_U + col, acc[ai][bj][m][0], acc[ai][bj][m][1], 1.f);
                    if (fr == 0 || fr == 15) store8(HALO + ((size_t)(row >> 4) * 2 + (fr == 15 ? 1 : 0)) * FFN_U + col, acc[ai][bj][m][0], acc[ai][bj][m][1], 1.f);
                }
        }
    }
};

template <class Epi>
DI void gemm_phase(LAS unsigned char* lds, const int tid, const Gemm g, const StaticOrder& S, const Epi& E) {
    const int wid = __builtin_amdgcn_readfirstlane(tid >> 6), lane = tid & 63, wr = wid >> 2, wc = wid & 3, fr = lane & 15, fq = lane >> 4;
    const int K = g.K; int nt = K / BK; asm volatile("" : "+s"(nt));
    unsigned voffA[2], voffB[2];
#pragma unroll
    for (int i = 0; i < 2; ++i) { int R, C; stage_rc(tid * 16 + i * 8192, R, C); const int Rb = Epi::PERM ? ((R & ~31) + perm32(R & 31)) : R;
        voffA[i] = (unsigned)(R * g.lda + C) * 2u; voffB[i] = (unsigned)(Rb * K + C) * 2u; }
    const size_t kstep = (size_t)(BK * 2);
    const size_t kpairA = (size_t)g.kpairA;
    const size_t hstepA = (size_t)HALF * g.lda * 2, hstepB = (size_t)HALF * K * 2;
    const size_t tstepA = 2 * hstepA, tstepB = 2 * hstepB;
    const unsigned ldsw = (unsigned)wid * 1024u;
    const int aoff = lds_byte(wr * 64 + fr, fq * 8), boff = lds_byte(wc * 32 + fr, fq * 8);
#define PG8_SA(b, h) (((b) * 2 + (h)) * HTB)
#define PG8_SB(b, h) ((4 + (b) * 2 + (h)) * HTB)
#define PG8_STAGE(bufoff, gbase, voff) do { _Pragma("unroll") for (int _i = 0; _i < 2; ++_i) \
        __builtin_amdgcn_global_load_lds((const unsigned*)((const char*)(gbase) + (voff)[_i]), (LAS unsigned*)(lds + (bufoff) + ldsw + _i * 8192), 16, 0, 0); } while (0)
#define PG8_LDA(dst, b, h) do { _Pragma("unroll") for (int m = 0; m < 4; ++m) _Pragma("unroll") for (int k = 0; k < 2; ++k) dst[m][k] = *(const LAS bf16x8*)(lds + PG8_SA(b, h) + aoff + m * 2048 + k * 1024); } while (0)
#define PG8_LDB(dst, b, h) do { _Pragma("unroll") for (int n = 0; n < 2; ++n) _Pragma("unroll") for (int k = 0; k < 2; ++k) dst[n][k] = *(const LAS bf16x8*)(lds + PG8_SB(b, h) + boff + n * 2048 + k * 1024); } while (0)
#define PG8_MMA(ai, bj, At, Bt) do { __builtin_amdgcn_s_setprio(1); _Pragma("unroll") for (int m = 0; m < 4; ++m) _Pragma("unroll") for (int n = 0; n < 2; ++n) _Pragma("unroll") for (int k = 0; k < 2; ++k) \
        acc[ai][bj][m][n] = __builtin_amdgcn_mfma_f32_16x16x32_bf16(Bt[n][k], At[m][k], acc[ai][bj][m][n], 0, 0, 0); __builtin_amdgcn_s_setprio(0); } while (0)
#define PG8_WAIT_V(n) asm volatile("s_waitcnt vmcnt(" #n ")" ::: "memory")
#define PG8_WAIT_L(n) asm volatile("s_waitcnt lgkmcnt(" #n ")" ::: "memory")
#define PG8_BAR __builtin_amdgcn_s_barrier()
#define PG8_SCHED __builtin_amdgcn_sched_barrier(0)
    Unit cur, nxt; int ui = 0;
    if (!S.next(0, cur)) return;
    f32x4 acc[2][2][4][2];
#pragma unroll
    for (int a = 0; a < 2; ++a)
#pragma unroll
        for (int b = 0; b < 2; ++b)
#pragma unroll
            for (int m = 0; m < 4; ++m)
#pragma unroll
                for (int n = 0; n < 2; ++n) acc[a][b][m][n] = (f32x4){0.f, 0.f, 0.f, 0.f};
    bf16x8 At[4][2], B0[2][2], B1[2][2];
    const char* cA = (const char*)g.A + (size_t)cur.pm * tstepA; const char* cB = (const char*)g.Bt + (size_t)cur.pn * tstepB;
    PG8_STAGE(PG8_SB(0, 0), cB, voffB); PG8_STAGE(PG8_SB(0, 1), cB + hstepB, voffB); PG8_STAGE(PG8_SA(0, 0), cA, voffA); PG8_STAGE(PG8_SA(0, 1), cA + hstepA, voffA);
    if (wr == 1) PG8_BAR;
    PG8_WAIT_V(2); PG8_BAR;
    PG8_STAGE(PG8_SB(1, 0), cB + kstep, voffB); PG8_STAGE(PG8_SA(1, 0), cA + kstep, voffA); PG8_STAGE(PG8_SB(1, 1), cB + hstepB + kstep, voffB);
    PG8_WAIT_V(6); PG8_BAR;
    for (;;) {
        const bool has_next = S.next(ui + 1, nxt);
        const char* nA = has_next ? (const char*)g.A + (size_t)nxt.pm * tstepA : cA; const char* nB = has_next ? (const char*)g.Bt + (size_t)nxt.pn * tstepB : cB;
#pragma unroll 1
        for (int t = 0; t < nt; t += 2) {
            const bool last = (t == nt - 2);
            const char* a1 = cA + (size_t)(t >> 1) * kpairA + kstep;
            const char* a2 = last ? nA : cA + (size_t)((t >> 1) + 1) * kpairA; const char* b2 = last ? nB : cB + (size_t)(t + 2) * kstep;
            const char* a3 = a2 + kstep; const char* b3 = b2 + kstep;
            PG8_LDB(B0, 0, 0); PG8_LDB(B1, 0, 1); PG8_SCHED; PG8_LDA(At, 0, 0); PG8_STAGE(PG8_SA(1, 1), a1 + hstepA, voffA);
            PG8_WAIT_V(8); PG8_WAIT_L(0); PG8_BAR; PG8_MMA(0, 0, At, B0); PG8_MMA(0, 1, At, B1); PG8_BAR; PG8_SCHED;
            PG8_LDA(At, 0, 1); PG8_STAGE(PG8_SB(0, 0), b2, voffB); PG8_STAGE(PG8_SB(0, 1), b2 + hstepB, voffB); PG8_STAGE(PG8_SA(0, 0), a2, voffA);
            PG8_WAIT_V(8); PG8_WAIT_L(0); PG8_BAR; PG8_MMA(1, 0, At, B0); PG8_MMA(1, 1, At, B1); PG8_BAR; PG8_SCHED;
            PG8_LDB(B0, 1, 0); PG8_LDB(B1, 1, 1); PG8_SCHED; PG8_LDA(At, 1, 0); PG8_STAGE(PG8_SA(0, 1), a2 + hstepA, voffA);
            PG8_WAIT_V(8); PG8_WAIT_L(0); PG8_BAR; PG8_MMA(0, 0, At, B0); PG8_MMA(0, 1, At, B1); PG8_BAR; PG8_SCHED;
            PG8_LDA(At, 1, 1); PG8_STAGE(PG8_SB(1, 0), b3, voffB); PG8_STAGE(PG8_SB(1, 1), b3 + hstepB, voffB); PG8_STAGE(PG8_SA(1, 0), a3, voffA);
            PG8_WAIT_V(8); PG8_WAIT_L(0); PG8_BAR; PG8_MMA(1, 0, At, B0); PG8_MMA(1, 1, At, B1); PG8_BAR; PG8_SCHED;
        }
        if (wr == 0) PG8_BAR;
        E(acc, cur, wr, wc, fr, fq);
        if (!has_next) break;
#pragma unroll
        for (int a = 0; a < 2; ++a)
#pragma unroll
            for (int b = 0; b < 2; ++b)
#pragma unroll
                for (int m = 0; m < 4; ++m)
#pragma unroll
                    for (int n = 0; n < 2; ++n) acc[a][b][m][n] = (f32x4){0.f, 0.f, 0.f, 0.f};
        cur = nxt; cA = nA; cB = nB; ++ui;
        if (wr == 1) PG8_BAR;
    }
    PG8_WAIT_V(0);
    PG8_BAR;
#undef PG8_SA
#undef PG8_SB
#undef PG8_STAGE
#undef PG8_LDA
#undef PG8_LDB
#undef PG8_MMA
#undef PG8_WAIT_V
#undef PG8_WAIT_L
#undef PG8_BAR
#undef PG8_SCHED
}
}

namespace att {
constexpr int NW = 8, QBLK = 32, KVBLK = 64, DV = 128;
constexpr float THR2 = 8.f;
#define SBAR() __builtin_amdgcn_sched_barrier(0)
DI unsigned cvtpk(float lo, float hi) { unsigned r; asm volatile("v_cvt_pk_bf16_f32 %0, %1, %2" : "=v"(r) : "v"(lo), "v"(hi)); return r; }
DI void partialSM(f32x16& p0, f32x16& p1, float& m_reg, float& mn, float& alpha) {
    float pmax = p0[0];
#pragma unroll
    for (int r = 1; r < 16; ++r) pmax = fmaxf(pmax, p0[r]);
#pragma unroll
    for (int r = 0; r < 16; ++r) pmax = fmaxf(pmax, p1[r]);
    { auto rr = __builtin_amdgcn_permlane32_swap(__float_as_uint(pmax), __float_as_uint(pmax), false, false);
      pmax = fmaxf(__uint_as_float(rr[0]), __uint_as_float(rr[1])); }
    if (__builtin_expect(__all(pmax - m_reg <= THR2), 1)) { mn = m_reg; alpha = 1.f; }
    else { mn = fmaxf(m_reg, pmax); alpha = __builtin_amdgcn_exp2f(m_reg - mn); m_reg = mn; }
#pragma unroll
    for (int r = 0; r < 16; ++r) p0[r] = p0[r] - mn;
#pragma unroll
    for (int r = 0; r < 16; ++r) p1[r] = p1[r] - mn;
#pragma unroll
    for (int r = 0; r < 16; ++r) p0[r] = __builtin_amdgcn_exp2f(p0[r]);
}
DI void finishSM(f32x16& p0, f32x16& p1, float alpha, float& l_reg, bf16x8& pa0, bf16x8& pa1, bf16x8& pa2, bf16x8& pa3) {
#pragma unroll
    for (int r = 0; r < 16; ++r) p1[r] = __builtin_amdgcn_exp2f(p1[r]);
    float ps = 0;
#pragma unroll
    for (int r = 0; r < 16; ++r) ps += p0[r];
#pragma unroll
    for (int r = 0; r < 16; ++r) ps += p1[r];
    { auto rr = __builtin_amdgcn_permlane32_swap(__float_as_uint(ps), __float_as_uint(ps), false, false);
      ps = __uint_as_float(rr[0]) + __uint_as_float(rr[1]); }
    l_reg = l_reg * alpha + ps;
#define PK4(P, BASE, OUT) do { unsigned a0 = cvtpk(P[BASE + 0], P[BASE + 1]), a1 = cvtpk(P[BASE + 2], P[BASE + 3]);   \
    unsigned b0 = cvtpk(P[BASE + 4], P[BASE + 5]), b1 = cvtpk(P[BASE + 6], P[BASE + 7]);                              \
    auto r0 = __builtin_amdgcn_permlane32_swap(a0, b0, false, false); auto r1 = __builtin_amdgcn_permlane32_swap(a1, b1, false, false); \
    u32x4 w = {r0[0], r1[0], r0[1], r1[1]}; OUT = *reinterpret_cast<bf16x8*>(&w); } while (0)
    PK4(p0, 0, pa0); PK4(p0, 8, pa1); PK4(p1, 0, pa2); PK4(p1, 8, pa3);
#undef PK4
}
DI int v_st(int k, int c) { const int kk = (k & ~0xC) | ((k & 4) << 1) | ((k & 8) >> 1); return ((kk >> 3) * 4 + (c >> 5)) * 512 + ((kk & 7) * 32 + (c & 31)) * 2; }
DI int v_rd_base(int lane) { return ((lane & 3) << 3) | (((lane >> 2) & 3) << 6) | (((lane >> 4) & 1) << 5) | (((lane >> 5) & 1) << 8); }
constexpr int v_rd_off(int d0, int ks, int half) { return d0 * 512 + ks * 4096 + half * 2048; }
template <int OFF> DI s16x4 tr_read(int vb) {
    s16x4 r; asm volatile("ds_read_b64_tr_b16 %0, %1 offset:%2" : "=&v"(r) : "v"(vb), "i"(OFF) : "memory"); return r;
}
template <int D0> DI void pv_one(f32x16& od, int vb, bf16x8 pa0, bf16x8 pa1, bf16x8 pa2, bf16x8 pa3) {
    const s16x4 l0 = tr_read<v_rd_off(D0, 0, 0)>(vb), h0 = tr_read<v_rd_off(D0, 0, 1)>(vb), l1 = tr_read<v_rd_off(D0, 1, 0)>(vb), h1 = tr_read<v_rd_off(D0, 1, 1)>(vb);
    const s16x4 l2 = tr_read<v_rd_off(D0, 2, 0)>(vb), h2 = tr_read<v_rd_off(D0, 2, 1)>(vb), l3 = tr_read<v_rd_off(D0, 3, 0)>(vb), h3 = tr_read<v_rd_off(D0, 3, 1)>(vb);
    asm volatile("s_waitcnt lgkmcnt(0)" ::: "memory"); SBAR();
#define PK(L, H) (bf16x8){L[0], L[1], L[2], L[3], H[0], H[1], H[2], H[3]}
    od = MFMA32(pa0, PK(l0, h0), od);
    od = MFMA32(pa1, PK(l1, h1), od);
    od = MFMA32(pa2, PK(l2, h2), od);
    od = MFMA32(pa3, PK(l3, h3), od);
#undef PK
}
DI void pv_d0(f32x16* o, int vb, bf16x8 pa0, bf16x8 pa1, bf16x8 pa2, bf16x8 pa3) {
    pv_one<0>(o[0], vb, pa0, pa1, pa2, pa3); pv_one<1>(o[1], vb, pa0, pa1, pa2, pa3); pv_one<2>(o[2], vb, pa0, pa1, pa2, pa3); pv_one<3>(o[3], vb, pa0, pa1, pa2, pa3);
}

template <int DQK> struct Cfg {
    static constexpr int KROWB = DQK * 2 + 16;
    static constexpr int SHM_V = KVBLK * DV * 2, SHM_K = KVBLK * KROWB;
    static constexpr int SHM = 2 * SHM_V + 2 * SHM_K + NW * 64 * 4;
    static constexpr int NKC = DQK / 64;
    static constexpr int CPR = DQK / 8;
};
template <int DQK, bool ALIBI, bool ROPE, int ldq, int ldk, int ldv, int ldo>
DI void attn_unit(const bf16* __restrict__ Qb, const bf16* __restrict__ Kh, const bf16* __restrict__ Vh,
                  bf16* __restrict__ Ob, int seq, float slope2, int qpos0, const float* __restrict__ rope, char* lds, const int tid, const float kmax) {
    using C = Cfg<DQK>;
    constexpr int ND = DQK / 16;
    const int wid = tid >> 6, lane = tid & 63, r32 = lane & 31, hi = lane >> 5;
    char* V_lds = lds; char* K_lds = lds + 2 * C::SHM_V;
    float* ws = (float*)(lds + 2 * C::SHM_V + 2 * C::SHM_K) + wid * 64; float* li_l = ws; float* al_l = ws + 32;
    float m_reg = -1e30f, l_reg = 0; f32x16 o[4] = {}; bf16x8 qr[ND];
    const bf16* Qw = Qb + (long)(wid * QBLK + r32) * ldq + hi * 8;
#pragma unroll
    for (int d0 = 0; d0 < ND; ++d0) qr[d0] = *reinterpret_cast<const bf16x8*>(Qw + d0 * 16);
    if (ROPE) {
        const float* rp = rope + (size_t)(qpos0 + wid * QBLK + r32) * 64;
#pragma unroll
        for (int d0 = ND - 4; d0 < ND; ++d0) {
            const f32x4 c0 = *(const f32x4*)(rp + (8 * (d0 - (ND - 4)) + 4 * hi) * 2), c1 = *(const f32x4*)(rp + (8 * (d0 - (ND - 4)) + 4 * hi) * 2 + 4);
            const u32x4 w = __builtin_bit_cast(u32x4, qr[d0]); u32x4 o_;
            { const float a = bflo(w[0]), b = bfhi(w[0]); o_[0] = pk2(a * c0[0] - b * c0[1], a * c0[1] + b * c0[0]); }
            { const float a = bflo(w[1]), b = bfhi(w[1]); o_[1] = pk2(a * c0[2] - b * c0[3], a * c0[3] + b * c0[2]); }
            { const float a = bflo(w[2]), b = bfhi(w[2]); o_[2] = pk2(a * c1[0] - b * c1[1], a * c1[1] + b * c1[0]); }
            { const float a = bflo(w[3]), b = bfhi(w[3]); o_[3] = pk2(a * c1[2] - b * c1[3], a * c1[3] + b * c1[2]); }
            qr[d0] = __builtin_bit_cast(bf16x8, o_);
        }
    }
    const int sr = tid >> 4, sc = (tid & 15) * 8, vst0 = v_st(sr, sc), vst1 = v_st(32 + sr, sc);
    int krow[C::NKC], kcol[C::NKC], kdst[C::NKC];
#pragma unroll
    for (int i = 0; i < C::NKC; ++i) { const int c = tid + 512 * i; krow[i] = c / C::CPR; kcol[i] = (c % C::CPR) * 8; kdst[i] = krow[i] * C::KROWB + kcol[i] * 2; }
    const int vb0 = (int)(uintptr_t)V_lds + v_rd_base(lane);
    const float qposh = (float)(qpos0 + wid * QBLK + r32 - 4 * hi);
    struct { bf16x8 vs0, vs1, ks[C::NKC]; } st_;
#define SLOAD(k0) do { st_.vs0 = *reinterpret_cast<const bf16x8*>(&Vh[(long)((k0) + sr) * ldv + sc]); st_.vs1 = *reinterpret_cast<const bf16x8*>(&Vh[(long)((k0) + 32 + sr) * ldv + sc]); \
    _Pragma("unroll") for (int i_ = 0; i_ < C::NKC; ++i_) st_.ks[i_] = *reinterpret_cast<const bf16x8*>(&Kh[(long)((k0) + krow[i_]) * ldk + kcol[i_]]); } while (0)
#define SWRITE(b) do { *(bf16x8*)(V_lds + (b) * C::SHM_V + vst0) = st_.vs0; *(bf16x8*)(V_lds + (b) * C::SHM_V + vst1) = st_.vs1; \
    _Pragma("unroll") for (int i_ = 0; i_ < C::NKC; ++i_) *(bf16x8*)(K_lds + (b) * C::SHM_K + kdst[i_]) = st_.ks[i_]; } while (0)
#define SWAIT() asm volatile("s_waitcnt vmcnt(0)" ::: "memory")
#define RESC(a) do { if (__any((a) < 1.f)) { if (hi == 0) al_l[r32] = (a); asm volatile("s_waitcnt lgkmcnt(0)" ::: "memory"); \
    _Pragma("unroll") for (int d = 0; d < 4; ++d) _Pragma("unroll") for (int r = 0; r < 16; ++r) o[d][r] *= al_l[crow(r, hi)]; } } while (0)
#define QKT(P0, P1, KB, k0) do { P0 = f32x16{}; P1 = f32x16{}; \
    _Pragma("unroll") for (int d0 = 0; d0 < ND; ++d0) { const int cb = (d0 * 16 + hi * 8) * 2; \
        const bf16x8 b0_ = *reinterpret_cast<const bf16x8*>((KB) + r32 * C::KROWB + cb); \
        const bf16x8 b1_ = *reinterpret_cast<const bf16x8*>((KB) + (32 + r32) * C::KROWB + cb); \
        P0 = MFMA32(b0_, qr[d0], P0); P1 = MFMA32(b1_, qr[d0], P1); } \
    if (ALIBI) { const float kb_ = qposh - (float)(k0); \
        _Pragma("unroll") for (int r = 0; r < 16; ++r) { const float d_ = kb_ - (float)((r & 3) + 8 * (r >> 2)); P0[r] -= slope2 * fabsf(d_); P1[r] -= slope2 * fabsf(d_ - 32.f); } } } while (0)
    f32x16 pA0, pA1; float mnA, alA; bf16x8 pa0, pa1, pa2, pa3; int NT = seq / KVBLK; int jlo = 0;
    if (ALIBI) {
        float sq = 0.f;
#pragma unroll
        for (int d0 = 0; d0 < ND; ++d0) { const u32x4 w = __builtin_bit_cast(u32x4, qr[d0]);
#pragma unroll
            for (int q4 = 0; q4 < 4; ++q4) sq += bflo(w[q4]) * bflo(w[q4]) + bfhi(w[q4]) * bfhi(w[q4]); }
        sq += __shfl_xor(sq, 32);
#pragma unroll
        for (int o_ = 1; o_ < 32; o_ <<= 1) sq = fmaxf(sq, __shfl_xor(sq, o_));
        if (lane == 0) ws[63] = sq;
        __syncthreads();
        float qm = 0.f;
#pragma unroll
        for (int w_ = 0; w_ < NW; ++w_) qm = fmaxf(qm, ((const float*)(lds + 2 * C::SHM_V + 2 * C::SHM_K))[w_ * 64 + 63]);
        const float bound = 2.f * sqrtf(qm) * kmax * 1.01f + 40.f;
        const float dc = fminf(bound / slope2, 16384.f);
        const int dcut = (int)dc + 1;
        const int a_ = qpos0 - dcut; jlo = a_ > 0 ? (a_ >> 6) : 0;
        const int b_ = (qpos0 + QBLK * NW - 1 + dcut) >> 6; NT = b_ + 1 < NT ? b_ + 1 : NT;
    }
    SLOAD(jlo * KVBLK); SWAIT(); SWRITE(0); __syncthreads();
#pragma unroll 1
    for (int j = jlo; j < NT; ++j) {
        const int bsel = (j - jlo) & 1;
        if (j + 1 < NT) SLOAD((j + 1) * KVBLK);
        SBAR(); QKT(pA0, pA1, K_lds + bsel * C::SHM_K, j * KVBLK);
        partialSM(pA0, pA1, m_reg, mnA, alA);
        RESC(alA);
        finishSM(pA0, pA1, alA, l_reg, pa0, pa1, pa2, pa3); SBAR();
        pv_d0(o, vb0 + bsel * C::SHM_V, pa0, pa1, pa2, pa3);
        if (j + 1 < NT) { SWAIT(); SWRITE(bsel ^ 1); }
        __syncthreads();
    }
    if (hi == 0) li_l[r32] = l_reg; asm volatile("s_waitcnt lgkmcnt(0)" ::: "memory");
    float rli[16];
#pragma unroll
    for (int r = 0; r < 16; ++r) rli[r] = __builtin_amdgcn_rcpf(li_l[crow(r, hi)]);
    bf16* Ow = Ob + (long)(wid * QBLK) * ldo;
#pragma unroll
    for (int r = 0; r < 16; ++r) { const int orow = crow(r, hi);
#pragma unroll
        for (int d0 = 0; d0 < 4; ++d0) Ow[(long)orow * ldo + d0 * 32 + r32] = f2bf(o[d0][r] * rli[r]); }
    __syncthreads();
#undef SLOAD
#undef SWRITE
#undef SWAIT
#undef RESC
#undef QKT
}
#undef SBAR
}

#define XB_TMO      128
#define XB_XCNT(j)  (256  + 64 * (j))
#define XB_XSUB(j)  (1280 + 64 * (j))
#define XB_XGEN(j)  (2304 + 64 * (j))
#define XB_TOP      3328
#define XB_TOPGEN   3392
#define XCD_BAR_WORDS 3456
#define XB_SPIN_CAP (1u << 18)
DI unsigned xb_ld(unsigned* p)              { return __hip_atomic_load(p, __ATOMIC_RELAXED, __HIP_MEMORY_SCOPE_AGENT); }
DI unsigned xb_add(unsigned* p, unsigned v) { return __hip_atomic_fetch_add(p, v, __ATOMIC_RELAXED, __HIP_MEMORY_SCOPE_AGENT); }
DI unsigned xb_xcc_id() { return (unsigned)__builtin_amdgcn_s_getreg((3 << 11) | 20) & 0xFu; }
#define XB_SPIN(cond, bar) do { unsigned _sp = 0; while (cond) { __builtin_amdgcn_s_sleep(1); \
    if ((++_sp & 255u) == 0u) { if (xb_ld(&(bar)[XB_TMO])) break; if (_sp > XB_SPIN_CAP) { atomicAdd(&(bar)[XB_TMO], 1u); break; } } } } while (0)
struct XcdBarrier { unsigned* bar; unsigned x; volatile LAS unsigned* st; };
DI XcdBarrier xcd_barrier_post(unsigned* bar, volatile LAS unsigned* st) {
    XcdBarrier b; b.bar = bar; b.x = xb_xcc_id(); b.st = st;
    if (threadIdx.x == 0) (void)xb_add(&bar[XB_XCNT(b.x)], 1u);
    return b;
}
DI void xcd_barrier_complete(unsigned* bar, unsigned x, unsigned& nloc, unsigned& nx) {
    const unsigned G = gridDim.x * gridDim.y * gridDim.z;
    unsigned sum, cnt, mine, sp = 0u;
    for (;;) {
        sum = 0u; cnt = 0u; mine = 0u;
#pragma unroll
        for (unsigned j = 0; j < 16; ++j) { const unsigned c = xb_ld(&bar[XB_XCNT(j)]); sum += c; cnt += (c > 0u) ? 1u : 0u; mine = (j == x) ? c : mine; }
        if (sum == G) break;
        __builtin_amdgcn_s_sleep(1);
        if ((++sp & 255u) == 0u) { if (xb_ld(&bar[XB_TMO])) break; if (sp > XB_SPIN_CAP) { atomicAdd(&bar[XB_TMO], 1u); break; } }
    }
    nloc = mine > 0u ? mine : 1u; nx = cnt > 0u ? cnt : 1u;
}
DI void xcd_barrier(const XcdBarrier& b) {
    asm volatile("s_waitcnt vmcnt(0)" ::: "memory");
    __syncthreads();
    if (threadIdx.x == 0) {
        unsigned* bar = b.bar;
        __builtin_amdgcn_s_waitcnt(0);
        unsigned nloc = b.st[0], nx = b.st[1];
        if (nloc == 0u) { xcd_barrier_complete(bar, b.x, nloc, nx); b.st[0] = nloc; b.st[1] = nx; }
        const unsigned old = xb_add(&bar[XB_XSUB(b.x)], 1u);
        const unsigned gen = old / nloc;
        if (old + 1u == (gen + 1u) * nloc) {
            __builtin_amdgcn_fence(__ATOMIC_RELEASE, "agent");
            asm volatile("s_waitcnt vmcnt(0)" ::: "memory");
            const unsigned og = xb_add(&bar[XB_TOP], 1u);
            const unsigned tg = og / nx;
            if (og + 1u == (tg + 1u) * nx) xb_add(&bar[XB_TOPGEN], 1u);
            else XB_SPIN(xb_ld(&bar[XB_TOPGEN]) == tg, bar);
            __builtin_amdgcn_fence(__ATOMIC_ACQUIRE, "agent");
            xb_add(&bar[XB_XGEN(b.x)], 1u);
            asm volatile("s_waitcnt vmcnt(0)" ::: "memory");
        } else {
            XB_SPIN(xb_ld(&bar[XB_XGEN(b.x)]) == gen, bar);
            __builtin_amdgcn_fence(__ATOMIC_ACQUIRE, "agent");
            asm volatile("s_waitcnt vmcnt(0)" ::: "memory");
        }
    }
    __syncthreads();
}

constexpr int RING_BYTES = 131072;
constexpr int LDSCTL_OFF = RING_BYTES, MISC_OFF = LDSCTL_OFF + 320;
constexpr int LDS_BYTES = 147456;

struct Ctx { LAS unsigned char* lds; int tid, lane, wave, G, bx, gw, NGW; };

enum { MAP_ID = 0, MAP_ROPEQ = 1, MAP_FFNUP = 2 };
DI int map_row(int kind, int n) {
    if (kind == MAP_ROPEQ) { const int h = n / 192, r = n % 192; if (r < 128) return n; const int i = r - 128; return h * 192 + 128 + ((i < 32) ? 2 * i : 2 * (i - 32) + 1); }
    if (kind == MAP_FFNUP) { if (n < FFN_H) return (n >> 7) * 256 + (n & 127); const int c = n - FFN_H; return (c >> 7) * 256 + 128 + (c & 127); }
    return n;
}
DI void transpose_item(const float* W, int K, int N, bf16* WT, int kind, int row_off, LAS float* scr, int item, int lane) {
    const int nblk = N / 32, kb = item / nblk, nb = item % nblk, k0 = 64 * kb, n0 = 32 * nb;
#pragma unroll 8
    for (int i = 0; i < 32; ++i) { const int kk = 2 * i + (lane >> 5); scr[kk * 33 + (lane & 31)] = W[(size_t)(k0 + kk) * N + n0 + (lane & 31)]; }
    asm volatile("s_waitcnt lgkmcnt(0)" ::: "memory");
    const int c = lane & 7;
#pragma unroll
    for (int j = 0; j < 4; ++j) { const int n = (lane >> 3) + 8 * j; const LAS float* s = scr + (8 * c) * 33 + n;
        u32x4 o; o.x = pk2(s[0 * 33], s[1 * 33]); o.y = pk2(s[2 * 33], s[3 * 33]); o.z = pk2(s[4 * 33], s[5 * 33]); o.w = pk2(s[6 * 33], s[7 * 33]);
        *(u32x4*)(WT + (size_t)(row_off + map_row(kind, n0 + n)) * K + k0 + 8 * c) = o; }
    asm volatile("s_waitcnt lgkmcnt(0)" ::: "memory");
}
struct TJob { const float* W; int K, N; bf16* WT; int kind, row_off; };
template <int NJ> DI void run_transposes(const Ctx& c, const TJob (&jobs)[NJ]) {
    LAS float* scr = (LAS float*)(c.lds + c.wave * 16384);
    int total = 0;
#pragma unroll
    for (int j = 0; j < NJ; ++j) total += (jobs[j].K / 64) * (jobs[j].N / 32);
    for (int it = c.gw; it < total; it += c.NGW) {
        int r = it;
#pragma unroll
        for (int j = 0; j < NJ; ++j) { const int n = (jobs[j].K / 64) * (jobs[j].N / 32);
            if (r >= 0 && r < n) transpose_item(jobs[j].W, jobs[j].K, jobs[j].N, jobs[j].WT, jobs[j].kind, jobs[j].row_off, scr, r, c.lane);
            r -= n; }
    }
}
DI void zero_rows(const Ctx& c, bf16* WT, int K, int row0, int nrows) {
    for (int r = c.gw; r < nrows; r += c.NGW) { u32x4* p = (u32x4*)(WT + (size_t)(row0 + r) * K);
        for (int i = c.lane; i < K / 8; i += 64) p[i] = (u32x4){0u, 0u, 0u, 0u}; }
}

DI void load_row_f32(const float* row, int lane, f32x4 (&v)[4]) {
#pragma unroll
    for (int j = 0; j < 4; ++j) v[j] = *((const f32x4*)row + lane + 64 * j);
}
DI void load_row_bf16(const bf16* row, int lane, f32x4 (&v)[4]) {
#pragma unroll
    for (int j = 0; j < 4; ++j) { const u32x2 w = *((const u32x2*)row + lane + 64 * j); v[j] = (f32x4){bflo(w.x), bfhi(w.x), bflo(w.y), bfhi(w.y)}; }
}
DI void store_row_bf16(bf16* row, int lane, const f32x4 (&v)[4]) {
#pragma unroll
    for (int j = 0; j < 4; ++j) { u32x2 w; w.x = pk2(v[j][0], v[j][1]); w.y = pk2(v[j][2], v[j][3]); *((u32x2*)row + lane + 64 * j) = w; }
}
DI float sumsq4(const f32x4 (&v)[4]) { float s = 0.f;
#pragma unroll
    for (int j = 0; j < 4; ++j) s += (v[j][0] * v[j][0] + v[j][1] * v[j][1]) + (v[j][2] * v[j][2] + v[j][3] * v[j][3]);
    return s; }
DI void pass_norm0(const Ctx& c, const float* x, const float* g, bf16* XN) {
    f32x4 gv[4]; load_row_f32(g, c.lane, gv);
    for (int m = c.gw; m < MROWS; m += c.NGW) {
        f32x4 v[4]; load_row_f32(x + (size_t)m * DM, c.lane, v);
        const float rstd = rsqrtf(wave_sum(sumsq4(v)) * (1.f / DM) + EPS);
#pragma unroll
        for (int j = 0; j < 4; ++j) v[j] = v[j] * rstd * gv[j];
        store_row_bf16(XN + (size_t)m * DM, c.lane, v);
    }
}
DI void pass_res_norm(const Ctx& c, const bf16* a, const float* base, const float* g1, const float* g2, float* out, bf16* XN) {
    f32x4 g1v[4], g2v[4]; load_row_f32(g1, c.lane, g1v);
    if (XN) load_row_f32(g2, c.lane, g2v);
    for (int m = c.gw; m < MROWS; m += c.NGW) {
        f32x4 v[4], b[4]; load_row_bf16(a + (size_t)m * DM, c.lane, v); load_row_f32(base + (size_t)m * DM, c.lane, b);
        const float rstd = rsqrtf(wave_sum(sumsq4(v)) * (1.f / DM) + EPS);
#pragma unroll
        for (int j = 0; j < 4; ++j) { b[j] = b[j] + v[j] * rstd * g1v[j]; *((f32x4*)(out + (size_t)m * DM) + c.lane + 64 * j) = b[j]; }
        if (XN) {
            const float rstd2 = rsqrtf(wave_sum(sumsq4(b)) * (1.f / DM) + EPS);
#pragma unroll
            for (int j = 0; j < 4; ++j) b[j] = b[j] * rstd2 * g2v[j];
            store_row_bf16(XN + (size_t)m * DM, c.lane, b);
        }
    }
}

__device__ const double ROPE_INV[32] = {
    1.0, 0.7498942093324559, 0.5623413251903491, 0.4216965034285822, 0.31622776601683794, 0.23713737056616552, 0.1778279410038923, 0.1333521432163324,
    0.1, 0.07498942093324558, 0.05623413251903491, 0.042169650342858224, 0.03162277660168379, 0.023713737056616554, 0.01778279410038923, 0.01333521432163324,
    0.01, 0.007498942093324558, 0.005623413251903491, 0.004216965034285823, 0.0031622776601683794, 0.0023713737056616554, 0.0017782794100389228, 0.001333521432163324,
    0.001, 0.0007498942093324559, 0.0005623413251903491, 0.00042169650342858224, 0.00031622776601683794, 0.00023713737056616554, 0.00017782794100389227, 0.0001333521432163324};
DI void fill_rope(const Ctx& c, float* rope) {
    for (int i = c.bx * NTHREADS + c.tid; i < SEQ * 32; i += c.G * NTHREADS) {
        const int pos = i >> 5, k = i & 31;
        const double t = (double)pos * ROPE_INV[k] * 0.15915494309189535;
        const float fr = (float)(t - (double)(long long)t);
        rope[2 * i] = __builtin_amdgcn_cosf(fr); rope[2 * i + 1] = __builtin_amdgcn_sinf(fr);
    }
}
DI void pass_mla_mid(const Ctx& c, const bf16* DQKV, const float* gq, const float* gkv, const float* rope, bf16* CQ, bf16* CKV, bf16* KF) {
    float gqv[6], gkvv[4];
#pragma unroll
    for (int i = 0; i < 6; ++i) gqv[i] = gq[c.lane + 64 * i];
#pragma unroll
    for (int i = 0; i < 4; ++i) gkvv[i] = gkv[c.lane + 64 * i];
    for (int m = c.gw; m < MROWS; m += c.NGW) {
        const bf16* row = DQKV + (size_t)m * 768;
        float xq[6], xk[4]; float sq = 0.f, sk = 0.f;
#pragma unroll
        for (int i = 0; i < 6; ++i) { xq[i] = bf2f(row[c.lane + 64 * i]); sq += xq[i] * xq[i]; }
#pragma unroll
        for (int i = 0; i < 4; ++i) { xk[i] = bf2f(row[384 + c.lane + 64 * i]); sk += xk[i] * xk[i]; }
        const float rq = rsqrtf(wave_sum(sq) * (1.f / 384.f) + EPS), rk = rsqrtf(wave_sum(sk) * (1.f / 256.f) + EPS);
#pragma unroll
        for (int i = 0; i < 6; ++i) CQ[(size_t)m * 384 + c.lane + 64 * i] = f2bf(xq[i] * rq * gqv[i]);
#pragma unroll
        for (int i = 0; i < 4; ++i) CKV[(size_t)m * 256 + c.lane + 64 * i] = f2bf(xk[i] * rk * gkvv[i]);
        const int i = c.lane & 31; const float x1 = bf2f(row[640 + i]), x2 = bf2f(row[672 + i]);
        const float* rp = rope + ((size_t)(m & (SEQ - 1)) * 32 + i) * 2; const float cs = rp[0], sn = rp[1];
        const float ov = (c.lane < 32) ? (x1 * cs - x2 * sn) : (x1 * sn + x2 * cs);
        const bf16 ob = f2bf(ov); const int idx = 2 * i + (c.lane >> 5);
#pragma unroll
        for (int h = 0; h < 8; ++h) KF[(size_t)m * 1536 + h * 192 + 128 + idx] = ob;
    }
}
constexpr int CW_KMAX = 8192, CW_QCTR = 8448;
DI void pass_kmax(const Ctx& c, const bf16* Kd, unsigned* ctl) {
    LAS float* red = (LAS float*)c.lds;
    for (int rb = c.bx; rb < MROWS / 128; rb += c.G) {
        float mx = 0.f;
        for (int i = 0; i < 16; ++i) {
            const bf16* row = Kd + (size_t)(rb * 128 + c.wave * 16 + i) * 1024 + 16 * c.lane;
            const u32x4 a = *(const u32x4*)row, b = *(const u32x4*)(row + 8);
            float s = 0.f;
#pragma unroll
            for (int q = 0; q < 4; ++q) s += bflo(a[q]) * bflo(a[q]) + bfhi(a[q]) * bfhi(a[q]) + bflo(b[q]) * bflo(b[q]) + bfhi(b[q]) * bfhi(b[q]);
            s += __shfl_xor(s, 1); s += __shfl_xor(s, 2);
            mx = fmaxf(mx, s);
        }
        __syncthreads();
        if ((c.lane & 3) == 0) red[c.wave * 16 + (c.lane >> 2)] = mx;
        __syncthreads();
        if (c.tid < 16) { float m = 0.f;
#pragma unroll
            for (int w = 0; w < NWAVES; ++w) m = fmaxf(m, red[w * 16 + c.tid]);
            atomicMax(ctl + CW_KMAX + ((rb * 128) / SEQ) * 16 + c.tid, __float_as_uint(sqrtf(m))); }
    }
}
template <int DQK, bool ALIBI, bool ROPE, int ldq, int qhs, int ldk, int khs, int ldv, int vhs, int vdiv, int ldo, int ohs, int nheads>
DI void attention_phase(const Ctx& c, const bf16* Q, const bf16* K, const bf16* V, bf16* O, const float* rope, unsigned* ctl) {
    constexpr int NU = BATCH * nheads * 32;
    if (!ALIBI) {
        for (int u = c.bx; u < NU; u += c.G) {
            const int xcd = u & 7, slot = (u >> 3) & 31, rnd = u >> 8, bh = xcd + 8 * rnd, qb = slot;
            const int b = bh / nheads, h = bh % nheads;
            const size_t row0 = (size_t)b * SEQ;
            att::attn_unit<DQK, ALIBI, ROPE, ldq, ldk, ldv, ldo>(Q + (row0 + qb * 256) * ldq + h * qhs, K + row0 * ldk + h * khs, V + row0 * ldv + (h / vdiv) * vhs,
                                       O + (row0 + qb * 256) * ldo + h * ohs, SEQ, 0.f, qb * 256, rope, (char*)c.lds, c.tid, 0.f);
        }
    } else {
        volatile LAS unsigned* qw = (volatile LAS unsigned*)(c.lds + LDSCTL_OFF);
        for (;;) {
            if (c.tid == 0) qw[0] = __hip_atomic_fetch_add(ctl + CW_QCTR, 1u, __ATOMIC_RELAXED, __HIP_MEMORY_SCOPE_AGENT);
            __syncthreads();
            const int u = (int)qw[0];
            __syncthreads();
            if (u >= NU) break;
            const int hh = 7 - (u >> 8), r = u & 255, b = r >> 6, sub = (r >> 5) & 1, qb = r & 31, h = 2 * hh + sub;
            const size_t row0 = (size_t)b * SEQ;
            const float slope2 = exp2f(-(float)(hh + 1)) * LOG2E;
            const float kmax = __uint_as_float(__hip_atomic_load(ctl + CW_KMAX + b * 16 + h, __ATOMIC_RELAXED, __HIP_MEMORY_SCOPE_AGENT));
            att::attn_unit<DQK, ALIBI, ROPE, ldq, ldk, ldv, ldo>(Q + (row0 + qb * 256) * ldq + h * qhs, K + row0 * ldk + h * khs, V + row0 * ldv + (h / vdiv) * vhs,
                                       O + (row0 + qb * 256) * ldo + h * ohs, SEQ, slope2, qb * 256, rope, (char*)c.lds, c.tid, kmax);
        }
    }
}

DI void pass_diff_combine(const Ctx& c, const bf16* OS, const float* lamp, const float* subg, bf16* OC) {
    const float lam_init = 0.8f - 0.6f * expf(-0.3f * 1.0f);
    const float sa = wave_sum(lamp[c.lane] * lamp[64 + c.lane]), sb = wave_sum(lamp[128 + c.lane] * lamp[192 + c.lane]);
    const float lam = expf(sa) - expf(sb) + lam_init;
    const int h = c.lane >> 3, e0 = (c.lane & 7) * 16;
    float gv[16];
#pragma unroll
    for (int i = 0; i < 16; ++i) gv[i] = subg[e0 + i] * (1.f - lam_init);
    for (int m = c.gw; m < MROWS; m += c.NGW) {
        const bf16* r1 = OS + (size_t)m * 2048 + (2 * h) * 128 + e0; const bf16* r2 = r1 + 128;
        const u32x4 a0 = *(const u32x4*)r1, a1 = *(const u32x4*)(r1 + 8), b0 = *(const u32x4*)r2, b1 = *(const u32x4*)(r2 + 8);
        float o[16]; float ss = 0.f;
#pragma unroll
        for (int i = 0; i < 4; ++i) { o[2 * i] = bflo(a0[i]) - lam * bflo(b0[i]); o[2 * i + 1] = bfhi(a0[i]) - lam * bfhi(b0[i]);
            o[8 + 2 * i] = bflo(a1[i]) - lam * bflo(b1[i]); o[8 + 2 * i + 1] = bfhi(a1[i]) - lam * bfhi(b1[i]); }
#pragma unroll
        for (int i = 0; i < 16; ++i) ss += o[i] * o[i];
        ss += __shfl_xor(ss, 1); ss += __shfl_xor(ss, 2); ss += __shfl_xor(ss, 4);
        const float rstd = rsqrtf(ss * (1.f / 128.f) + EPS);
        u32x4 w0, w1;
#pragma unroll
        for (int i = 0; i < 4; ++i) { w0[i] = pk2(o[2 * i] * rstd * gv[2 * i], o[2 * i + 1] * rstd * gv[2 * i + 1]); w1[i] = pk2(o[8 + 2 * i] * rstd * gv[8 + 2 * i], o[8 + 2 * i + 1] * rstd * gv[8 + 2 * i + 1]); }
        bf16* op = OC + (size_t)m * 1024 + h * 128 + e0; *(u32x4*)op = w0; *(u32x4*)(op + 8) = w1;
    }
}

DI float gelu_tanh(float x) { const float z = 0.7978845608028654f * (x + 0.044715f * x * x * x); return x * frcp(1.f + fexp(-2.f * z)); }
DI void pass_conv(const Ctx& c, bf16* U, const bf16* HALO, const float* cw, const float* cb, const bool wr = true) {
    const int NSTRIP = MROWS / 16;
    for (int s = c.gw; s < NSTRIP; s += c.NGW) {
        const int t0 = s * 16; const bool first = (t0 & (SEQ - 1)) == 0, lastst = ((t0 + 16) & (SEQ - 1)) == 0;
        for (int it = 0; it < 11; ++it) {
            const int cc = c.lane + 64 * it, ch = 4 * cc, gcol = (ch >> 7) * 256 + (ch & 127);
            const f32x4 wg0 = *(const f32x4*)(cw + ch), wg1 = *(const f32x4*)(cw + FFN_U + ch), wg2 = *(const f32x4*)(cw + 2 * FFN_U + ch), bg = *(const f32x4*)(cb + ch);
            const f32x4 wv0 = *(const f32x4*)(cw + FFN_H + ch), wv1 = *(const f32x4*)(cw + FFN_U + FFN_H + ch), wv2 = *(const f32x4*)(cw + 2 * FFN_U + FFN_H + ch), bv = *(const f32x4*)(cb + FFN_H + ch);
            u32x2 pg, pv, cg, cv, ng, nv;
            if (first) { pg = (u32x2){0u, 0u}; pv = pg; } else { const bf16* hp = HALO + ((size_t)(s - 1) * 2 + 1) * FFN_U + gcol; pg = *(const u32x2*)hp; pv = *(const u32x2*)(hp + 128); }
            { const bf16* up = U + (size_t)t0 * FFN_U + gcol; cg = *(const u32x2*)up; cv = *(const u32x2*)(up + 128); }
#pragma unroll 4
            for (int r = 0; r < 16; ++r) {
                if (r < 15) { const bf16* up = U + (size_t)(t0 + r + 1) * FFN_U + gcol; ng = *(const u32x2*)up; nv = *(const u32x2*)(up + 128); }
                else if (lastst) { ng = (u32x2){0u, 0u}; nv = ng; }
                else { const bf16* hp = HALO + ((size_t)(s + 1) * 2) * FFN_U + gcol; ng = *(const u32x2*)hp; nv = *(const u32x2*)(hp + 128); }
                f32x4 g_, v_;
                g_[0] = bg[0] + wg0[0] * bflo(pg.x) + wg1[0] * bflo(cg.x) + wg2[0] * bflo(ng.x); g_[1] = bg[1] + wg0[1] * bfhi(pg.x) + wg1[1] * bfhi(cg.x) + wg2[1] * bfhi(ng.x);
                g_[2] = bg[2] + wg0[2] * bflo(pg.y) + wg1[2] * bflo(cg.y) + wg2[2] * bflo(ng.y); g_[3] = bg[3] + wg0[3] * bfhi(pg.y) + wg1[3] * bfhi(cg.y) + wg2[3] * bfhi(ng.y);
                v_[0] = bv[0] + wv0[0] * bflo(pv.x) + wv1[0] * bflo(cv.x) + wv2[0] * bflo(nv.x); v_[1] = bv[1] + wv0[1] * bfhi(pv.x) + wv1[1] * bfhi(cv.x) + wv2[1] * bfhi(nv.x);
                v_[2] = bv[2] + wv0[2] * bflo(pv.y) + wv1[2] * bflo(cv.y) + wv2[2] * bflo(nv.y); v_[3] = bv[3] + wv0[3] * bfhi(pv.y) + wv1[3] * bfhi(cv.y) + wv2[3] * bfhi(nv.y);
                u32x2 o; o.x = pk2(gelu_tanh(g_[0]) * v_[0], gelu_tanh(g_[1]) * v_[1]); o.y = pk2(gelu_tanh(g_[2]) * v_[2], gelu_tanh(g_[3]) * v_[3]);
                if (wr) *(u32x2*)(U + (size_t)(t0 + r) * FFN_U + gcol) = o;
                pg = cg; pv = cv; cg = ng; cv = nv;
            }
        }
    }
}

constexpr int ML_CH = 128, ML_NC = SEQ / ML_CH, ML_H = 8, ML_DK = 64, ML_DV = 128, ML_EX = 160;
constexpr int ML_LDK = 72, ML_LDT = 96, ML_LDV = 160, ML_LDP = 136;
struct MlLds { LAS bf16* kA; LAS bf16* kB; LAS bf16* vx; LAS bf16* P; LAS bf16* Cs; LAS float* sc; };
DI void ml_gates(const Ctx& c, const float* gates, int row0, int h, LAS float* sc) {
    if (c.tid < 128) { const float* g = gates + (size_t)(row0 + c.tid) * 32 + h;
        sc[c.tid] = g[0]; sc[128 + c.tid] = log_sigmoid_(g[8]); sc[256 + c.tid] = g[16]; sc[384 + c.tid] = log_sigmoid_(g[24]); }
    __syncthreads();
    if (c.tid == 0) { float a = 0.f;
#pragma unroll 4
        for (int t = 0; t < 128; ++t) { a += sc[128 + t]; sc[512 + t] = a; } }
    if (c.tid == 64) { float a = 0.f;
#pragma unroll 4
        for (int t = 127; t >= 0; --t) { a += sc[384 + t]; sc[640 + t] = a; } }
    __syncthreads();
}
DI void ml_load_v(const Ctx& c, const bf16* v, int row0, int h, LAS bf16* vx) {
#pragma unroll
    for (int i = 0; i < 4; ++i) { const int ch = c.tid + 512 * i, r = ch >> 4, cc = (ch & 15) * 8;
        *(LAS u32x4*)(vx + r * ML_LDV + cc) = *(const u32x4*)(v + (size_t)(row0 + r) * 1024 + h * 128 + cc); }
    if (c.tid < 128) { LAS bf16* p = vx + c.tid * ML_LDV + 128;
        *(LAS u32x4*)p = (u32x4){0x00003f80u, 0u, 0u, 0u}; *(LAS u32x4*)(p + 8) = (u32x4){0u, 0u, 0u, 0u}; *(LAS u32x4*)(p + 16) = (u32x4){0u, 0u, 0u, 0u}; *(LAS u32x4*)(p + 24) = (u32x4){0u, 0u, 0u, 0u}; }
}
DI void ml_phase1(const Ctx& c, const bf16* k, const bf16* v, const float* gates, bf16* ST, float* DEC) {
    LAS bf16* kA = (LAS bf16*)c.lds; LAS bf16* kB = kA + 128 * ML_LDT; LAS bf16* vx = kB + 128 * ML_LDT; LAS float* sc = (LAS float*)(vx + 128 * ML_LDV);
    const int NU = BATCH * ML_H * ML_NC;
    for (int u = c.bx; u < NU; u += c.G) {
        const int ck = u % ML_NC, h = (u / ML_NC) % ML_H, b = u / (ML_NC * ML_H); const int row0 = b * SEQ + ck * ML_CH;
        ml_gates(c, gates, row0, h, sc);
        const float bl = sc[512 + 127], B0 = sc[640];
#pragma unroll
        for (int i = 0; i < 2; ++i) { const int ch = c.tid + 512 * i, r = ch >> 3, cc = (ch & 7) * 8;
            const u32x4 w = *(const u32x4*)(k + (size_t)(row0 + r) * 512 + h * 64 + cc);
            const float wF = fexp(bl - sc[512 + r] + sc[r]), wB = fexp(B0 - sc[640 + r] + sc[256 + r]);
            u32x4 a, bb;
#pragma unroll
            for (int q = 0; q < 4; ++q) { a[q] = pk2(bflo(w[q]) * wF, bfhi(w[q]) * wF); bb[q] = pk2(bflo(w[q]) * wB, bfhi(w[q]) * wB); }
            *(LAS u32x4*)(kA + r * ML_LDT + cc) = a; *(LAS u32x4*)(kB + r * ML_LDT + cc) = bb; }
        ml_load_v(c, v, row0, h, vx);
        __syncthreads();
#pragma unroll 1
        for (int id = c.wave; id < 20; id += 8) {
            const int dir = id / 10, rem = id % 10, db = rem / 5, eb = rem % 5;
            const LAS bf16* kw = dir ? kB : kA;
            f32x16 acc = {};
#pragma unroll 2
            for (int ks = 0; ks < 8; ++ks) acc = MFMA32(frag_tr(kw, ML_LDT, 16 * ks, 32 * db, c.lane), frag_tr(vx, ML_LDV, 16 * ks, 32 * eb, c.lane), acc);
            bf16* dst = ST + ((size_t)((b * ML_H + h) * 2 + dir) * ML_NC + ck) * (ML_DK * ML_EX);
            const int n = c.lane & 31, hi = c.lane >> 5;
#pragma unroll
            for (int r = 0; r < 16; ++r) dst[(32 * db + crow(r, hi)) * ML_EX + 32 * eb + n] = f2bf(acc[r]);
        }
        if (c.tid == 0) { float* d = DEC + (size_t)((b * ML_H + h) * 2) * ML_NC + ck; d[0] = fexp(bl); d[ML_NC] = fexp(B0); }
        __syncthreads();
    }
}
DI void ml_phase2(const Ctx& c, bf16* ST, const float* DEC) {
    constexpr int NG = ML_DK * ML_EX / 8;
    const int NTASK = BATCH * ML_H * 2 * NG;
    for (int t = c.bx * NTHREADS + c.tid; t < NTASK; t += c.G * NTHREADS) {
        const int g = t % NG, chain = t / NG, dir = chain & 1;
        bf16* base = ST + (size_t)chain * ML_NC * (ML_DK * ML_EX) + g * 8; const float* dec = DEC + (size_t)chain * ML_NC;
        float carry[8];
#pragma unroll
        for (int i = 0; i < 8; ++i) carry[i] = 0.f;
        for (int s = 0; s < ML_NC; ++s) {
            const int ck = dir ? (ML_NC - 1 - s) : s;
            u32x4* p = (u32x4*)(base + (size_t)ck * (ML_DK * ML_EX)); const u32x4 a = *p; const float d = dec[ck];
            u32x4 o;
#pragma unroll
            for (int q = 0; q < 4; ++q) { o[q] = pk2(carry[2 * q], carry[2 * q + 1]); carry[2 * q] = d * carry[2 * q] + bflo(a[q]); carry[2 * q + 1] = d * carry[2 * q + 1] + bfhi(a[q]); }
            *p = o;
        }
    }
}
DI void ml_phase3(const Ctx& c, const bf16* q, const bf16* k, const bf16* v, const bf16* og, const float* gates, const bf16* ST, const float* ng, bf16* Z) {
    LAS bf16* kl = (LAS bf16*)c.lds; LAS bf16* vx = kl + 128 * ML_LDK; LAS bf16* P = vx + 128 * ML_LDV; LAS bf16* Cs = P + 128 * ML_LDP; LAS float* sc = (LAS float*)(Cs + 64 * ML_LDV);
    LAS bf16* hb = P;
    const int NU = BATCH * ML_H * ML_NC;
    const int n = c.lane & 31, hi = c.lane >> 5, tb = c.wave & 3, wg2 = c.wave >> 2;
    for (int u = c.bx; u < NU; u += c.G) {
        const int ck = u % ML_NC, h = (u / ML_NC) % ML_H, b = u / (ML_NC * ML_H); const int row0 = b * SEQ + ck * ML_CH;
        ml_gates(c, gates, row0, h, sc);
#pragma unroll
        for (int i = 0; i < 2; ++i) { const int ch = c.tid + 512 * i, r = ch >> 3, cc = (ch & 7) * 8;
            *(LAS u32x4*)(kl + r * ML_LDK + cc) = *(const u32x4*)(k + (size_t)(row0 + r) * 512 + h * 64 + cc); }
        ml_load_v(c, v, row0, h, vx);
        const bf16* qg = q + (size_t)row0 * 512 + h * 64;
        bf16x8 qf[4];
#pragma unroll
        for (int kd = 0; kd < 4; ++kd) qf[kd] = gfrag_row(qg, 512, 32 * tb, 16 * kd, c.lane);
        f32x16 hs[2] = {};
#pragma unroll 1
        for (int dir = 0; dir < 2; ++dir) {
            const bf16* st = ST + ((size_t)((b * ML_H + h) * 2 + dir) * ML_NC + ck) * (ML_DK * ML_EX);
            for (int ch = c.tid; ch < 64 * 20; ch += NTHREADS) { const int r = ch / 20, cc = (ch % 20) * 8; *(LAS u32x4*)(Cs + r * ML_LDV + cc) = *(const u32x4*)(st + r * ML_EX + cc); }
            __syncthreads();
            const int ioff = dir ? 256 : 0, boff = dir ? 640 : 512;
            const float bt = sc[boff + 32 * tb + n];
#pragma unroll 1
            for (int sb2 = 0; sb2 < 2; ++sb2) {
                const int sb = 2 * wg2 + sb2;
                f32x16 a = {};
#pragma unroll
                for (int kd = 0; kd < 4; ++kd) a = MFMA32(frag_row(kl, ML_LDK, 32 * sb, 16 * kd, c.lane), qf[kd], a);
                const int t = 32 * tb + n;
#pragma unroll
                for (int g4 = 0; g4 < 4; ++g4) {
                    const int s0 = 32 * sb + 8 * g4 + 4 * hi;
                    float w[4];
#pragma unroll
                    for (int j = 0; j < 4; ++j) { const int s = s0 + j; const bool keep = dir ? (s >= t) : (s <= t);
                        const float e = fexp(fminf(bt - sc[boff + s], 0.f) + sc[ioff + s]); w[j] = keep ? a[4 * g4 + j] * e : 0.f; }
                    u32x2 o; o.x = pk2(w[0], w[1]); o.y = pk2(w[2], w[3]);
                    *(LAS u32x2*)(P + t * ML_LDP + s0) = o;
                }
            }
            __syncthreads();
            f32x16 acc[3] = {}, aci[3] = {};
#pragma unroll 2
            for (int ks = 0; ks < 8; ++ks) { const bf16x8 A = frag_row(P, ML_LDP, 32 * tb, 16 * ks, c.lane);
#pragma unroll
                for (int e = 0; e < 3; ++e) { const int et = (e == 2) ? 4 : 2 * wg2 + e; acc[e] = MFMA32(A, frag_tr(vx, ML_LDV, 16 * ks, 32 * et, c.lane), acc[e]); } }
#pragma unroll
            for (int kd = 0; kd < 4; ++kd) {
#pragma unroll
                for (int e = 0; e < 3; ++e) { const int et = (e == 2) ? 4 : 2 * wg2 + e; aci[e] = MFMA32(qf[kd], frag_tr(Cs, ML_LDV, 16 * kd, 32 * et, c.lane), aci[e]); } }
#pragma unroll
            for (int r = 0; r < 16; ++r) {
                const float eb_ = fexp(sc[boff + 32 * tb + crow(r, hi)]);
                const float t2 = acc[2][r] + eb_ * aci[2][r];
                const float den = __shfl(t2, hi * 32);
                const float inv = frcp(fmaxf(fabsf(den), 1.f));
                hs[0][r] += (acc[0][r] + eb_ * aci[0][r]) * inv; hs[1][r] += (acc[1][r] + eb_ * aci[1][r]) * inv;
            }
            __syncthreads();
        }
#pragma unroll
        for (int e = 0; e < 2; ++e)
#pragma unroll
            for (int r = 0; r < 16; ++r) hb[(32 * tb + crow(r, hi)) * ML_LDP + 32 * (2 * wg2 + e) + n] = f2bf(hs[e][r]);
        __syncthreads();
        const float g0 = ng[h * 128 + 2 * c.lane], g1 = ng[h * 128 + 2 * c.lane + 1];
        for (int rr = 0; rr < 16; ++rr) {
            const int t = 16 * c.wave + rr; const unsigned w = *(const LAS unsigned*)(hb + t * ML_LDP + 2 * c.lane);
            const float x0 = bflo(w), x1 = bfhi(w);
            const float mean = wave_sum(x0 + x1) * (1.f / 128.f); const float d0 = x0 - mean, d1 = x1 - mean;
            const float rstd = rsqrtf(wave_sum(d0 * d0 + d1 * d1) * (1.f / 128.f) + EPS);
            const unsigned ow = *(const unsigned*)(og + (size_t)(row0 + t) * 1024 + h * 128 + 2 * c.lane);
            *(unsigned*)(Z + (size_t)(row0 + t) * 1024 + h * 128 + 2 * c.lane) = pk2(d0 * rstd * g0 * sigmoidf_(bflo(ow)), d1 * rstd * g1 * sigmoidf_(bfhi(ow)));
        }
        __syncthreads();
    }
}

constexpr int RT_CH = 1024, RT_NC = SEQ / RT_CH, RT_H = 4, RT_DK = 256, RT_DV = 512;
constexpr int RT_LDK = 264, RT_LDB = 544, RT_LDA = 72, RT_LD2 = 288;
DI void rt_phase2(const Ctx& c, const bf16* k, const bf16* v, const float* dlogit, bf16* RS) {
    LAS bf16* kw = (LAS bf16*)c.lds; LAS bf16* vh = kw + 64 * RT_LD2;
    const int NU = BATCH * RT_H * 2 * RT_NC;
    const int n = c.lane & 31, hi = c.lane >> 5;
    for (int u = c.bx; u < NU; u += c.G) {
        const int ck = u % RT_NC, dir = (u / RT_NC) & 1, h = (u / (2 * RT_NC)) % RT_H, b = u / (2 * RT_NC * RT_H);
        const int row0 = b * SEQ + ck * RT_CH;
        const float lg2 = log_sigmoid_(dlogit[dir * 4 + h]) * LOG2E;
        bf16* dst = RS + ((size_t)((b * RT_H + h) * 2 + dir) * RT_NC + ck) * (RT_DK * RT_DV);
        for (int half = 0; half < 2; ++half) {
            f32x16 acc[8] = {};
            for (int sb = 0; sb < RT_CH / 64; ++sb) {
                __syncthreads();
#pragma unroll
                for (int i = 0; i < 4; ++i) { const int ch = c.tid + 512 * i, r = ch >> 5, cc = (ch & 31) * 8; const int s = 64 * sb + r;
                    const float w = fexp2(lg2 * (float)(dir ? s : (RT_CH - 1 - s)));
                    const u32x4 kk = *(const u32x4*)(k + (size_t)(row0 + s) * 1024 + h * 256 + cc);
                    u32x4 o;
#pragma unroll
                    for (int q = 0; q < 4; ++q) o[q] = pk2(bflo(kk[q]) * w, bfhi(kk[q]) * w);
                    *(LAS u32x4*)(kw + r * RT_LD2 + cc) = o;
                    *(LAS u32x4*)(vh + r * RT_LD2 + cc) = *(const u32x4*)(v + (size_t)(row0 + s) * 2048 + h * 512 + half * 256 + cc); }
                __syncthreads();
#pragma unroll 1
                for (int ks = 0; ks < 4; ++ks) { const bf16x8 A = frag_tr(kw, RT_LD2, 16 * ks, 32 * c.wave, c.lane);
#pragma unroll
                    for (int et = 0; et < 8; ++et) { acc[et] = MFMA32(A, frag_tr(vh, RT_LD2, 16 * ks, 32 * et, c.lane), acc[et]); if (et == 3) __builtin_amdgcn_sched_barrier(0); } }
            }
#pragma unroll
            for (int et = 0; et < 8; ++et)
#pragma unroll
                for (int r = 0; r < 16; ++r) dst[(size_t)(32 * c.wave + crow(r, hi)) * RT_DV + half * 256 + 32 * et + n] = f2bf(acc[et][r]);
        }
        __syncthreads();
    }
}
DI void rt_phase3(const Ctx& c, bf16* RS, const float* dlogit) {
    constexpr int NG = RT_DK * RT_DV / 8;
    const int NTASK = BATCH * RT_H * 2 * NG;
    for (int t = c.bx * NTHREADS + c.tid; t < NTASK; t += c.G * NTHREADS) {
        const int g = t % NG, chain = t / NG, dir = chain & 1, h = (chain >> 1) % RT_H;
        const float gch = fexp2(log_sigmoid_(dlogit[dir * 4 + h]) * LOG2E * (float)RT_CH);
        bf16* base = RS + (size_t)chain * RT_NC * (RT_DK * RT_DV) + (size_t)g * 8;
        float carry[8];
#pragma unroll
        for (int i = 0; i < 8; ++i) carry[i] = 0.f;
#pragma unroll
        for (int s = 0; s < RT_NC; ++s) {
            const int ck = dir ? (RT_NC - 1 - s) : s;
            u32x4* p = (u32x4*)(base + (size_t)ck * (RT_DK * RT_DV)); const u32x4 a = *p;
            u32x4 o;
#pragma unroll
            for (int q = 0; q < 4; ++q) { o[q] = pk2(carry[2 * q], carry[2 * q + 1]); carry[2 * q] = gch * carry[2 * q] + bflo(a[q]); carry[2 * q + 1] = gch * carry[2 * q + 1] + bfhi(a[q]); }
            *p = o;
        }
    }
}
DI void rt_phase4(const Ctx& c, const bf16* q, const bf16* k, const bf16* v, bf16* gz, const bf16* RS, const float* dlogit, const float* ng, const bool wr = true) {
    LAS bf16* kt = (LAS bf16*)c.lds; LAS bf16* Bt = kt + 64 * RT_LDK; LAS bf16* At = Bt + 64 * RT_LDB; LAS float* red = (LAS float*)(At + 128 * RT_LDA);
    const int NU = BATCH * RT_H * RT_NC * 8;
    const int n = c.lane & 31, hi = c.lane >> 5, tb = c.wave & 3, eh = c.wave >> 2;
    for (int u = c.bx; u < NU; u += c.G) {
        const int tq = u & 7, ck = (u >> 3) % RT_NC, h = (u / (8 * RT_NC)) % RT_H, b = u / (8 * RT_NC * RT_H);
        const int rowc = b * SEQ + ck * RT_CH, rowq = rowc + tq * 128;
        const float lf2 = log_sigmoid_(dlogit[h]) * LOG2E, lb2 = log_sigmoid_(dlogit[4 + h]) * LOG2E;
        const bf16* qg = q + (size_t)rowq * 1024 + h * 256;
        f32x16 acc[8] = {};
        u32x4 sb_[8], sk_[4];
#define RT_PREFETCH(st) do { int ot = c.tid; asm volatile("" : "+v"(ot)); \
        if ((st) < 16) { const int s0_ = 64 * (st); \
            _Pragma("unroll") for (int i = 0; i < 4; ++i) { const int ch = ot + 512 * i, r = ch >> 5, cc = (ch & 31) * 8; sk_[i] = *(const u32x4*)(k + (size_t)(rowc + s0_ + r) * 1024 + h * 256 + cc); } \
            _Pragma("unroll") for (int i = 0; i < 8; ++i) { const int ch = ot + 512 * i, r = ch >> 6, cc = (ch & 63) * 8; sb_[i] = *(const u32x4*)(v + (size_t)(rowc + s0_ + r) * 2048 + h * 512 + cc); } \
        } else { const int dir_ = ((st) - 16) >> 2, d0_ = 64 * (((st) - 16) & 3); \
            const bf16* rs_ = RS + ((size_t)((b * RT_H + h) * 2 + dir_) * RT_NC + ck) * (RT_DK * RT_DV) + (size_t)d0_ * RT_DV; \
            _Pragma("unroll") for (int i = 0; i < 8; ++i) { const int ch = ot + 512 * i, r = ch >> 6, cc = (ch & 63) * 8; sb_[i] = *(const u32x4*)(rs_ + (size_t)r * RT_DV + cc); } \
            _Pragma("unroll") for (int i = 0; i < 2; ++i) { const int ch = ot + 512 * i, r = ch >> 3, cc = (ch & 7) * 8; sk_[i] = *(const u32x4*)(qg + (size_t)r * 1024 + d0_ + cc); } } } while (0)
        RT_PREFETCH(0);
#pragma unroll 1
        for (int step = 0; step < 24; ++step) {
            __syncthreads();
            { int ot = c.tid; asm volatile("" : "+v"(ot));
#pragma unroll
              for (int i = 0; i < 8; ++i) { const int ch = ot + 512 * i, r = ch >> 6, cc = (ch & 63) * 8; *(LAS u32x4*)(Bt + r * RT_LDB + cc) = sb_[i]; }
              if (step < 16) {
#pragma unroll
                  for (int i = 0; i < 4; ++i) { const int ch = ot + 512 * i, r = ch >> 5, cc = (ch & 31) * 8; *(LAS u32x4*)(kt + r * RT_LDK + cc) = sk_[i]; }
              } else {
                  const int dir = (step - 16) >> 2;
#pragma unroll
                  for (int i = 0; i < 2; ++i) { const int ch = ot + 512 * i, r = ch >> 3, cc = (ch & 7) * 8; const int tpos = 128 * tq + r;
                      const float xi = dir ? fexp2(lb2 * (float)(RT_CH - tpos)) : fexp2(lf2 * (float)(tpos + 1));
                      u32x4 o;
#pragma unroll
                      for (int q4 = 0; q4 < 4; ++q4) o[q4] = pk2(bflo(sk_[i][q4]) * xi, bfhi(sk_[i][q4]) * xi);
                      *(LAS u32x4*)(At + r * RT_LDA + cc) = o; }
              } }
            if (step >= 16 && step + 1 < 24) RT_PREFETCH(step + 1);
            __syncthreads();
            if (step < 16) {
                const int s0 = 64 * step;
                f32x16 a = {};
#pragma unroll 4
                for (int kd = 0; kd < 16; ++kd) a = MFMA32(frag_row(kt, RT_LDK, 32 * eh, 16 * kd, c.lane), gfrag_row(qg, 1024, 32 * tb, 16 * kd, c.lane), a);
                const int tl = 32 * tb + n, tpos = 128 * tq + tl;
#pragma unroll
                for (int g4 = 0; g4 < 4; ++g4) {
                    const int sl = 32 * eh + 8 * g4 + 4 * hi;
                    float w[4];
#pragma unroll
                    for (int j = 0; j < 4; ++j) { const float rel = (float)(tpos - (s0 + sl + j));
                        const float mk = (rel >= 0.f ? fexp2(rel * lf2) : 0.f) + (rel <= 0.f ? fexp2(-rel * lb2) : 0.f); w[j] = a[4 * g4 + j] * mk; }
                    u32x2 o; o.x = pk2(w[0], w[1]); o.y = pk2(w[2], w[3]);
                    *(LAS u32x2*)(At + tl * RT_LDA + sl) = o;
                }
                RT_PREFETCH(step + 1);
                __syncthreads();
            }
#pragma unroll 1
            for (int ks = 0; ks < 4; ++ks) { const bf16x8 A = frag_row(At, RT_LDA, 32 * tb, 16 * ks, c.lane);
#pragma unroll
                for (int et = 0; et < 8; ++et) { acc[et] = MFMA32(A, frag_tr(Bt, RT_LDB, 16 * ks, 32 * (8 * eh + et), c.lane), acc[et]); if (et == 3) __builtin_amdgcn_sched_barrier(0); } }
        }
#undef RT_PREFETCH
#pragma unroll
        for (int r = 0; r < 16; ++r) {
            float s1 = 0.f, s2 = 0.f;
#pragma unroll
            for (int et = 0; et < 8; ++et) { s1 += acc[et][r]; s2 += acc[et][r] * acc[et][r]; }
#pragma unroll
            for (int o = 1; o < 32; o <<= 1) { s1 += __shfl_xor(s1, o); s2 += __shfl_xor(s2, o); }
            if (n == 0) { red[((32 * tb + crow(r, hi)) * 2 + eh) * 2] = s1; red[((32 * tb + crow(r, hi)) * 2 + eh) * 2 + 1] = s2; }
        }
        __syncthreads();
#pragma unroll
        for (int r = 0; r < 16; ++r) {
            const int tl = 32 * tb + crow(r, hi);
            const float s1 = red[(tl * 2) * 2] + red[(tl * 2 + 1) * 2], s2 = red[(tl * 2) * 2 + 1] + red[(tl * 2 + 1) * 2 + 1];
            const float mean = s1 * (1.f / 512.f), var = fmaxf(s2 * (1.f / 512.f) - mean * mean, 0.f), rstd = rsqrtf(var + EPS);
            bf16* gp = gz + (size_t)(rowq + tl) * 2048 + h * 512 + 256 * eh + n;
#pragma unroll
            for (int et = 0; et < 8; ++et) { const float gt = bf2f(gp[32 * et]); const float y = (acc[et][r] - mean) * rstd * ng[h * 512 + 256 * eh + 32 * et + n];
                if (wr) gp[32 * et] = f2bf(y * gt * sigmoidf_(gt)); }
        }
        __syncthreads();
    }
}

struct Args { const float* in[25]; float* out; unsigned char* ws; int ph_lo, ph_hi; };
constexpr int NPHASES = 64;
#define PHASE(...) do { if (ph >= lo && ph < hi) { { Ctx c = c0; asm volatile("" : "+v"(c.tid)); c.lane = c.tid & 63; c.wave = __builtin_amdgcn_readfirstlane(c.tid >> 6); c.gw = c.bx * NWAVES + c.wave; \
    __VA_ARGS__; } if (ph + 1 < hi) xcd_barrier(bar); } ++ph; } while (0)
#define FFN_JOBS(L) {args.in[2] + (size_t)(L) * DM * FFN_U, DM, FFN_U, WTup, MAP_FFNUP, 0}, {args.in[5] + (size_t)(L) * FFN_H * DM, FFN_H, DM, WTdown, MAP_ID, 0}

template <int L> DI void run_layer(const Ctx& c0, const Args& args, const XcdBarrier& bar, const int lo, const int hi, int& ph) {
    unsigned char* ws = args.ws;
    const float* x = args.in[0]; const float* norm_g = args.in[1];
    float* hout = args.out;
    float* rope = (float*)(ws + WS_ROPE);
    bf16* XN = (bf16*)(ws + WS_XN);
    unsigned char* S = ws + WS_S;
    bf16* WTmix = (bf16*)(ws + WT_MIX); bf16* WTup = (bf16*)(ws + WT_UP); bf16* WTdown = (bf16*)(ws + WT_DOWN);
    bf16* U = (bf16*)S; bf16* HALO = (bf16*)(S + 352 * MiB);
    LAS unsigned char* ring = c0.lds;

        const float* g0 = norm_g + (size_t)(L * 4 + 0) * DM; const float* g1 = g0 + DM; const float* g2 = g0 + 2 * DM; const float* g3 = g0 + 3 * DM;
        const float* hbase = (L == 0) ? x : hout;
        bf16* AOUT = (bf16*)S;
        if constexpr (L == 0) {
            bf16* Wd = WTmix; bf16* Wuq = (bf16*)(ws + WT_MIX + 2 * MiB); bf16* Wukv = (bf16*)(ws + WT_MIX + 4 * MiB); bf16* Wo = (bf16*)(ws + WT_MIX + 6 * MiB);
            bf16* DQKV = (bf16*)S; bf16* CQ = (bf16*)(S + 48 * MiB); bf16* CKV = (bf16*)(S + 72 * MiB); bf16* Q = (bf16*)(S + 88 * MiB); bf16* KF = (bf16*)(S + 184 * MiB);
            bf16* V = (bf16*)(S + 280 * MiB); bf16* O = (bf16*)(S + 344 * MiB);
            PHASE({
                fill_rope(c, rope);
                const TJob jobs[6] = {{args.in[6], DM, 384, Wd, MAP_ID, 0}, {args.in[9], DM, 320, Wd, MAP_ID, 384}, {args.in[8], 384, 1536, Wuq, MAP_ROPEQ, 0},
                                      {args.in[11], 256, 2048, Wukv, MAP_ID, 0}, {args.in[12], DM, DM, Wo, MAP_ID, 0}, {args.in[2], DM, FFN_U, WTup, MAP_FFNUP, 0}};
                run_transposes<6>(c, jobs);
                const TJob jobs2[1] = {{args.in[5], FFN_H, DM, WTdown, MAP_ID, 0}};
                run_transposes<1>(c, jobs2);
                zero_rows(c, Wd, DM, 704, 64);
                pass_norm0(c, x, g0, XN);
            });
            PHASE({ pg8::Gemm g{XN, Wd, MROWS, 768, DM, DM, 256}; pg8::StaticOrder so; so.init(MROWS, 768, c.G, c.bx);
                pg8::gemm_phase(ring, c.tid, g, so, pg8::epi_plain(DQKV, 768, 1.f)); });
            PHASE({ pass_mla_mid(c, DQKV, args.in[7], args.in[10], rope, CQ, CKV, KF); });
            PHASE({ pg8::Gemm g{CQ, Wuq, MROWS, 1536, 384, 384, 256}; pg8::StaticOrder so; so.init(MROWS, 1536, c.G, c.bx);
                  pg8::gemm_phase(ring, c.tid, g, so, pg8::epi_plain(Q, 1536, 0.07216878364870322f * LOG2E)); });
            PHASE({ pg8::Gemm g{CKV, Wukv, MROWS, 2048, 256, 256, 256}; pg8::StaticOrder so; so.init(MROWS, 2048, c.G, c.bx);
                  pg8::EpiMlaKV E{KF, V}; pg8::gemm_phase(ring, c.tid, g, so, E); });
#if defined(PROBE_MLA)
            PHASE({ attention_phase<192, false, true, 1536, 192, 1536, 192, 1024, 128, 1, 1024, 128, 8>(c, Q, KF, V, O, rope, (unsigned*)(ws + WS_CTL)); });
#endif
            PHASE({ attention_phase<192, false, true, 1536, 192, 1536, 192, 1024, 128, 1, 1024, 128, 8>(c, Q, KF, V, O, rope, (unsigned*)(ws + WS_CTL)); });
            PHASE({ pg8::Gemm g{O, Wo, MROWS, DM, DM, DM, 256}; pg8::StaticOrder so; so.init(MROWS, DM, c.G, c.bx);
                pg8::gemm_phase(ring, c.tid, g, so, pg8::epi_plain(AOUT, DM, 1.f)); });
        } else if constexpr (L == 1) {
            bf16* Wqkv = WTmix; bf16* Wo = (bf16*)(ws + WT_MIX + 8 * MiB);
            bf16* Qd = (bf16*)S; bf16* Kd = (bf16*)(S + 64 * MiB); bf16* Vd = (bf16*)(S + 128 * MiB); bf16* OS = (bf16*)(S + 192 * MiB); bf16* OC = (bf16*)(S + 320 * MiB);
            PHASE({ pg8::Gemm g{XN, Wqkv, MROWS, 3072, DM, DM, 256}; pg8::StaticOrder so; so.init(MROWS, 3072, c.G, c.bx);
                pg8::EpiSeg<false> E{}; E.p0 = Qd; E.ld0 = DM; E.s0 = 0.125f * LOG2E; E.e0 = 8; E.p1 = Kd; E.ld1 = DM; E.s1 = 1.f; E.e1 = 16; E.p2 = Vd; E.ld2 = DM; E.s2 = 1.f; E.e2 = 100000;
                pg8::gemm_phase(ring, c.tid, g, so, E); });
            PHASE({ pass_kmax(c, Kd, (unsigned*)(ws + WS_CTL)); });
            PHASE({ attention_phase<64, true, false, 1024, 64, 1024, 64, 1024, 128, 2, 2048, 128, 16>(c, Qd, Kd, Vd, OS, rope, (unsigned*)(ws + WS_CTL)); });
            PHASE({ pass_diff_combine(c, OS, args.in[14], args.in[15], OC); });
            PHASE({ pg8::Gemm g{OC, Wo, MROWS, DM, DM, DM, 256}; pg8::StaticOrder so; so.init(MROWS, DM, c.G, c.bx);
                pg8::gemm_phase(ring, c.tid, g, so, pg8::epi_plain(AOUT, DM, 1.f)); });
        } else if constexpr (L == 2) {
            bf16* Win = WTmix; bf16* Wout = (bf16*)(ws + WT_MIX + 8 * MiB);
            bf16* q = (bf16*)S; bf16* k = (bf16*)(S + 32 * MiB); bf16* v = (bf16*)(S + 64 * MiB); bf16* og = (bf16*)(S + 128 * MiB);
            float* gates = (float*)(S + 192 * MiB); float* DEC = (float*)(S + 196 * MiB); bf16* ST = (bf16*)(S + 200 * MiB); bf16* Z = (bf16*)(S + 288 * MiB);
            PHASE({ pg8::Gemm g{XN, Win, MROWS, 3328, DM, DM, 256}; pg8::StaticOrder so; so.init(MROWS, 3328, c.G, c.bx);
                pg8::EpiSeg<true> E{}; E.p0 = q; E.ld0 = 512; E.s0 = 1.f; E.e0 = 4; E.p1 = k; E.ld1 = 512; E.s1 = 0.125f; E.e1 = 8; E.p2 = v; E.ld2 = DM; E.s2 = 1.f; E.e2 = 16; E.p3 = og; E.ld3 = DM; E.s3 = 1.f;
                E.gates = gates; E.gbias = args.in[18]; E.gblk = 24;
                pg8::gemm_phase(ring, c.tid, g, so, E); });
#if defined(PROBE_ML)
            PHASE({ ml_phase1(c, k, v, gates, ST, DEC); });
#endif
            PHASE({ ml_phase1(c, k, v, gates, ST, DEC); });
            PHASE({ ml_phase2(c, ST, DEC); });
#if defined(PROBE_ML)
            PHASE({ ml_phase3(c, q, k, v, og, gates, ST, args.in[19], Z); });
#endif
            PHASE({ ml_phase3(c, q, k, v, og, gates, ST, args.in[19], Z); });
            PHASE({ pg8::Gemm g{Z, Wout, MROWS, DM, DM, DM, 256}; pg8::StaticOrder so; so.init(MROWS, DM, c.G, c.bx);
                pg8::gemm_phase(ring, c.tid, g, so, pg8::epi_plain(AOUT, DM, 1.f)); });
        } else {
            bf16* Win = WTmix; bf16* Wo = (bf16*)(ws + WT_MIX + 12 * MiB);
            bf16* q = (bf16*)S; bf16* k = (bf16*)(S + 64 * MiB); bf16* v = (bf16*)(S + 128 * MiB); bf16* gz = (bf16*)(S + 256 * MiB); bf16* RS = XN;
            PHASE({ pg8::Gemm g{XN, Win, MROWS, 6144, DM, DM, 256}; pg8::StaticOrder so; so.init(MROWS, 6144, c.G, c.bx);
                pg8::EpiSeg<false> E{}; E.p0 = q; E.ld0 = DM; E.s0 = 1.f; E.e0 = 8; E.p1 = k; E.ld1 = DM; E.s1 = 0.0625f; E.e1 = 16; E.p2 = v; E.ld2 = 2048; E.s2 = 1.f; E.e2 = 32; E.p3 = gz; E.ld3 = 2048; E.s3 = 1.f;
                pg8::gemm_phase(ring, c.tid, g, so, E); });
#if defined(PROBE_RT)
            PHASE({ rt_phase2(c, k, v, args.in[22], RS); });
#endif
            PHASE({ rt_phase2(c, k, v, args.in[22], RS); });
            PHASE({ rt_phase3(c, RS, args.in[22]); });
#if defined(PROBE_RT)
            PHASE({ rt_phase4(c, q, k, v, gz, RS, args.in[22], args.in[23], args.ph_lo == 12345); });
#endif
            PHASE({ rt_phase4(c, q, k, v, gz, RS, args.in[22], args.in[23]); });
            PHASE({ pg8::Gemm g{gz, Wo, MROWS, DM, 2048, 2048, 256}; pg8::StaticOrder so; so.init(MROWS, DM, c.G, c.bx);
                pg8::gemm_phase(ring, c.tid, g, so, pg8::epi_plain(AOUT, DM, 1.f)); });
        }
#if defined(PROBE_ROW)
        PHASE({ pass_res_norm(c, AOUT, hbase, g1, g2, (float*)(S + 64 * MiB), (bf16*)(S + 192 * MiB)); });
#endif
        PHASE({ pass_res_norm(c, AOUT, hbase, g1, g2, hout, XN); });
#if defined(PROBE_UP)
        PHASE({ pg8::Gemm g{XN, WTup, MROWS, FFN_U, DM, DM, 256}; pg8::StaticOrder so; so.init(MROWS, FFN_U, c.G, c.bx);
            pg8::EpiFfnUp E{U, HALO}; pg8::gemm_phase(ring, c.tid, g, so, E); });
#endif
        PHASE({ pg8::Gemm g{XN, WTup, MROWS, FFN_U, DM, DM, 256}; pg8::StaticOrder so; so.init(MROWS, FFN_U, c.G, c.bx);
            pg8::EpiFfnUp E{U, HALO}; pg8::gemm_phase(ring, c.tid, g, so, E); });
#if defined(PROBE_CONV)
        PHASE({ pass_conv(c, U, HALO, args.in[3] + (size_t)L * 3 * FFN_U, args.in[4] + (size_t)L * FFN_U, args.ph_lo == 12345); });
#endif
        PHASE({ pass_conv(c, U, HALO, args.in[3] + (size_t)L * 3 * FFN_U, args.in[4] + (size_t)L * FFN_U); });
        PHASE({ pg8::Gemm g{U, WTdown, MROWS, DM, FFN_H, FFN_U, 512}; pg8::StaticOrder so; so.init(MROWS, DM, c.G, c.bx);
            pg8::gemm_phase(ring, c.tid, g, so, pg8::epi_plain(XN, DM, 1.f)); });
        PHASE({
            pass_res_norm(c, XN, hout, g3, (L < 3) ? g0 + 4 * DM : g0, hout, (L < 3) ? XN : nullptr);
            if constexpr (L == 0) { const TJob jobs[4] = {{args.in[13], DM, 3072, WTmix, MAP_ID, 0}, {args.in[16], DM, DM, (bf16*)(ws + WT_MIX + 8 * MiB), MAP_ID, 0}, FFN_JOBS(1)}; run_transposes<4>(c, jobs); }
            else if constexpr (L == 1) { const TJob jobs[4] = {{args.in[17], DM, 3104, WTmix, MAP_ID, 0}, {args.in[20], DM, DM, (bf16*)(ws + WT_MIX + 8 * MiB), MAP_ID, 0}, FFN_JOBS(2)}; run_transposes<4>(c, jobs);
                zero_rows(c, WTmix, DM, 3104, 224); }
            else if constexpr (L == 2) { const TJob jobs[4] = {{args.in[21], DM, 6144, WTmix, MAP_ID, 0}, {args.in[24], 2048, DM, (bf16*)(ws + WT_MIX + 12 * MiB), MAP_ID, 0}, FFN_JOBS(3)}; run_transposes<4>(c, jobs); }
        });
    }

__global__ void __launch_bounds__(NTHREADS, 2) enc_fwd(Args args) {
    extern __shared__ __attribute__((aligned(16))) unsigned char lds_raw[];
    Ctx c;
    c.lds = (LAS unsigned char*)lds_raw;
    c.tid = threadIdx.x; c.lane = c.tid & 63; c.wave = __builtin_amdgcn_readfirstlane(c.tid >> 6);
    c.G = gridDim.x; c.bx = blockIdx.x; c.gw = c.bx * NWAVES + c.wave; c.NGW = c.G * NWAVES;
    volatile LAS unsigned* MISC = (volatile LAS unsigned*)(c.lds + MISC_OFF);
    for (int u = c.tid; u < (LDS_BYTES - LDSCTL_OFF) / 4; u += NTHREADS) ((LAS unsigned*)(c.lds + LDSCTL_OFF))[u] = 0u;
    __syncthreads();
    XcdBarrier bar = xcd_barrier_post((unsigned*)(args.ws + WS_CTL) + 4096, MISC + 8);
    const int lo = args.ph_lo, hi = args.ph_hi;
    int ph = 0;
    run_layer<0>(c, args, bar, lo, hi, ph);
    run_layer<1>(c, args, bar, lo, hi, ph);
    run_layer<2>(c, args, bar, lo, hi, ph);
    run_layer<3>(c, args, bar, lo, hi, ph);
}
#undef PHASE

#ifndef MK_N_LAUNCHES
#define MK_N_LAUNCHES 1
#endif
extern "C" void kernel_launch(void* const* d_in, const int* in_sizes, int n_in, void* d_out, int out_size, void* d_ws, size_t ws_size, hipStream_t stream) {
    static int grid = 0;
    if (grid == 0) {
        if (n_in != 25 || in_sizes[0] != MROWS * DM || out_size != MROWS * DM || ws_size < WS_END) {
            fprintf(stderr, "kernel_launch: unexpected shapes: n_in %d in0 %d out %d ws %zu (need %zu)\n", n_in, n_in > 0 ? in_sizes[0] : -1, out_size, ws_size, (size_t)WS_END); grid = -1; return; }
        int dev = 0, cus = 0, per_cu = 0;
        if (hipGetDevice(&dev) != hipSuccess || hipDeviceGetAttribute(&cus, hipDeviceAttributeMultiprocessorCount, dev) != hipSuccess) { grid = -1; return; }
        if (hipFuncSetAttribute((const void*)enc_fwd, hipFuncAttributeMaxDynamicSharedMemorySize, LDS_BYTES) != hipSuccess) { fprintf(stderr, "kernel_launch: hipFuncSetAttribute failed\n"); grid = -1; return; }
        if (hipOccupancyMaxActiveBlocksPerMultiprocessor(&per_cu, (const void*)enc_fwd, NTHREADS, LDS_BYTES) != hipSuccess || per_cu < 1)
            fprintf(stderr, "kernel_launch: note: occupancy query reports %d workgroups per CU\n", per_cu);
        (void)hipGetLastError();
        grid = cus;
    }
    if (grid < 0) return;
    Args a{};
    for (int i = 0; i < 25; ++i) a.in[i] = (const float*)d_in[i];
    a.out = (float*)d_out; a.ws = (unsigned char*)d_ws;
    if (MK_N_LAUNCHES == 1) {
        (void)hipMemsetAsync((char*)d_ws + WS_CTL, 0, CTL_ZERO_BYTES, stream);
        a.ph_lo = 0; a.ph_hi = NPHASES;
        hipLaunchKernelGGL(enc_fwd, dim3(grid), dim3(NTHREADS), LDS_BYTES, stream, a);
    } else {
        for (int p = 0; p < NPHASES; ++p) {
            (void)hipMemsetAsync((char*)d_ws + WS_CTL, 0, CTL_ZERO_BYTES, stream);
            a.ph_lo = p; a.ph_hi = p + 1;
            hipLaunchKernelGGL(enc_fwd, dim3(grid), dim3(NTHREADS), LDS_BYTES, stream, a);
        }
    }
    const hipError_t le = hipPeekAtLastError();
    if (le != hipSuccess) fprintf(stderr, "kernel_launch: launch failed: %s\n", hipGetErrorName(le));
}
```

```cpp
#include <hip/hip_runtime.h>
#include <cstdio>
#include <cstdint>

#define DI __device__ __forceinline__
#define LAS __attribute__((address_space(3)))
#define GAS __attribute__((address_space(1)))
typedef unsigned short bf16;
typedef short bf16x8 __attribute__((ext_vector_type(8)));
typedef short s16x4 __attribute__((ext_vector_type(4)));
typedef float f32x2 __attribute__((ext_vector_type(2)));
typedef float f32x4 __attribute__((ext_vector_type(4)));
typedef float f32x16 __attribute__((ext_vector_type(16)));
typedef unsigned u32x2 __attribute__((ext_vector_type(2)));
typedef unsigned u32x4 __attribute__((ext_vector_type(4)));
typedef __bf16 bf16x2_t __attribute__((ext_vector_type(2)));

constexpr int BATCH = 4, SEQ = 8192, DM = 1024, MROWS = BATCH * SEQ;
constexpr int FFN_H = 2816, FFN_U = 2 * FFN_H;
constexpr float EPS = 1e-6f, LOG2E = 1.4426950408889634f;
constexpr int NWAVES = 8, NTHREADS = NWAVES * 64;

constexpr size_t MiB = 1u << 20;
constexpr size_t WS_CTL = 0, CTL_ZERO_BYTES = 1 * MiB;
constexpr size_t WS_ROPE = 1 * MiB;
constexpr size_t WS_WT = 4 * MiB;
constexpr size_t WT_MIX = WS_WT, WT_UP = WS_WT + 16 * MiB, WT_DOWN = WS_WT + 28 * MiB;
constexpr size_t WS_XN = 40 * MiB;
constexpr size_t WS_S = 104 * MiB;
constexpr size_t WS_END = 512 * MiB;

DI unsigned pk2(float lo, float hi) { f32x2 v = {lo, hi}; bf16x2_t b = __builtin_convertvector(v, bf16x2_t); return __builtin_bit_cast(unsigned, b); }
DI float bflo(unsigned w) { return __uint_as_float(w << 16); }
DI float bfhi(unsigned w) { return __uint_as_float(w & 0xffff0000u); }
DI float bf2f(bf16 b) { return __uint_as_float((unsigned)b << 16); }
DI bf16 f2bf(float f) { return (bf16)(pk2(f, 0.f) & 0xffffu); }
DI float wave_sum(float v) {
#pragma unroll
    for (int o = 1; o < 64; o <<= 1) v += __shfl_xor(v, o);
    return v;
}
DI float fexp2(float x) { return __builtin_amdgcn_exp2f(x); }
DI float fexp(float x) { return __builtin_amdgcn_exp2f(x * LOG2E); }
DI float frcp(float x) { return __builtin_amdgcn_rcpf(x); }
DI float sigmoidf_(float x) { return frcp(1.f + fexp(-x)); }
DI float log_sigmoid_(float x) { return fminf(x, 0.f) - log1pf(expf(-fabsf(x))); }
DI int crow(int r, int hi) { return (r & 3) + 8 * (r >> 2) + 4 * hi; }
#define MFMA32(a, b, c) __builtin_amdgcn_mfma_f32_32x32x16_bf16((a), (b), (c), 0, 0, 0)

DI bf16x8 frag_row(const LAS bf16* base, int ld, int row0, int k0, int lane) {
    return *(const LAS bf16x8*)(base + (row0 + (lane & 31)) * ld + k0 + 8 * (lane >> 5));
}
typedef short v4i16_t __attribute__((ext_vector_type(4)));
DI s16x4 tr_rd(const LAS bf16* p) { return __builtin_bit_cast(s16x4, __builtin_amdgcn_ds_read_tr16_b64_v4i16((LAS v4i16_t*)p)); }
DI bf16x8 frag_tr(const LAS bf16* base, int ld, int k0, int n0, int lane) {
    const int g = lane >> 4, i = lane & 15, r = i >> 2, c = i & 3, h = lane >> 5;
    const LAS bf16* p = base + (k0 + 8 * h + r) * ld + n0 + 16 * (g & 1) + 4 * c;
    const s16x4 lo = tr_rd(p), hi = tr_rd(p + 4 * ld);
    return (bf16x8){lo[0], lo[1], lo[2], lo[3], hi[0], hi[1], hi[2], hi[3]};
}
DI bf16x8 gfrag_row(const bf16* base, int ld, int row0, int k0, int lane) {
    return *(const bf16x8*)(base + (size_t)(row0 + (lane & 31)) * ld + k0 + 8 * (lane >> 5));
}

namespace pg8 {
typedef unsigned short bf16_t;
constexpr int BM = 256, BK = 64, HALF = 128, HTB = HALF * BK * 2, STAGE_BYTES = 8 * HTB, NXCD = 8, WGM = 8;
__host__ __device__ __forceinline__ int lds_byte(int r, int c) { const int st = (r >> 4) * 2 + (c >> 5), rr = r & 15, cc = c & 31, ob = rr * 64 + cc * 2; return st * 1024 + (ob ^ (((ob >> 9) & 1) << 5)); }
__host__ __device__ __forceinline__ void stage_rc(int b, int& R, int& C) { const int st = b / 1024, sb = b % 1024, swz = sb ^ (((sb >> 9) & 1) << 5); R = (st >> 1) * 16 + swz / 64; C = (st & 1) * 32 + (swz % 64) / 2; }
__host__ __device__ __forceinline__ int perm32(int rho) { const int n = rho >> 4, i = rho & 15; return 8 * (i >> 2) + 4 * n + (i & 3); }

struct Unit { int pm, pn; };
struct Gemm { const bf16_t* A; const bf16_t* Bt; int M, N, K; int lda; int kpairA; };

struct StaticOrder {
    int nM, nN, nwg, G, c;
    __host__ __device__ void init(int M, int N, int G_, int c_) { nM = M / BM; nN = N / BM; nwg = nM * nN; G = G_; c = c_; }
    __host__ __device__ bool next(int i, Unit& u) const {
        const long L = (long)i * G + c; if (L >= nwg) return false;
        int wgid = (int)L; { const int q = nwg / NXCD, r = nwg % NXCD, xcd = wgid % NXCD, off = wgid / NXCD; wgid = (xcd < r ? xcd * (q + 1) : r * (q + 1) + (xcd - r) * q) + off; }
        const int nig = WGM * nN, gid = wgid / nig, fm = gid * WGM, gsz = (nM - fm) < WGM ? (nM - fm) : WGM;
        u.pm = fm + ((wgid % nig) % gsz); u.pn = (wgid % nig) / gsz; return true;
    }
};

DI void store8(bf16_t* p, f32x4 v0, f32x4 v1, float sc) {
    u32x4 w; w.x = pk2(v0[0] * sc, v0[1] * sc); w.y = pk2(v0[2] * sc, v0[3] * sc); w.z = pk2(v1[0] * sc, v1[1] * sc); w.w = pk2(v1[2] * sc, v1[3] * sc);
    *(u32x4*)p = w;
}
template <bool GATES> struct EpiSeg {
    static constexpr bool PERM = true;
    bf16_t *p0, *p1, *p2, *p3; int ld0, ld1, ld2, ld3; int e0, e1, e2; float s0, s1, s2, s3;
    float* gates; const float* gbias; int gblk;
    const float* rowscale;
    DI void operator()(const f32x4 (&acc)[2][2][4][2], const Unit& u, int wr, int wc, int fr, int fq) const {
        const int row0 = u.pm * BM + wr * 64 + fr;
#define RS_(ai, m) (rowscale ? rowscale[row0 + (ai) * HALF + (m) * 16] : 1.f)
#pragma unroll
        for (int bj = 0; bj < 2; ++bj) {
            const int blk = 2 * u.pn + bj;
            if (GATES && blk >= gblk) {
                if (blk == gblk && wc == 0) {
                    const f32x4 b0 = *(const f32x4*)(gbias + 8 * fq), b1 = *(const f32x4*)(gbias + 8 * fq + 4);
#pragma unroll
                    for (int ai = 0; ai < 2; ++ai)
#pragma unroll
                        for (int m = 0; m < 4; ++m) { float* gp = gates + (size_t)(row0 + ai * HALF + m * 16) * 32 + 8 * fq;
                            const float r_ = RS_(ai, m); *(f32x4*)gp = acc[ai][bj][m][0] * r_ + b0; *(f32x4*)(gp + 4) = acc[ai][bj][m][1] * r_ + b1; }
                }
                continue;
            }
            bf16_t* base; int ld, b0; float sc;
            if (blk < e0) { base = p0; ld = ld0; b0 = 0; sc = s0; }
            else if (blk < e1) { base = p1; ld = ld1; b0 = e0; sc = s1; }
            else if (blk < e2) { base = p2; ld = ld2; b0 = e1; sc = s2; }
            else { base = p3; ld = ld3; b0 = e2; sc = s3; }
            bf16_t* cp = base + (blk - b0) * 128 + wc * 32 + 8 * fq;
#pragma unroll
            for (int ai = 0; ai < 2; ++ai)
#pragma unroll
                for (int m = 0; m < 4; ++m) store8(cp + (size_t)(row0 + ai * HALF + m * 16) * ld, acc[ai][bj][m][0], acc[ai][bj][m][1], sc * RS_(ai, m));
        }
#undef RS_
    }
};
DI EpiSeg<false> epi_plain(bf16_t* O, int ld, float sc, const float* rowscale = nullptr) { EpiSeg<false> E{}; E.p0 = O; E.ld0 = ld; E.e0 = 100000; E.e1 = 100000; E.e2 = 100000; E.s0 = sc; E.rowscale = rowscale; return E; }
struct EpiF32 {
    static constexpr bool PERM = true;
    float* O; int ld;
    DI void operator()(const f32x4 (&acc)[2][2][4][2], const Unit& u, int wr, int wc, int fr, int fq) const {
        const int row0 = u.pm * BM + wr * 64 + fr;
#pragma unroll
        for (int bj = 0; bj < 2; ++bj) { float* cp = O + u.pn * 256 + bj * 128 + wc * 32 + 8 * fq;
#pragma unroll
            for (int ai = 0; ai < 2; ++ai)
#pragma unroll
                for (int m = 0; m < 4; ++m) { float* rp = cp + (size_t)(row0 + ai * HALF + m * 16) * ld; *(f32x4*)rp = acc[ai][bj][m][0]; *(f32x4*)(rp + 4) = acc[ai][bj][m][1]; } }
    }
};
struct EpiMlaKV {
    static constexpr bool PERM = true;
    bf16_t* KF; bf16_t* V;
    DI void operator()(const f32x4 (&acc)[2][2][4][2], const Unit& u, int wr, int wc, int fr, int fq) const {
        const int row0 = u.pm * BM + wr * 64 + fr;
#pragma unroll
        for (int bj = 0; bj < 2; ++bj) {
            bf16_t* cp = (bj == 0 ? KF + u.pn * 192 : V + u.pn * 128) + wc * 32 + 8 * fq; const int ld = (bj == 0) ? 1536 : 1024;
#pragma unroll
            for (int ai = 0; ai < 2; ++ai)
#pragma unroll
                for (int m = 0; m < 4; ++m) store8(cp + (size_t)(row0 + ai * HALF + m * 16) * ld, acc[ai][bj][m][0], acc[ai][bj][m][1], 1.f);
        }
    }
};
struct EpiFfnUp {
    static constexpr bool PERM = true;
    bf16_t* U; bf16_t* HALO; const float* rowscale;
    DI void operator()(const f32x4 (&acc)[2][2][4][2], const Unit& u, int wr, int wc, int fr, int fq) const {
        const int row0 = u.pm * BM + wr * 64 + fr;
        float rs[2][4];
#pragma unroll
        for (int ai = 0; ai < 2; ++ai)
#pragma unroll
            for (int m = 0; m < 4; ++m) rs[ai][m] = rowscale[row0 + ai * HALF + m * 16];
#pragma unroll
        for (int bj = 0; bj < 2; ++bj) {
            const int col = u.pn * 256 + bj * 128 + wc * 32 + 8 * fq;
#pragma unroll
            for (int ai = 0; ai < 2; ++ai)
#pragma unroll
                for (int m = 0; m < 4; ++m) {
                    const int row = row0 + ai * HALF + m * 16;
                    store8(U + (size_t)row * FFN_U + col, acc[ai][bj][m][0], acc[ai][bj][m][1], rs[ai][m]);
                    if (fr == 0 || fr == 15) store8(HALO + ((size_t)(row >> 4) * 2 + (fr == 15 ? 1 : 0)) * FFN_U + col, acc[ai][bj][m][0], acc[ai][bj][m][1], rs[ai][m]);
                }
        }
    }
};

template <class Epi>
DI void gemm_phase(LAS unsigned char* lds, const int tid, const Gemm g, const StaticOrder& S, const Epi& E) {
    const int wid = __builtin_amdgcn_readfirstlane(tid >> 6), lane = tid & 63, wr = wid >> 2, wc = wid & 3, fr = lane & 15, fq = lane >> 4;
    const int K = g.K; int nt = K / BK; asm volatile("" : "+s"(nt));
    unsigned voffA[2], voffB[2];
#pragma unroll
    for (int i = 0; i < 2; ++i) { int R, C; stage_rc(tid * 16 + i * 8192, R, C); const int Rb = Epi::PERM ? ((R & ~31) + perm32(R & 31)) : R;
        voffA[i] = (unsigned)(R * g.lda + C) * 2u; voffB[i] = (unsigned)(Rb * K + C) * 2u; }
    const size_t kstep = (size_t)(BK * 2);
    const size_t kpairA = (size_t)g.kpairA;
    const size_t hstepA = (size_t)HALF * g.lda * 2, hstepB = (size_t)HALF * K * 2;
    const size_t tstepA = 2 * hstepA, tstepB = 2 * hstepB;
    const unsigned ldsw = (unsigned)wid * 1024u;
    const int aoff = lds_byte(wr * 64 + fr, fq * 8), boff = lds_byte(wc * 32 + fr, fq * 8);
#define PG8_SA(b, h) (((b) * 2 + (h)) * HTB)
#define PG8_SB(b, h) ((4 + (b) * 2 + (h)) * HTB)
#define PG8_STAGE(bufoff, gbase, voff) do { _Pragma("unroll") for (int _i = 0; _i < 2; ++_i) \
        __builtin_amdgcn_global_load_lds((const unsigned*)((const char*)(gbase) + (voff)[_i]), (LAS unsigned*)(lds + (bufoff) + ldsw + _i * 8192), 16, 0, 0); } while (0)
#define PG8_LDA(dst, b, h) do { _Pragma("unroll") for (int m = 0; m < 4; ++m) _Pragma("unroll") for (int k = 0; k < 2; ++k) dst[m][k] = *(const LAS bf16x8*)(lds + PG8_SA(b, h) + aoff + m * 2048 + k * 1024); } while (0)
#define PG8_LDB(dst, b, h) do { _Pragma("unroll") for (int n = 0; n < 2; ++n) _Pragma("unroll") for (int k = 0; k < 2; ++k) dst[n][k] = *(const LAS bf16x8*)(lds + PG8_SB(b, h) + boff + n * 2048 + k * 1024); } while (0)
#define PG8_MMA(ai, bj, At, Bt) do { __builtin_amdgcn_s_setprio(1); _Pragma("unroll") for (int m = 0; m < 4; ++m) _Pragma("unroll") for (int n = 0; n < 2; ++n) _Pragma("unroll") for (int k = 0; k < 2; ++k) \
        acc[ai][bj][m][n] = __builtin_amdgcn_mfma_f32_16x16x32_bf16(Bt[n][k], At[m][k], acc[ai][bj][m][n], 0, 0, 0); __builtin_amdgcn_s_setprio(0); } while (0)
#define PG8_WAIT_V(n) asm volatile("s_waitcnt vmcnt(" #n ")" ::: "memory")
#define PG8_WAIT_L(n) asm volatile("s_waitcnt lgkmcnt(" #n ")" ::: "memory")
#define PG8_BAR __builtin_amdgcn_s_barrier()
#define PG8_SCHED __builtin_amdgcn_sched_barrier(0)
    Unit cur, nxt; int ui = 0;
    if (!S.next(0, cur)) return;
    f32x4 acc[2][2][4][2];
#pragma unroll
    for (int a = 0; a < 2; ++a)
#pragma unroll
        for (int b = 0; b < 2; ++b)
#pragma unroll
            for (int m = 0; m < 4; ++m)
#pragma unroll
                for (int n = 0; n < 2; ++n) acc[a][b][m][n] = (f32x4){0.f, 0.f, 0.f, 0.f};
    bf16x8 At[4][2], B0[2][2], B1[2][2];
    const char* cA = (const char*)g.A + (size_t)cur.pm * tstepA; const char* cB = (const char*)g.Bt + (size_t)cur.pn * tstepB;
    PG8_STAGE(PG8_SB(0, 0), cB, voffB); PG8_STAGE(PG8_SB(0, 1), cB + hstepB, voffB); PG8_STAGE(PG8_SA(0, 0), cA, voffA); PG8_STAGE(PG8_SA(0, 1), cA + hstepA, voffA);
    if (wr == 1) PG8_BAR;
    PG8_WAIT_V(2); PG8_BAR;
    PG8_STAGE(PG8_SB(1, 0), cB + kstep, voffB); PG8_STAGE(PG8_SA(1, 0), cA + kstep, voffA); PG8_STAGE(PG8_SB(1, 1), cB + hstepB + kstep, voffB);
    PG8_WAIT_V(6); PG8_BAR;
    for (;;) {
        const bool has_next = S.next(ui + 1, nxt);
        const char* nA = has_next ? (const char*)g.A + (size_t)nxt.pm * tstepA : cA; const char* nB = has_next ? (const char*)g.Bt + (size_t)nxt.pn * tstepB : cB;
#pragma unroll 1
        for (int t = 0; t < nt; t += 2) {
            const bool last = (t == nt - 2);
            const char* a1 = cA + (size_t)(t >> 1) * kpairA + kstep;
            const char* a2 = last ? nA : cA + (size_t)((t >> 1) + 1) * kpairA; const char* b2 = last ? nB : cB + (size_t)(t + 2) * kstep;
            const char* a3 = a2 + kstep; const char* b3 = b2 + kstep;
            PG8_LDB(B0, 0, 0); PG8_LDB(B1, 0, 1); PG8_SCHED; PG8_LDA(At, 0, 0); PG8_STAGE(PG8_SA(1, 1), a1 + hstepA, voffA);
            PG8_WAIT_V(8); PG8_WAIT_L(0); PG8_BAR; PG8_MMA(0, 0, At, B0); PG8_MMA(0, 1, At, B1); PG8_BAR; PG8_SCHED;
            PG8_LDA(At, 0, 1); PG8_STAGE(PG8_SB(0, 0), b2, voffB); PG8_STAGE(PG8_SB(0, 1), b2 + hstepB, voffB); PG8_STAGE(PG8_SA(0, 0), a2, voffA);
            PG8_WAIT_V(8); PG8_WAIT_L(0); PG8_BAR; PG8_MMA(1, 0, At, B0); PG8_MMA(1, 1, At, B1); PG8_BAR; PG8_SCHED;
            PG8_LDB(B0, 1, 0); PG8_LDB(B1, 1, 1); PG8_SCHED; PG8_LDA(At, 1, 0); PG8_STAGE(PG8_SA(0, 1), a2 + hstepA, voffA);
            PG8_WAIT_V(8); PG8_WAIT_L(0); PG8_BAR; PG8_MMA(0, 0, At, B0); PG8_MMA(0, 1, At, B1); PG8_BAR; PG8_SCHED;
            PG8_LDA(At, 1, 1); PG8_STAGE(PG8_SB(1, 0), b3, voffB); PG8_STAGE(PG8_SB(1, 1), b3 + hstepB, voffB); PG8_STAGE(PG8_SA(1, 0), a3, voffA);
            PG8_WAIT_V(8); PG8_WAIT_L(0); PG8_BAR; PG8_MMA(1, 0, At, B0); PG8_MMA(1, 1, At, B1); PG8_BAR; PG8_SCHED;
        }
        if (wr == 0) PG8_BAR;
        E(acc, cur, wr, wc, fr, fq);
        if (!has_next) break;
#pragma unroll
        for (int a = 0; a < 2; ++a)
#pragma unroll
            for (int b = 0; b < 2; ++b)
#pragma unroll
                for (int m = 0; m < 4; ++m)
#pragma unroll
                    for (int n = 0; n < 2; ++n) acc[a][b][m][n] = (f32x4){0.f, 0.f, 0.f, 0.f};
        cur = nxt; cA = nA; cB = nB; ++ui;
        if (wr == 1) PG8_BAR;
    }
    PG8_WAIT_V(0);
    PG8_BAR;
#undef PG8_SA
#undef PG8_SB
#undef PG8_STAGE
#undef PG8_LDA
#undef PG8_LDB
#undef PG8_MMA
#undef PG8_WAIT_V
#undef PG8_WAIT_L
#undef PG8_BAR
#undef PG8_SCHED
}
}

namespace att {
constexpr int NW = 8, QBLK = 32, KVBLK = 64, DV = 128;
constexpr float THR2 = 8.f;
#define SBAR() __builtin_amdgcn_sched_barrier(0)
DI unsigned cvtpk(float lo, float hi) { unsigned r; asm volatile("v_cvt_pk_bf16_f32 %0, %1, %2" : "=v"(r) : "v"(lo), "v"(hi)); return r; }
DI void partialSM(f32x16& p0, f32x16& p1, float& m_reg, float& mn, float& alpha) {
    float pmax = p0[0];
#pragma unroll
    for (int r = 1; r < 16; ++r) pmax = fmaxf(pmax, p0[r]);
#pragma unroll
    for (int r = 0; r < 16; ++r) pmax = fmaxf(pmax, p1[r]);
    { auto rr = __builtin_amdgcn_permlane32_swap(__float_as_uint(pmax), __float_as_uint(pmax), false, false);
      pmax = fmaxf(__uint_as_float(rr[0]), __uint_as_float(rr[1])); }
    if (__builtin_expect(__all(pmax - m_reg <= THR2), 1)) { mn = m_reg; alpha = 1.f; }
    else { mn = fmaxf(m_reg, pmax); alpha = __builtin_amdgcn_exp2f(m_reg - mn); m_reg = mn; }
#pragma unroll
    for (int r = 0; r < 16; ++r) p0[r] = p0[r] - mn;
#pragma unroll
    for (int r = 0; r < 16; ++r) p1[r] = p1[r] - mn;
#pragma unroll
    for (int r = 0; r < 16; ++r) p0[r] = __builtin_amdgcn_exp2f(p0[r]);
}
DI void finishSM(f32x16& p0, f32x16& p1, float alpha, float& l_reg, bf16x8& pa0, bf16x8& pa1, bf16x8& pa2, bf16x8& pa3) {
#pragma unroll
    for (int r = 0; r < 16; ++r) p1[r] = __builtin_amdgcn_exp2f(p1[r]);
    float ps = 0;
#pragma unroll
    for (int r = 0; r < 16; ++r) ps += p0[r];
#pragma unroll
    for (int r = 0; r < 16; ++r) ps += p1[r];
    { auto rr = __builtin_amdgcn_permlane32_swap(__float_as_uint(ps), __float_as_uint(ps), false, false);
      ps = __uint_as_float(rr[0]) + __uint_as_float(rr[1]); }
    l_reg = l_reg * alpha + ps;
#define PK4(P, BASE, OUT) do { unsigned a0 = cvtpk(P[BASE + 0], P[BASE + 1]), a1 = cvtpk(P[BASE + 2], P[BASE + 3]);   \
    unsigned b0 = cvtpk(P[BASE + 4], P[BASE + 5]), b1 = cvtpk(P[BASE + 6], P[BASE + 7]);                              \
    auto r0 = __builtin_amdgcn_permlane32_swap(a0, b0, false, false); auto r1 = __builtin_amdgcn_permlane32_swap(a1, b1, false, false); \
    u32x4 w = {r0[0], r1[0], r0[1], r1[1]}; OUT = *reinterpret_cast<bf16x8*>(&w); } while (0)
    PK4(p0, 0, pa0); PK4(p0, 8, pa1); PK4(p1, 0, pa2); PK4(p1, 8, pa3);
#undef PK4
}
DI int v_st(int k, int c) { const int kk = (k & ~0xC) | ((k & 4) << 1) | ((k & 8) >> 1); return ((kk >> 3) * 4 + (c >> 5)) * 512 + ((kk & 7) * 32 + (c & 31)) * 2; }
DI int v_rd_base(int lane) { return ((lane & 3) << 3) | (((lane >> 2) & 3) << 6) | (((lane >> 4) & 1) << 5) | (((lane >> 5) & 1) << 8); }
constexpr int v_rd_off(int d0, int ks, int half) { return d0 * 512 + ks * 4096 + half * 2048; }
template <int OFF> DI s16x4 tr_read(int vb) {
    s16x4 r; asm volatile("ds_read_b64_tr_b16 %0, %1 offset:%2" : "=&v"(r) : "v"(vb), "i"(OFF) : "memory"); return r;
}
template <int D0> DI void pv_one(f32x16& od, int vb, bf16x8 pa0, bf16x8 pa1, bf16x8 pa2, bf16x8 pa3) {
    const s16x4 l0 = tr_read<v_rd_off(D0, 0, 0)>(vb), h0 = tr_read<v_rd_off(D0, 0, 1)>(vb), l1 = tr_read<v_rd_off(D0, 1, 0)>(vb), h1 = tr_read<v_rd_off(D0, 1, 1)>(vb);
    const s16x4 l2 = tr_read<v_rd_off(D0, 2, 0)>(vb), h2 = tr_read<v_rd_off(D0, 2, 1)>(vb), l3 = tr_read<v_rd_off(D0, 3, 0)>(vb), h3 = tr_read<v_rd_off(D0, 3, 1)>(vb);
    asm volatile("s_waitcnt lgkmcnt(0)" ::: "memory"); SBAR();
#define PK(L, H) (bf16x8){L[0], L[1], L[2], L[3], H[0], H[1], H[2], H[3]}
    od = MFMA32(pa0, PK(l0, h0), od);
    od = MFMA32(pa1, PK(l1, h1), od);
    od = MFMA32(pa2, PK(l2, h2), od);
    od = MFMA32(pa3, PK(l3, h3), od);
#undef PK
}
DI void pv_d0(f32x16* o, int vb, bf16x8 pa0, bf16x8 pa1, bf16x8 pa2, bf16x8 pa3) {
    pv_one<0>(o[0], vb, pa0, pa1, pa2, pa3); pv_one<1>(o[1], vb, pa0, pa1, pa2, pa3); pv_one<2>(o[2], vb, pa0, pa1, pa2, pa3); pv_one<3>(o[3], vb, pa0, pa1, pa2, pa3);
}

template <int DQK> struct Cfg {
    static constexpr int KROWB = DQK * 2 + 16;
    static constexpr int SHM_V = KVBLK * DV * 2, SHM_K = KVBLK * KROWB;
    static constexpr int SHM = 2 * SHM_V + 2 * SHM_K + NW * 64 * 4 + NW * 4096;
    static constexpr int NKC = DQK / 64;
    static constexpr int CPR = DQK / 8;
};
template <int DQK, bool ALIBI, bool ROPE, int ldq, int ldk, int ldv, int ldo>
DI void attn_unit(const bf16* __restrict__ Qb, const bf16* __restrict__ Kh, const bf16* __restrict__ Vh,
                  bf16* __restrict__ Ob, int seq, float slope2, int qpos0, const float* __restrict__ rope, char* lds, const int tid_in, const float kmax) {
    using C = Cfg<DQK>;
    constexpr int ND = DQK / 16;
    int tid = tid_in; asm volatile("" : "+v"(tid));
    const int wid = tid >> 6, lane = tid & 63, r32 = lane & 31, hi = lane >> 5;
    char* V_lds = lds; char* K_lds = lds + 2 * C::SHM_V;
    float* ws = (float*)(lds + 2 * C::SHM_V + 2 * C::SHM_K) + wid * 64; float* li_l = ws; float* al_l = ws + 32;
    float m_reg = -1e30f, l_reg = 0; f32x16 o[4] = {}; bf16x8 qr[ND];
    const bf16* Qw = Qb + (long)(wid * QBLK + r32) * ldq + hi * 8;
#pragma unroll
    for (int d0 = 0; d0 < ND; ++d0) qr[d0] = *reinterpret_cast<const bf16x8*>(Qw + d0 * 16);
    char* qrope = lds + 2 * C::SHM_V + 2 * C::SHM_K + NW * 64 * 4 + wid * 4096 + lane * 16;
    if (ROPE) {
        const float* rp = rope + (size_t)(qpos0 + wid * QBLK + r32) * 64;
#pragma unroll
        for (int d0 = ND - 4; d0 < ND; ++d0) {
            const f32x4 c0 = *(const f32x4*)(rp + (8 * (d0 - (ND - 4)) + 4 * hi) * 2), c1 = *(const f32x4*)(rp + (8 * (d0 - (ND - 4)) + 4 * hi) * 2 + 4);
            const u32x4 w = __builtin_bit_cast(u32x4, qr[d0]); u32x4 o_;
            { const float a = bflo(w[0]), b = bfhi(w[0]); o_[0] = pk2(a * c0[0] - b * c0[1], a * c0[1] + b * c0[0]); }
            { const float a = bflo(w[1]), b = bfhi(w[1]); o_[1] = pk2(a * c0[2] - b * c0[3], a * c0[3] + b * c0[2]); }
            { const float a = bflo(w[2]), b = bfhi(w[2]); o_[2] = pk2(a * c1[0] - b * c1[1], a * c1[1] + b * c1[0]); }
            { const float a = bflo(w[3]), b = bfhi(w[3]); o_[3] = pk2(a * c1[2] - b * c1[3], a * c1[3] + b * c1[2]); }
            *(u32x4*)(qrope + (d0 - (ND - 4)) * 1024) = o_;
        }
    }
    const int sr = tid >> 4, sc = (tid & 15) * 8, vst0 = v_st(sr, sc), vst1 = v_st(32 + sr, sc);
    int krow[C::NKC], kcol[C::NKC], kdst[C::NKC];
#pragma unroll
    for (int i = 0; i < C::NKC; ++i) { const int c = tid + 512 * i; krow[i] = c / C::CPR; kcol[i] = (c % C::CPR) * 8; kdst[i] = krow[i] * C::KROWB + kcol[i] * 2; }
    const int vb0 = (int)(uintptr_t)V_lds + v_rd_base(lane);
    const float qposh = (float)(qpos0 + wid * QBLK + r32 - 4 * hi);
    constexpr int SD = (DQK <= 64) ? 2 : 1;
    struct { bf16x8 vs0, vs1, ks[C::NKC]; } st_[SD];
#define SLOAD(s_, k0) do { st_[s_].vs0 = *reinterpret_cast<const bf16x8*>(&Vh[(long)((k0) + sr) * ldv + sc]); st_[s_].vs1 = *reinterpret_cast<const bf16x8*>(&Vh[(long)((k0) + 32 + sr) * ldv + sc]); \
    _Pragma("unroll") for (int i_ = 0; i_ < C::NKC; ++i_) st_[s_].ks[i_] = *reinterpret_cast<const bf16x8*>(&Kh[(long)((k0) + krow[i_]) * ldk + kcol[i_]]); } while (0)
#define SWRITE(s_, b) do { *(bf16x8*)(V_lds + (b) * C::SHM_V + vst0) = st_[s_].vs0; *(bf16x8*)(V_lds + (b) * C::SHM_V + vst1) = st_[s_].vs1; \
    _Pragma("unroll") for (int i_ = 0; i_ < C::NKC; ++i_) *(bf16x8*)(K_lds + (b) * C::SHM_K + kdst[i_]) = st_[s_].ks[i_]; } while (0)
#define SWAIT() asm volatile("s_waitcnt vmcnt(0)" ::: "memory")
#define RESC(a) do { if (__any((a) < 1.f)) { if (hi == 0) al_l[r32] = (a); asm volatile("s_waitcnt lgkmcnt(0)" ::: "memory"); \
    _Pragma("unroll") for (int d = 0; d < 4; ++d) _Pragma("unroll") for (int r = 0; r < 16; ++r) o[d][r] *= al_l[crow(r, hi)]; } } while (0)
#define KLD(i_, KB, d0_) do { const int cb_ = ((d0_) * 16 + hi * 8) * 2; kb0[i_] = *reinterpret_cast<const bf16x8*>((KB) + r32 * C::KROWB + cb_); kb1[i_] = *reinterpret_cast<const bf16x8*>((KB) + (32 + r32) * C::KROWB + cb_); } while (0)
#define QKT(P0, P1, KB, k0) do { P0 = f32x16{}; P1 = f32x16{}; bf16x8 kb0[3], kb1[3]; \
    KLD(0, KB, 0); KLD(1, KB, 1); \
    _Pragma("unroll") for (int d0 = 0; d0 < ND; ++d0) { \
        if (d0 + 2 < ND) KLD((d0 + 2) % 3, KB, d0 + 2); \
        SBAR(); \
        const bf16x8 qf_ = (ROPE && d0 >= ND - 4) ? *reinterpret_cast<const bf16x8*>(qrope + (d0 - (ND - 4)) * 1024) : qr[d0]; \
        P0 = MFMA32(kb0[d0 % 3], qf_, P0); P1 = MFMA32(kb1[d0 % 3], qf_, P1); SBAR(); } \
    if (ALIBI) { const float kb_ = qposh - (float)(k0); \
        _Pragma("unroll") for (int r = 0; r < 16; ++r) { const float d_ = kb_ - (float)((r & 3) + 8 * (r >> 2)); P0[r] -= slope2 * fabsf(d_); P1[r] -= slope2 * fabsf(d_ - 32.f); } } } while (0)
    f32x16 pA0, pA1; float mnA, alA; bf16x8 pa0, pa1, pa2, pa3; int NT = seq / KVBLK; int jlo = 0;
    if (ALIBI) {
        float sq = 0.f;
#pragma unroll
        for (int d0 = 0; d0 < ND; ++d0) { const u32x4 w = __builtin_bit_cast(u32x4, qr[d0]);
#pragma unroll
            for (int q4 = 0; q4 < 4; ++q4) sq += bflo(w[q4]) * bflo(w[q4]) + bfhi(w[q4]) * bfhi(w[q4]); }
        sq += __shfl_xor(sq, 32);
#pragma unroll
        for (int o_ = 1; o_ < 32; o_ <<= 1) sq = fmaxf(sq, __shfl_xor(sq, o_));
        if (lane == 0) ws[63] = sq;
        __syncthreads();
        float qm = 0.f;
#pragma unroll
        for (int w_ = 0; w_ < NW; ++w_) qm = fmaxf(qm, ((const float*)(lds + 2 * C::SHM_V + 2 * C::SHM_K))[w_ * 64 + 63]);
        const float bound = 2.f * sqrtf(qm) * kmax * 1.01f + 40.f;
        const float dc = fminf(bound / slope2, 16384.f);
        const int dcut = (int)dc + 1;
        const int a_ = qpos0 - dcut; jlo = a_ > 0 ? (a_ >> 6) : 0;
        const int b_ = (qpos0 + QBLK * NW - 1 + dcut) >> 6; NT = b_ + 1 < NT ? b_ + 1 : NT;
    }
    const int nT = NT - jlo;
    SLOAD(0, jlo * KVBLK); SWAIT(); SWRITE(0, 0);
    if (1 < nT) SLOAD(SD - 1, (jlo + 1) * KVBLK);
    if (SD == 2 && 2 < nT) SLOAD(0, (jlo + 2) * KVBLK);
    __syncthreads();
#define STG(t, P) do { if ((t) + 1 < nT) { if (SD == 1) SWAIT(); SWRITE((SD == 2 ? (P) : 0), (P)); } if ((t) + 1 + SD < nT) SLOAD((SD == 2 ? (P) : 0), (jlo + (t) + 1 + SD) * KVBLK); } while (0)
#define H1(t, B) do { SBAR(); QKT(pA0, pA1, K_lds + (B) * C::SHM_K, (jlo + (t)) * KVBLK); partialSM(pA0, pA1, m_reg, mnA, alA); RESC(alA); } while (0)
#define H2(t, B) do { finishSM(pA0, pA1, alA, l_reg, pa0, pa1, pa2, pa3); SBAR(); pv_d0(o, vb0 + (B) * C::SHM_V, pa0, pa1, pa2, pa3); } while (0)
    if (__builtin_amdgcn_readfirstlane(wid) < 4) {
        int t = 0;
#pragma unroll 1
        for (; t + 1 < nT; t += 2) { H1(t, 0); __syncthreads(); STG(t, 1); H2(t, 0); __syncthreads(); H1(t + 1, 1); __syncthreads(); STG(t + 1, 0); H2(t + 1, 1); __syncthreads(); }
        if (t < nT) { H1(t, 0); __syncthreads(); STG(t, 1); H2(t, 0); __syncthreads(); }
        __syncthreads();
    } else {
        __syncthreads();
        int t = 0;
#pragma unroll 1
        for (; t + 1 < nT; t += 2) { STG(t, 1); H1(t, 0); __syncthreads(); H2(t, 0); __syncthreads(); STG(t + 1, 0); H1(t + 1, 1); __syncthreads(); H2(t + 1, 1); __syncthreads(); }
        if (t < nT) { STG(t, 1); H1(t, 0); __syncthreads(); H2(t, 0); __syncthreads(); }
    }
#undef STG
#undef H1
#undef H2
    if (hi == 0) li_l[r32] = l_reg; asm volatile("s_waitcnt lgkmcnt(0)" ::: "memory");
    float rli[16];
#pragma unroll
    for (int r = 0; r < 16; ++r) rli[r] = __builtin_amdgcn_rcpf(li_l[crow(r, hi)]);
    bf16* Ow = Ob + (long)(wid * QBLK) * ldo;
#pragma unroll
    for (int r = 0; r < 16; ++r) { const int orow = crow(r, hi);
#pragma unroll
        for (int d0 = 0; d0 < 4; ++d0) Ow[(long)orow * ldo + d0 * 32 + r32] = f2bf(o[d0][r] * rli[r]); }
    __syncthreads();
#undef SLOAD
#undef SWRITE
#undef SWAIT
#undef RESC
#undef QKT
#undef KLD
}
#undef SBAR
}

#define XB_TMO      128
#define XB_XCNT(j)  (256  + 64 * (j))
#define XB_XSUB(j)  (1280 + 64 * (j))
#define XB_XGEN(j)  (2304 + 64 * (j))
#define XB_TOP      3328
#define XB_TOPGEN   3392
#define XCD_BAR_WORDS 3456
#define XB_SPIN_CAP (1u << 18)
DI unsigned xb_ld(unsigned* p)              { return __hip_atomic_load(p, __ATOMIC_RELAXED, __HIP_MEMORY_SCOPE_AGENT); }
DI unsigned xb_add(unsigned* p, unsigned v) { return __hip_atomic_fetch_add(p, v, __ATOMIC_RELAXED, __HIP_MEMORY_SCOPE_AGENT); }
DI unsigned xb_xcc_id() { return (unsigned)__builtin_amdgcn_s_getreg((3 << 11) | 20) & 0xFu; }
#define XB_SPIN(cond, bar) do { unsigned _sp = 0; while (cond) { __builtin_amdgcn_s_sleep(1); \
    if ((++_sp & 255u) == 0u) { if (xb_ld(&(bar)[XB_TMO])) break; if (_sp > XB_SPIN_CAP) { atomicAdd(&(bar)[XB_TMO], 1u); break; } } } } while (0)
struct XcdBarrier { unsigned* bar; unsigned x; volatile LAS unsigned* st; };
DI XcdBarrier xcd_barrier_post(unsigned* bar, volatile LAS unsigned* st) {
    XcdBarrier b; b.bar = bar; b.x = xb_xcc_id(); b.st = st;
    if (threadIdx.x == 0) (void)xb_add(&bar[XB_XCNT(b.x)], 1u);
    return b;
}
DI void xcd_barrier_complete(unsigned* bar, unsigned x, unsigned& nloc, unsigned& nx) {
    const unsigned G = gridDim.x * gridDim.y * gridDim.z;
    unsigned sum, cnt, mine, sp = 0u;
    for (;;) {
        sum = 0u; cnt = 0u; mine = 0u;
#pragma unroll
        for (unsigned j = 0; j < 16; ++j) { const unsigned c = xb_ld(&bar[XB_XCNT(j)]); sum += c; cnt += (c > 0u) ? 1u : 0u; mine = (j == x) ? c : mine; }
        if (sum == G) break;
        __builtin_amdgcn_s_sleep(1);
        if ((++sp & 255u) == 0u) { if (xb_ld(&bar[XB_TMO])) break; if (sp > XB_SPIN_CAP) { atomicAdd(&bar[XB_TMO], 1u); break; } }
    }
    nloc = mine > 0u ? mine : 1u; nx = cnt > 0u ? cnt : 1u;
}
DI void xcd_barrier(const XcdBarrier& b) {
    asm volatile("s_waitcnt vmcnt(0)" ::: "memory");
    __syncthreads();
    if (threadIdx.x == 0) {
        unsigned* bar = b.bar;
        __builtin_amdgcn_s_waitcnt(0);
        unsigned nloc = b.st[0], nx = b.st[1];
        if (nloc == 0u) { xcd_barrier_complete(bar, b.x, nloc, nx); b.st[0] = nloc; b.st[1] = nx; }
        const unsigned old = xb_add(&bar[XB_XSUB(b.x)], 1u);
        const unsigned gen = old / nloc;
        if (old + 1u == (gen + 1u) * nloc) {
            __builtin_amdgcn_fence(__ATOMIC_RELEASE, "agent");
            asm volatile("s_waitcnt vmcnt(0)" ::: "memory");
            const unsigned og = xb_add(&bar[XB_TOP], 1u);
            const unsigned tg = og / nx;
            if (og + 1u == (tg + 1u) * nx) xb_add(&bar[XB_TOPGEN], 1u);
            else XB_SPIN(xb_ld(&bar[XB_TOPGEN]) == tg, bar);
            __builtin_amdgcn_fence(__ATOMIC_ACQUIRE, "agent");
            xb_add(&bar[XB_XGEN(b.x)], 1u);
            asm volatile("s_waitcnt vmcnt(0)" ::: "memory");
        } else {
            XB_SPIN(xb_ld(&bar[XB_XGEN(b.x)]) == gen, bar);
            __builtin_amdgcn_fence(__ATOMIC_ACQUIRE, "agent");
            asm volatile("s_waitcnt vmcnt(0)" ::: "memory");
        }
    }
    __syncthreads();
}

constexpr int RING_BYTES = 131072;
constexpr int LDSCTL_OFF = RING_BYTES, MISC_OFF = LDSCTL_OFF + 320;
constexpr int LDS_BYTES = 147456;

struct Ctx { LAS unsigned char* lds; int tid, lane, wave, G, bx, gw, NGW; };

enum { MAP_ID = 0, MAP_ROPEQ = 1, MAP_FFNUP = 2 };
DI int map_row(int kind, int n) {
    if (kind == MAP_ROPEQ) { const int h = n / 192, r = n % 192; if (r < 128) return n; const int i = r - 128; return h * 192 + 128 + ((i < 32) ? 2 * i : 2 * (i - 32) + 1); }
    if (kind == MAP_FFNUP) { if (n < FFN_H) return (n >> 7) * 256 + (n & 127); const int c = n - FFN_H; return (c >> 7) * 256 + 128 + (c & 127); }
    return n;
}
DI void transpose_item(const float* W, int K, int N, bf16* WT, int kind, int row_off, const float* kscale, LAS float* scr, int item, int lane) {
    const int nblk = N / 32, kb = item / nblk, nb = item % nblk, k0 = 64 * kb, n0 = 32 * nb;
#pragma unroll 8
    for (int i = 0; i < 32; ++i) { const int kk = 2 * i + (lane >> 5); const float sc_ = kscale ? kscale[k0 + kk] : 1.f; scr[kk * 33 + (lane & 31)] = W[(size_t)(k0 + kk) * N + n0 + (lane & 31)] * sc_; }
    asm volatile("s_waitcnt lgkmcnt(0)" ::: "memory");
    const int c = lane & 7;
#pragma unroll
    for (int j = 0; j < 4; ++j) { const int n = (lane >> 3) + 8 * j; const LAS float* s = scr + (8 * c) * 33 + n;
        u32x4 o; o.x = pk2(s[0 * 33], s[1 * 33]); o.y = pk2(s[2 * 33], s[3 * 33]); o.z = pk2(s[4 * 33], s[5 * 33]); o.w = pk2(s[6 * 33], s[7 * 33]);
        *(u32x4*)(WT + (size_t)(row_off + map_row(kind, n0 + n)) * K + k0 + 8 * c) = o; }
    asm volatile("s_waitcnt lgkmcnt(0)" ::: "memory");
}
struct TJob { const float* W; int K, N; bf16* WT; int kind, row_off; const float* kscale; };
template <int NJ> DI void run_transposes(const Ctx& c, const TJob (&jobs)[NJ]) {
    LAS float* scr = (LAS float*)(c.lds + c.wave * 16384);
    int total = 0;
#pragma unroll
    for (int j = 0; j < NJ; ++j) total += (jobs[j].K / 64) * (jobs[j].N / 32);
    for (int it = c.gw; it < total; it += c.NGW) {
        int r = it;
#pragma unroll
        for (int j = 0; j < NJ; ++j) { const int n = (jobs[j].K / 64) * (jobs[j].N / 32);
            if (r >= 0 && r < n) transpose_item(jobs[j].W, jobs[j].K, jobs[j].N, jobs[j].WT, jobs[j].kind, jobs[j].row_off, jobs[j].kscale, scr, r, c.lane);
            r -= n; }
    }
}
DI void zero_rows(const Ctx& c, bf16* WT, int K, int row0, int nrows) {
    for (int r = c.gw; r < nrows; r += c.NGW) { u32x4* p = (u32x4*)(WT + (size_t)(row0 + r) * K);
        for (int i = c.lane; i < K / 8; i += 64) p[i] = (u32x4){0u, 0u, 0u, 0u}; }
}

DI void load_row_f32(const float* row, int lane, f32x4 (&v)[4]) {
#pragma unroll
    for (int j = 0; j < 4; ++j) v[j] = *((const f32x4*)row + lane + 64 * j);
}
DI void load_row_bf16(const bf16* row, int lane, f32x4 (&v)[4]) {
#pragma unroll
    for (int j = 0; j < 4; ++j) { const u32x2 w = *((const u32x2*)row + lane + 64 * j); v[j] = (f32x4){bflo(w.x), bfhi(w.x), bflo(w.y), bfhi(w.y)}; }
}
DI void store_row_bf16(bf16* row, int lane, const f32x4 (&v)[4]) {
#pragma unroll
    for (int j = 0; j < 4; ++j) { u32x2 w; w.x = pk2(v[j][0], v[j][1]); w.y = pk2(v[j][2], v[j][3]); *((u32x2*)row + lane + 64 * j) = w; }
}
DI float sumsq4(const f32x4 (&v)[4]) { float s = 0.f;
#pragma unroll
    for (int j = 0; j < 4; ++j) s += (v[j][0] * v[j][0] + v[j][1] * v[j][1]) + (v[j][2] * v[j][2] + v[j][3] * v[j][3]);
    return s; }
DI void pass_first(const Ctx& c, const float* x, bf16* HB, float* RSTD) {
    for (int m = c.gw; m < MROWS; m += c.NGW) {
        f32x4 v[4]; load_row_f32(x + (size_t)m * DM, c.lane, v);
        const float ss = wave_sum(sumsq4(v));
        store_row_bf16(HB + (size_t)m * DM, c.lane, v);
        if (c.lane == 0) RSTD[m] = rsqrtf(ss * (1.f / DM) + EPS);
    }
}
DI void pass_res(const Ctx& c, const bf16* a, const float* g1, bf16* HB, float* RSTD) {
    f32x4 g1v[4]; load_row_f32(g1, c.lane, g1v);
    for (int m = c.gw; m < MROWS; m += c.NGW) {
        f32x4 v[4], b[4]; load_row_bf16(a + (size_t)m * DM, c.lane, v); load_row_bf16(HB + (size_t)m * DM, c.lane, b);
        const float rstd = rsqrtf(wave_sum(sumsq4(v)) * (1.f / DM) + EPS);
#pragma unroll
        for (int j = 0; j < 4; ++j) b[j] = b[j] + v[j] * rstd * g1v[j];
        const float ss = wave_sum(sumsq4(b));
        store_row_bf16(HB + (size_t)m * DM, c.lane, b);
        if (c.lane == 0) RSTD[m] = rsqrtf(ss * (1.f / DM) + EPS);
    }
}
DI void pass_final(const Ctx& c, float* out, const float* g1, const bf16* HB) {
    f32x4 g1v[4]; load_row_f32(g1, c.lane, g1v);
    for (int m = c.gw; m < MROWS; m += c.NGW) {
        f32x4 v[4], b[4]; load_row_f32(out + (size_t)m * DM, c.lane, v); load_row_bf16(HB + (size_t)m * DM, c.lane, b);
        const float rstd = rsqrtf(wave_sum(sumsq4(v)) * (1.f / DM) + EPS);
#pragma unroll
        for (int j = 0; j < 4; ++j) { b[j] = b[j] + v[j] * rstd * g1v[j]; *((f32x4*)(out + (size_t)m * DM) + c.lane + 64 * j) = b[j]; }
    }
}

__device__ const double ROPE_INV[32] = {
    1.0, 0.7498942093324559, 0.5623413251903491, 0.4216965034285822, 0.31622776601683794, 0.23713737056616552, 0.1778279410038923, 0.1333521432163324,
    0.1, 0.07498942093324558, 0.05623413251903491, 0.042169650342858224, 0.03162277660168379, 0.023713737056616554, 0.01778279410038923, 0.01333521432163324,
    0.01, 0.007498942093324558, 0.005623413251903491, 0.004216965034285823, 0.0031622776601683794, 0.0023713737056616554, 0.0017782794100389228, 0.001333521432163324,
    0.001, 0.0007498942093324559, 0.0005623413251903491, 0.00042169650342858224, 0.00031622776601683794, 0.00023713737056616554, 0.00017782794100389227, 0.0001333521432163324};
DI void fill_rope(const Ctx& c, float* rope) {
    for (int i = c.bx * NTHREADS + c.tid; i < SEQ * 32; i += c.G * NTHREADS) {
        const int pos = i >> 5, k = i & 31;
        const double t = (double)pos * ROPE_INV[k] * 0.15915494309189535;
        const float fr = (float)(t - (double)(long long)t);
        rope[2 * i] = __builtin_amdgcn_cosf(fr); rope[2 * i + 1] = __builtin_amdgcn_sinf(fr);
    }
}
DI void pass_mla_mid(const Ctx& c, const bf16* DQKV, const float* gq, const float* gkv, const float* rope, bf16* CQ, bf16* CKV, bf16* KF) {
    float gqv[6], gkvv[4];
#pragma unroll
    for (int i = 0; i < 6; ++i) gqv[i] = gq[c.lane + 64 * i];
#pragma unroll
    for (int i = 0; i < 4; ++i) gkvv[i] = gkv[c.lane + 64 * i];
    for (int m = c.gw; m < MROWS; m += c.NGW) {
        const bf16* row = DQKV + (size_t)m * 768;
        float xq[6], xk[4]; float sq = 0.f, sk = 0.f;
#pragma unroll
        for (int i = 0; i < 6; ++i) { xq[i] = bf2f(row[c.lane + 64 * i]); sq += xq[i] * xq[i]; }
#pragma unroll
        for (int i = 0; i < 4; ++i) { xk[i] = bf2f(row[384 + c.lane + 64 * i]); sk += xk[i] * xk[i]; }
        const float rq = rsqrtf(wave_sum(sq) * (1.f / 384.f) + EPS), rk = rsqrtf(wave_sum(sk) * (1.f / 256.f) + EPS);
#pragma unroll
        for (int i = 0; i < 6; ++i) CQ[(size_t)m * 384 + c.lane + 64 * i] = f2bf(xq[i] * rq * gqv[i]);
#pragma unroll
        for (int i = 0; i < 4; ++i) CKV[(size_t)m * 256 + c.lane + 64 * i] = f2bf(xk[i] * rk * gkvv[i]);
        const int i = c.lane & 31; const float x1 = bf2f(row[640 + i]), x2 = bf2f(row[672 + i]);
        const float* rp = rope + ((size_t)(m & (SEQ - 1)) * 32 + i) * 2; const float cs = rp[0], sn = rp[1];
        const float ov = (c.lane < 32) ? (x1 * cs - x2 * sn) : (x1 * sn + x2 * cs);
        const bf16 ob = f2bf(ov); const int idx = 2 * i + (c.lane >> 5);
#pragma unroll
        for (int h = 0; h < 8; ++h) KF[(size_t)m * 1536 + h * 192 + 128 + idx] = ob;
    }
}
constexpr int CW_KMAX = 8192, CW_QCTR = 8448;
DI void pass_kmax(const Ctx& c, const bf16* Kd, unsigned* ctl) {
    LAS float* red = (LAS float*)c.lds;
    for (int rb = c.bx; rb < MROWS / 128; rb += c.G) {
        float mx = 0.f;
        for (int i = 0; i < 16; ++i) {
            const bf16* row = Kd + (size_t)(rb * 128 + c.wave * 16 + i) * 1024 + 16 * c.lane;
            const u32x4 a = *(const u32x4*)row, b = *(const u32x4*)(row + 8);
            float s = 0.f;
#pragma unroll
            for (int q = 0; q < 4; ++q) s += bflo(a[q]) * bflo(a[q]) + bfhi(a[q]) * bfhi(a[q]) + bflo(b[q]) * bflo(b[q]) + bfhi(b[q]) * bfhi(b[q]);
            s += __shfl_xor(s, 1); s += __shfl_xor(s, 2);
            mx = fmaxf(mx, s);
        }
        __syncthreads();
        if ((c.lane & 3) == 0) red[c.wave * 16 + (c.lane >> 2)] = mx;
        __syncthreads();
        if (c.tid < 16) { float m = 0.f;
#pragma unroll
            for (int w = 0; w < NWAVES; ++w) m = fmaxf(m, red[w * 16 + c.tid]);
            atomicMax(ctl + CW_KMAX + ((rb * 128) / SEQ) * 16 + c.tid, __float_as_uint(sqrtf(m))); }
    }
}
template <int DQK, bool ALIBI, bool ROPE, int ldq, int qhs, int ldk, int khs, int ldv, int vhs, int vdiv, int ldo, int ohs, int nheads>
DI void attention_phase(const Ctx& c, const bf16* Q, const bf16* K, const bf16* V, bf16* O, const float* rope, unsigned* ctl) {
    constexpr int NU = BATCH * nheads * 32;
    if (!ALIBI) {
        for (int u = c.bx; u < NU; u += c.G) {
            const int xcd = u & 7, slot = (u >> 3) & 31, rnd = u >> 8, bh = xcd + 8 * rnd, qb = slot;
            const int b = bh / nheads, h = bh % nheads;
            const size_t row0 = (size_t)b * SEQ;
            att::attn_unit<DQK, ALIBI, ROPE, ldq, ldk, ldv, ldo>(Q + (row0 + qb * 256) * ldq + h * qhs, K + row0 * ldk + h * khs, V + row0 * ldv + (h / vdiv) * vhs,
                                       O + (row0 + qb * 256) * ldo + h * ohs, SEQ, 0.f, qb * 256, rope, (char*)c.lds, c.tid, 0.f);
        }
    } else {
        volatile LAS unsigned* qw = (volatile LAS unsigned*)(c.lds + LDSCTL_OFF);
        for (;;) {
            if (c.tid == 0) qw[0] = __hip_atomic_fetch_add(ctl + CW_QCTR, 1u, __ATOMIC_RELAXED, __HIP_MEMORY_SCOPE_AGENT);
            __syncthreads();
            const int u = (int)qw[0];
            __syncthreads();
            if (u >= NU) break;
            const int hh = 7 - (u >> 8), r = u & 255, b = r >> 6, sub = (r >> 5) & 1, qb = r & 31, h = 2 * hh + sub;
            const size_t row0 = (size_t)b * SEQ;
            const float slope2 = exp2f(-(float)(hh + 1)) * LOG2E;
            const float kmax = __uint_as_float(__hip_atomic_load(ctl + CW_KMAX + b * 16 + h, __ATOMIC_RELAXED, __HIP_MEMORY_SCOPE_AGENT));
            att::attn_unit<DQK, ALIBI, ROPE, ldq, ldk, ldv, ldo>(Q + (row0 + qb * 256) * ldq + h * qhs, K + row0 * ldk + h * khs, V + row0 * ldv + (h / vdiv) * vhs,
                                       O + (row0 + qb * 256) * ldo + h * ohs, SEQ, slope2, qb * 256, rope, (char*)c.lds, c.tid, kmax);
        }
    }
}

DI void pass_diff_combine(const Ctx& c, const bf16* OS, const float* lamp, const float* subg, bf16* OC) {
    const float lam_init = 0.8f - 0.6f * expf(-0.3f * 1.0f);
    const float sa = wave_sum(lamp[c.lane] * lamp[64 + c.lane]), sb = wave_sum(lamp[128 + c.lane] * lamp[192 + c.lane]);
    const float lam = expf(sa) - expf(sb) + lam_init;
    const int h = c.lane >> 3, e0 = (c.lane & 7) * 16;
    float gv[16];
#pragma unroll
    for (int i = 0; i < 16; ++i) gv[i] = subg[e0 + i] * (1.f - lam_init);
    for (int m = c.gw; m < MROWS; m += c.NGW) {
        const bf16* r1 = OS + (size_t)m * 2048 + (2 * h) * 128 + e0; const bf16* r2 = r1 + 128;
        const u32x4 a0 = *(const u32x4*)r1, a1 = *(const u32x4*)(r1 + 8), b0 = *(const u32x4*)r2, b1 = *(const u32x4*)(r2 + 8);
        float o[16]; float ss = 0.f;
#pragma unroll
        for (int i = 0; i < 4; ++i) { o[2 * i] = bflo(a0[i]) - lam * bflo(b0[i]); o[2 * i + 1] = bfhi(a0[i]) - lam * bfhi(b0[i]);
            o[8 + 2 * i] = bflo(a1[i]) - lam * bflo(b1[i]); o[8 + 2 * i + 1] = bfhi(a1[i]) - lam * bfhi(b1[i]); }
#pragma unroll
        for (int i = 0; i < 16; ++i) ss += o[i] * o[i];
        ss += __shfl_xor(ss, 1); ss += __shfl_xor(ss, 2); ss += __shfl_xor(ss, 4);
        const float rstd = rsqrtf(ss * (1.f / 128.f) + EPS);
        u32x4 w0, w1;
#pragma unroll
        for (int i = 0; i < 4; ++i) { w0[i] = pk2(o[2 * i] * rstd * gv[2 * i], o[2 * i + 1] * rstd * gv[2 * i + 1]); w1[i] = pk2(o[8 + 2 * i] * rstd * gv[8 + 2 * i], o[8 + 2 * i + 1] * rstd * gv[8 + 2 * i + 1]); }
        bf16* op = OC + (size_t)m * 1024 + h * 128 + e0; *(u32x4*)op = w0; *(u32x4*)(op + 8) = w1;
    }
}

DI float gelu_tanh(float x) { const float z = 0.7978845608028654f * (x + 0.044715f * x * x * x); return x * frcp(1.f + fexp(-2.f * z)); }
DI void pass_conv(const Ctx& c, bf16* U, const bf16* HALO, const float* cw, const float* cb) {
    const int NSTRIP = MROWS / 16;
    for (int s = c.gw; s < NSTRIP; s += c.NGW) {
        const int t0 = s * 16; const bool first = (t0 & (SEQ - 1)) == 0, lastst = ((t0 + 16) & (SEQ - 1)) == 0;
#pragma unroll 1
        for (int it = 0; it < 11; ++it) {
            const int cc = c.lane + 64 * it, ch = 4 * cc, gcol = (ch >> 7) * 256 + (ch & 127);
            u32x2 ug[18], uv[18];
            { const bf16* hp = HALO + ((size_t)(first ? s : s - 1) * 2 + 1) * FFN_U + gcol; ug[0] = *(const u32x2*)hp; uv[0] = *(const u32x2*)(hp + 128); }
#pragma unroll
            for (int r = 0; r < 16; ++r) { const bf16* up = U + (size_t)(t0 + r) * FFN_U + gcol; ug[r + 1] = *(const u32x2*)up; uv[r + 1] = *(const u32x2*)(up + 128); }
            { const bf16* hp = HALO + ((size_t)(lastst ? s : s + 1) * 2) * FFN_U + gcol; ug[17] = *(const u32x2*)hp; uv[17] = *(const u32x2*)(hp + 128); }
            if (first) { ug[0] = (u32x2){0u, 0u}; uv[0] = ug[0]; }
            if (lastst) { ug[17] = (u32x2){0u, 0u}; uv[17] = ug[17]; }
            const f32x4 wg0 = *(const f32x4*)(cw + ch), wg1 = *(const f32x4*)(cw + FFN_U + ch), wg2 = *(const f32x4*)(cw + 2 * FFN_U + ch), bg = *(const f32x4*)(cb + ch);
            const f32x4 wv0 = *(const f32x4*)(cw + FFN_H + ch), wv1 = *(const f32x4*)(cw + FFN_U + FFN_H + ch), wv2 = *(const f32x4*)(cw + 2 * FFN_U + FFN_H + ch), bv = *(const f32x4*)(cb + FFN_H + ch);
#pragma unroll
            for (int r = 0; r < 16; ++r) {
                const u32x2 pg = ug[r], cg = ug[r + 1], ng = ug[r + 2], pv = uv[r], cv = uv[r + 1], nv = uv[r + 2];
                f32x4 g_, v_;
                g_[0] = bg[0] + wg0[0] * bflo(pg.x) + wg1[0] * bflo(cg.x) + wg2[0] * bflo(ng.x); g_[1] = bg[1] + wg0[1] * bfhi(pg.x) + wg1[1] * bfhi(cg.x) + wg2[1] * bfhi(ng.x);
                g_[2] = bg[2] + wg0[2] * bflo(pg.y) + wg1[2] * bflo(cg.y) + wg2[2] * bflo(ng.y); g_[3] = bg[3] + wg0[3] * bfhi(pg.y) + wg1[3] * bfhi(cg.y) + wg2[3] * bfhi(ng.y);
                v_[0] = bv[0] + wv0[0] * bflo(pv.x) + wv1[0] * bflo(cv.x) + wv2[0] * bflo(nv.x); v_[1] = bv[1] + wv0[1] * bfhi(pv.x) + wv1[1] * bfhi(cv.x) + wv2[1] * bfhi(nv.x);
                v_[2] = bv[2] + wv0[2] * bflo(pv.y) + wv1[2] * bflo(cv.y) + wv2[2] * bflo(nv.y); v_[3] = bv[3] + wv0[3] * bfhi(pv.y) + wv1[3] * bfhi(cv.y) + wv2[3] * bfhi(nv.y);
                u32x2 o; o.x = pk2(gelu_tanh(g_[0]) * v_[0], gelu_tanh(g_[1]) * v_[1]); o.y = pk2(gelu_tanh(g_[2]) * v_[2], gelu_tanh(g_[3]) * v_[3]);
                *(u32x2*)(U + (size_t)(t0 + r) * FFN_U + gcol) = o;
            }
        }
    }
}

constexpr int ML_CH = 128, ML_NC = SEQ / ML_CH, ML_H = 8, ML_DK = 64, ML_DV = 128, ML_EX = 160;
constexpr int ML_LDK = 72, ML_LDT = 96, ML_LDV = 160, ML_LDP = 136;
struct MlLds { LAS bf16* kA; LAS bf16* kB; LAS bf16* vx; LAS bf16* P; LAS bf16* Cs; LAS float* sc; };
DI void ml_gates(const Ctx& c, const float* gates, int row0, int h, LAS float* sc) {
    if (c.tid < 128) { const float* g = gates + (size_t)(row0 + c.tid) * 32 + h;
        sc[c.tid] = g[0]; sc[128 + c.tid] = log_sigmoid_(g[8]); sc[256 + c.tid] = g[16]; sc[384 + c.tid] = log_sigmoid_(g[24]); }
    __syncthreads();
    if (c.tid == 0) { float a = 0.f;
#pragma unroll 4
        for (int t = 0; t < 128; ++t) { a += sc[128 + t]; sc[512 + t] = a; } }
    if (c.tid == 64) { float a = 0.f;
#pragma unroll 4
        for (int t = 127; t >= 0; --t) { a += sc[384 + t]; sc[640 + t] = a; } }
    __syncthreads();
}
DI void ml_load_v(const Ctx& c, const bf16* v, int row0, int h, LAS bf16* vx) {
#pragma unroll
    for (int i = 0; i < 4; ++i) { const int ch = c.tid + 512 * i, r = ch >> 4, cc = (ch & 15) * 8;
        *(LAS u32x4*)(vx + r * ML_LDV + cc) = *(const u32x4*)(v + (size_t)(row0 + r) * 1024 + h * 128 + cc); }
    if (c.tid < 128) { LAS bf16* p = vx + c.tid * ML_LDV + 128;
        *(LAS u32x4*)p = (u32x4){0x00003f80u, 0u, 0u, 0u}; *(LAS u32x4*)(p + 8) = (u32x4){0u, 0u, 0u, 0u}; *(LAS u32x4*)(p + 16) = (u32x4){0u, 0u, 0u, 0u}; *(LAS u32x4*)(p + 24) = (u32x4){0u, 0u, 0u, 0u}; }
}
DI void ml_phase1(const Ctx& c, const bf16* k, const bf16* v, const float* gates, bf16* ST, float* DEC) {
    LAS bf16* kA = (LAS bf16*)c.lds; LAS bf16* kB = kA + 128 * ML_LDT; LAS bf16* vx = kB + 128 * ML_LDT; LAS float* sc = (LAS float*)(vx + 128 * ML_LDV);
    const int NU = BATCH * ML_H * ML_NC;
    for (int u = c.bx; u < NU; u += c.G) {
        const int ck = u % ML_NC, h = (u / ML_NC) % ML_H, b = u / (ML_NC * ML_H); const int row0 = b * SEQ + ck * ML_CH;
        ml_gates(c, gates, row0, h, sc);
        const float bl = sc[512 + 127], B0 = sc[640];
#pragma unroll
        for (int i = 0; i < 2; ++i) { const int ch = c.tid + 512 * i, r = ch >> 3, cc = (ch & 7) * 8;
            const u32x4 w = *(const u32x4*)(k + (size_t)(row0 + r) * 512 + h * 64 + cc);
            const float wF = fexp(bl - sc[512 + r] + sc[r]), wB = fexp(B0 - sc[640 + r] + sc[256 + r]);
            u32x4 a, bb;
#pragma unroll
            for (int q = 0; q < 4; ++q) { a[q] = pk2(bflo(w[q]) * wF, bfhi(w[q]) * wF); bb[q] = pk2(bflo(w[q]) * wB, bfhi(w[q]) * wB); }
            *(LAS u32x4*)(kA + r * ML_LDT + cc) = a; *(LAS u32x4*)(kB + r * ML_LDT + cc) = bb; }
        ml_load_v(c, v, row0, h, vx);
        __syncthreads();
#pragma unroll 1
        for (int id = c.wave; id < 20; id += 8) {
            const int dir = id / 10, rem = id % 10, db = rem / 5, eb = rem % 5;
            const LAS bf16* kw = dir ? kB : kA;
            f32x16 acc = {};
#pragma unroll 2
            for (int ks = 0; ks < 8; ++ks) acc = MFMA32(frag_tr(kw, ML_LDT, 16 * ks, 32 * db, c.lane), frag_tr(vx, ML_LDV, 16 * ks, 32 * eb, c.lane), acc);
            bf16* dst = ST + ((size_t)((b * ML_H + h) * 2 + dir) * ML_NC + ck) * (ML_DK * ML_EX);
            const int n = c.lane & 31, hi = c.lane >> 5;
#pragma unroll
            for (int r = 0; r < 16; ++r) dst[(32 * db + crow(r, hi)) * ML_EX + 32 * eb + n] = f2bf(acc[r]);
        }
        if (c.tid == 0) { float* d = DEC + (size_t)((b * ML_H + h) * 2) * ML_NC + ck; d[0] = fexp(bl); d[ML_NC] = fexp(B0); }
        __syncthreads();
    }
}
DI void ml_phase2(const Ctx& c, bf16* ST, const float* DEC) {
    constexpr int NG = ML_DK * ML_EX / 8;
    const int NTASK = BATCH * ML_H * 2 * NG;
    for (int t = c.bx * NTHREADS + c.tid; t < NTASK; t += c.G * NTHREADS) {
        const int g = t % NG, chain = t / NG, dir = chain & 1;
        bf16* base = ST + (size_t)chain * ML_NC * (ML_DK * ML_EX) + g * 8; const float* dec = DEC + (size_t)chain * ML_NC;
        float carry[8];
#pragma unroll
        for (int i = 0; i < 8; ++i) carry[i] = 0.f;
        for (int s = 0; s < ML_NC; ++s) {
            const int ck = dir ? (ML_NC - 1 - s) : s;
            u32x4* p = (u32x4*)(base + (size_t)ck * (ML_DK * ML_EX)); const u32x4 a = *p; const float d = dec[ck];
            u32x4 o;
#pragma unroll
            for (int q = 0; q < 4; ++q) { o[q] = pk2(carry[2 * q], carry[2 * q + 1]); carry[2 * q] = d * carry[2 * q] + bflo(a[q]); carry[2 * q + 1] = d * carry[2 * q + 1] + bfhi(a[q]); }
            *p = o;
        }
    }
}
DI void ml_phase3(const Ctx& c, const bf16* q, const bf16* k, const bf16* v, const bf16* og, const float* gates, const bf16* ST, const float* ng, bf16* Z) {
    LAS bf16* kl = (LAS bf16*)c.lds; LAS bf16* vx = kl + 128 * ML_LDK; LAS bf16* P = vx + 128 * ML_LDV; LAS bf16* Cs = P + 128 * ML_LDP; LAS float* sc = (LAS float*)(Cs + 64 * ML_LDV);
    LAS bf16* hb = P;
    const int NU = BATCH * ML_H * ML_NC;
    const int n = c.lane & 31, hi = c.lane >> 5, tb = c.wave & 3, wg2 = c.wave >> 2;
    for (int u = c.bx; u < NU; u += c.G) {
        const int ck = u % ML_NC, h = (u / ML_NC) % ML_H, b = u / (ML_NC * ML_H); const int row0 = b * SEQ + ck * ML_CH;
        ml_gates(c, gates, row0, h, sc);
#pragma unroll
        for (int i = 0; i < 2; ++i) { const int ch = c.tid + 512 * i, r = ch >> 3, cc = (ch & 7) * 8;
            *(LAS u32x4*)(kl + r * ML_LDK + cc) = *(const u32x4*)(k + (size_t)(row0 + r) * 512 + h * 64 + cc); }
        ml_load_v(c, v, row0, h, vx);
        const bf16* qg = q + (size_t)row0 * 512 + h * 64;
        bf16x8 qf[4];
#pragma unroll
        for (int kd = 0; kd < 4; ++kd) qf[kd] = gfrag_row(qg, 512, 32 * tb, 16 * kd, c.lane);
        f32x16 hs[2] = {};
#pragma unroll 1
        for (int dir = 0; dir < 2; ++dir) {
            const bf16* st = ST + ((size_t)((b * ML_H + h) * 2 + dir) * ML_NC + ck) * (ML_DK * ML_EX);
            for (int ch = c.tid; ch < 64 * 20; ch += NTHREADS) { const int r = ch / 20, cc = (ch % 20) * 8; *(LAS u32x4*)(Cs + r * ML_LDV + cc) = *(const u32x4*)(st + r * ML_EX + cc); }
            __syncthreads();
            const int ioff = dir ? 256 : 0, boff = dir ? 640 : 512;
            const float bt = sc[boff + 32 * tb + n];
#pragma unroll 1
            for (int sb2 = 0; sb2 < 2; ++sb2) {
                const int sb = 2 * wg2 + sb2;
                f32x16 a = {};
#pragma unroll
                for (int kd = 0; kd < 4; ++kd) a = MFMA32(frag_row(kl, ML_LDK, 32 * sb, 16 * kd, c.lane), qf[kd], a);
                const int t = 32 * tb + n;
#pragma unroll
                for (int g4 = 0; g4 < 4; ++g4) {
                    const int s0 = 32 * sb + 8 * g4 + 4 * hi;
                    float w[4];
#pragma unroll
                    for (int j = 0; j < 4; ++j) { const int s = s0 + j; const bool keep = dir ? (s >= t) : (s <= t);
                        const float e = fexp(fminf(bt - sc[boff + s], 0.f) + sc[ioff + s]); w[j] = keep ? a[4 * g4 + j] * e : 0.f; }
                    u32x2 o; o.x = pk2(w[0], w[1]); o.y = pk2(w[2], w[3]);
                    *(LAS u32x2*)(P + t * ML_LDP + s0) = o;
                }
            }
            __syncthreads();
            f32x16 acc[3] = {}, aci[3] = {};
#pragma unroll 2
            for (int ks = 0; ks < 8; ++ks) { const bf16x8 A = frag_row(P, ML_LDP, 32 * tb, 16 * ks, c.lane);
#pragma unroll
                for (int e = 0; e < 3; ++e) { const int et = (e == 2) ? 4 : 2 * wg2 + e; acc[e] = MFMA32(A, frag_tr(vx, ML_LDV, 16 * ks, 32 * et, c.lane), acc[e]); } }
#pragma unroll
            for (int kd = 0; kd < 4; ++kd) {
#pragma unroll
                for (int e = 0; e < 3; ++e) { const int et = (e == 2) ? 4 : 2 * wg2 + e; aci[e] = MFMA32(qf[kd], frag_tr(Cs, ML_LDV, 16 * kd, 32 * et, c.lane), aci[e]); } }
#pragma unroll
            for (int r = 0; r < 16; ++r) {
                const float eb_ = fexp(sc[boff + 32 * tb + crow(r, hi)]);
                const float t2 = acc[2][r] + eb_ * aci[2][r];
                const float den = __shfl(t2, hi * 32);
                const float inv = frcp(fmaxf(fabsf(den), 1.f));
                hs[0][r] += (acc[0][r] + eb_ * aci[0][r]) * inv; hs[1][r] += (acc[1][r] + eb_ * aci[1][r]) * inv;
            }
            __syncthreads();
        }
#pragma unroll
        for (int e = 0; e < 2; ++e)
#pragma unroll
            for (int r = 0; r < 16; ++r) hb[(32 * tb + crow(r, hi)) * ML_LDP + 32 * (2 * wg2 + e) + n] = f2bf(hs[e][r]);
        __syncthreads();
        const float g0 = ng[h * 128 + 2 * c.lane], g1 = ng[h * 128 + 2 * c.lane + 1];
        for (int rr = 0; rr < 16; ++rr) {
            const int t = 16 * c.wave + rr; const unsigned w = *(const LAS unsigned*)(hb + t * ML_LDP + 2 * c.lane);
            const float x0 = bflo(w), x1 = bfhi(w);
            const float mean = wave_sum(x0 + x1) * (1.f / 128.f); const float d0 = x0 - mean, d1 = x1 - mean;
            const float rstd = rsqrtf(wave_sum(d0 * d0 + d1 * d1) * (1.f / 128.f) + EPS);
            const unsigned ow = *(const unsigned*)(og + (size_t)(row0 + t) * 1024 + h * 128 + 2 * c.lane);
            *(unsigned*)(Z + (size_t)(row0 + t) * 1024 + h * 128 + 2 * c.lane) = pk2(d0 * rstd * g0 * sigmoidf_(bflo(ow)), d1 * rstd * g1 * sigmoidf_(bfhi(ow)));
        }
        __syncthreads();
    }
}

constexpr int RT_CH = 1024, RT_NC = SEQ / RT_CH, RT_H = 4, RT_DK = 256, RT_DV = 512;
constexpr int RT_LDK = 264, RT_LDB = 544, RT_LDA = 72, RT_LD2 = 288;
DI void rt_phase2(const Ctx& c, const bf16* k, const bf16* v, const float* dlogit, bf16* RS) {
    LAS bf16* kw = (LAS bf16*)c.lds; LAS bf16* vh = kw + 64 * RT_LD2;
    const int NU = BATCH * RT_H * 2 * RT_NC;
    const int n = c.lane & 31, hi = c.lane >> 5;
    for (int u = c.bx; u < NU; u += c.G) {
        const int ck = u % RT_NC, dir = (u / RT_NC) & 1, h = (u / (2 * RT_NC)) % RT_H, b = u / (2 * RT_NC * RT_H);
        const int row0 = b * SEQ + ck * RT_CH;
        const float lg2 = log_sigmoid_(dlogit[dir * 4 + h]) * LOG2E;
        bf16* dst = RS + ((size_t)((b * RT_H + h) * 2 + dir) * RT_NC + ck) * (RT_DK * RT_DV);
        for (int half = 0; half < 2; ++half) {
            f32x16 acc[8] = {};
            u32x4 pk_[4], pv_[4];
#define R2_PREFETCH(sb_) do { int ot = c.tid; asm volatile("" : "+v"(ot)); \
            _Pragma("unroll") for (int i = 0; i < 4; ++i) { const int ch = ot + 512 * i, r = ch >> 5, cc = (ch & 31) * 8; const int s = 64 * (sb_) + r; \
                pk_[i] = *(const u32x4*)(k + (size_t)(row0 + s) * 1024 + h * 256 + cc); pv_[i] = *(const u32x4*)(v + (size_t)(row0 + s) * 2048 + h * 512 + half * 256 + cc); } } while (0)
            R2_PREFETCH(0);
#pragma unroll 1
            for (int sb = 0; sb < RT_CH / 64; ++sb) {
                __syncthreads();
                { int ot = c.tid; asm volatile("" : "+v"(ot));
#pragma unroll
                  for (int i = 0; i < 4; ++i) { const int ch = ot + 512 * i, r = ch >> 5, cc = (ch & 31) * 8; const int s = 64 * sb + r;
                    const float w = fexp2(lg2 * (float)(dir ? s : (RT_CH - 1 - s)));
                    u32x4 o;
#pragma unroll
                    for (int q = 0; q < 4; ++q) o[q] = pk2(bflo(pk_[i][q]) * w, bfhi(pk_[i][q]) * w);
                    *(LAS u32x4*)(kw + r * RT_LD2 + cc) = o;
                    *(LAS u32x4*)(vh + r * RT_LD2 + cc) = pv_[i]; } }
                if (sb + 1 < RT_CH / 64) R2_PREFETCH(sb + 1);
                __syncthreads();
#pragma unroll 1
                for (int ks = 0; ks < 4; ++ks) { const bf16x8 A = frag_tr(kw, RT_LD2, 16 * ks, 32 * c.wave, c.lane);
#pragma unroll
                    for (int et = 0; et < 8; ++et) { acc[et] = MFMA32(A, frag_tr(vh, RT_LD2, 16 * ks, 32 * et, c.lane), acc[et]); if (et == 3) __builtin_amdgcn_sched_barrier(0); } }
            }
#undef R2_PREFETCH
#pragma unroll
            for (int et = 0; et < 8; ++et)
#pragma unroll
                for (int r = 0; r < 16; ++r) dst[(size_t)(32 * c.wave + crow(r, hi)) * RT_DV + half * 256 + 32 * et + n] = f2bf(acc[et][r]);
        }
        __syncthreads();
    }
}
DI void rt_phase3(const Ctx& c, bf16* RS, const float* dlogit) {
    constexpr int NG = RT_DK * RT_DV / 8;
    const int NTASK = BATCH * RT_H * 2 * NG;
    for (int t = c.bx * NTHREADS + c.tid; t < NTASK; t += c.G * NTHREADS) {
        const int g = t % NG, chain = t / NG, dir = chain & 1, h = (chain >> 1) % RT_H;
        const float gch = fexp2(log_sigmoid_(dlogit[dir * 4 + h]) * LOG2E * (float)RT_CH);
        bf16* base = RS + (size_t)chain * RT_NC * (RT_DK * RT_DV) + (size_t)g * 8;
        float carry[8];
#pragma unroll
        for (int i = 0; i < 8; ++i) carry[i] = 0.f;
#pragma unroll
        for (int s = 0; s < RT_NC; ++s) {
            const int ck = dir ? (RT_NC - 1 - s) : s;
            u32x4* p = (u32x4*)(base + (size_t)ck * (RT_DK * RT_DV)); const u32x4 a = *p;
            u32x4 o;
#pragma unroll
            for (int q = 0; q < 4; ++q) { o[q] = pk2(carry[2 * q], carry[2 * q + 1]); carry[2 * q] = gch * carry[2 * q] + bflo(a[q]); carry[2 * q + 1] = gch * carry[2 * q + 1] + bfhi(a[q]); }
            *p = o;
        }
    }
}
DI void rt_phase4(const Ctx& c, const bf16* q, const bf16* k, const bf16* v, bf16* gz, const bf16* RS, const float* dlogit, const float* ng, const bool wr = true) {
    LAS bf16* kt = (LAS bf16*)c.lds; LAS bf16* Bt = kt + 64 * RT_LDK; LAS bf16* At = Bt + 64 * RT_LDB; LAS float* red = (LAS float*)(At + 128 * RT_LDA);
    const int NU = BATCH * RT_H * RT_NC * 8;
    const int n = c.lane & 31, hi = c.lane >> 5, tb = c.wave & 3, eh = c.wave >> 2;
    for (int u = c.bx; u < NU; u += c.G) {
        const int tq = u & 7, ck = (u >> 3) % RT_NC, h = (u / (8 * RT_NC)) % RT_H, b = u / (8 * RT_NC * RT_H);
        const int rowc = b * SEQ + ck * RT_CH, rowq = rowc + tq * 128;
        const float lf2 = log_sigmoid_(dlogit[h]) * LOG2E, lb2 = log_sigmoid_(dlogit[4 + h]) * LOG2E;
        const bf16* qg = q + (size_t)rowq * 1024 + h * 256;
        f32x16 acc[8] = {};
        u32x4 sb_[8], sk_[4];
#define RT_PREFETCH(st) do { int ot = c.tid; asm volatile("" : "+v"(ot)); \
        if ((st) < 16) { const int s0_ = 64 * (st); \
            _Pragma("unroll") for (int i = 0; i < 4; ++i) { const int ch = ot + 512 * i, r = ch >> 5, cc = (ch & 31) * 8; sk_[i] = *(const u32x4*)(k + (size_t)(rowc + s0_ + r) * 1024 + h * 256 + cc); } \
            _Pragma("unroll") for (int i = 0; i < 8; ++i) { const int ch = ot + 512 * i, r = ch >> 6, cc = (ch & 63) * 8; sb_[i] = *(const u32x4*)(v + (size_t)(rowc + s0_ + r) * 2048 + h * 512 + cc); } \
        } else { const int dir_ = ((st) - 16) >> 2, d0_ = 64 * (((st) - 16) & 3); \
            const bf16* rs_ = RS + ((size_t)((b * RT_H + h) * 2 + dir_) * RT_NC + ck) * (RT_DK * RT_DV) + (size_t)d0_ * RT_DV; \
            _Pragma("unroll") for (int i = 0; i < 8; ++i) { const int ch = ot + 512 * i, r = ch >> 6, cc = (ch & 63) * 8; sb_[i] = *(const u32x4*)(rs_ + (size_t)r * RT_DV + cc); } \
            _Pragma("unroll") for (int i = 0; i < 2; ++i) { const int ch = ot + 512 * i, r = ch >> 3, cc = (ch & 7) * 8; sk_[i] = *(const u32x4*)(qg + (size_t)r * 1024 + d0_ + cc); } } } while (0)
        RT_PREFETCH(0);
#pragma unroll 1
        for (int step = 0; step < 24; ++step) {
            __syncthreads();
            { int ot = c.tid; asm volatile("" : "+v"(ot));
#pragma unroll
              for (int i = 0; i < 8; ++i) { const int ch = ot + 512 * i, r = ch >> 6, cc = (ch & 63) * 8; *(LAS u32x4*)(Bt + r * RT_LDB + cc) = sb_[i]; }
              if (step < 16) {
#pragma unroll
                  for (int i = 0; i < 4; ++i) { const int ch = ot + 512 * i, r = ch >> 5, cc = (ch & 31) * 8; *(LAS u32x4*)(kt + r * RT_LDK + cc) = sk_[i]; }
              } else {
                  const int dir = (step - 16) >> 2;
#pragma unroll
                  for (int i = 0; i < 2; ++i) { const int ch = ot + 512 * i, r = ch >> 3, cc = (ch & 7) * 8; const int tpos = 128 * tq + r;
                      const float xi = dir ? fexp2(lb2 * (float)(RT_CH - tpos)) : fexp2(lf2 * (float)(tpos + 1));
                      u32x4 o;
#pragma unroll
                      for (int q4 = 0; q4 < 4; ++q4) o[q4] = pk2(bflo(sk_[i][q4]) * xi, bfhi(sk_[i][q4]) * xi);
                      *(LAS u32x4*)(At + r * RT_LDA + cc) = o; }
              } }
            if (step >= 16 && step + 1 < 24) RT_PREFETCH(step + 1);
            __syncthreads();
            if (step < 16) {
                const int s0 = 64 * step;
                f32x16 a = {};
#pragma unroll 4
                for (int kd = 0; kd < 16; ++kd) a = MFMA32(frag_row(kt, RT_LDK, 32 * eh, 16 * kd, c.lane), gfrag_row(qg, 1024, 32 * tb, 16 * kd, c.lane), a);
                const int tl = 32 * tb + n, tpos = 128 * tq + tl;
#pragma unroll
                for (int g4 = 0; g4 < 4; ++g4) {
                    const int sl = 32 * eh + 8 * g4 + 4 * hi;
                    float w[4];
#pragma unroll
                    for (int j = 0; j < 4; ++j) { const float rel = (float)(tpos - (s0 + sl + j));
                        const float mk = (rel >= 0.f ? fexp2(rel * lf2) : 0.f) + (rel <= 0.f ? fexp2(-rel * lb2) : 0.f); w[j] = a[4 * g4 + j] * mk; }
                    u32x2 o; o.x = pk2(w[0], w[1]); o.y = pk2(w[2], w[3]);
                    *(LAS u32x2*)(At + tl * RT_LDA + sl) = o;
                }
                RT_PREFETCH(step + 1);
                __syncthreads();
            }
#pragma unroll 1
            for (int ks = 0; ks < 4; ++ks) { const bf16x8 A = frag_row(At, RT_LDA, 32 * tb, 16 * ks, c.lane);
#pragma unroll
                for (int et = 0; et < 8; ++et) { acc[et] = MFMA32(A, frag_tr(Bt, RT_LDB, 16 * ks, 32 * (8 * eh + et), c.lane), acc[et]); if (et == 3) __builtin_amdgcn_sched_barrier(0); } }
        }
#undef RT_PREFETCH
#pragma unroll
        for (int r = 0; r < 16; ++r) {
            float s1 = 0.f, s2 = 0.f;
#pragma unroll
            for (int et = 0; et < 8; ++et) { s1 += acc[et][r]; s2 += acc[et][r] * acc[et][r]; }
#pragma unroll
            for (int o = 1; o < 32; o <<= 1) { s1 += __shfl_xor(s1, o); s2 += __shfl_xor(s2, o); }
            if (n == 0) { red[((32 * tb + crow(r, hi)) * 2 + eh) * 2] = s1; red[((32 * tb + crow(r, hi)) * 2 + eh) * 2 + 1] = s2; }
        }
        __syncthreads();
#pragma unroll
        for (int r = 0; r < 16; ++r) {
            const int tl = 32 * tb + crow(r, hi);
            const float s1 = red[(tl * 2) * 2] + red[(tl * 2 + 1) * 2], s2 = red[(tl * 2) * 2 + 1] + red[(tl * 2 + 1) * 2 + 1];
            const float mean = s1 * (1.f / 512.f), var = fmaxf(s2 * (1.f / 512.f) - mean * mean, 0.f), rstd = rsqrtf(var + EPS);
            bf16* gp = gz + (size_t)(rowq + tl) * 2048 + h * 512 + 256 * eh + n;
#pragma unroll
            for (int et = 0; et < 8; ++et) { const float gt = bf2f(gp[32 * et]); const float y = (acc[et][r] - mean) * rstd * ng[h * 512 + 256 * eh + 32 * et + n];
                if (wr) gp[32 * et] = f2bf(y * gt * sigmoidf_(gt)); }
        }
        __syncthreads();
    }
}

struct Args { const float* in[25]; float* out; unsigned char* ws; int ph_lo, ph_hi; };
constexpr int NPHASES = 64;
#define PHASE(...) do { if (ph >= lo && ph < hi) { { Ctx c = c0; c.lane = (int)__builtin_amdgcn_mbcnt_hi(~0u, __builtin_amdgcn_mbcnt_lo(~0u, 0u)); c.tid = c0.wave * 64 + c.lane; asm volatile("" : "+v"(c.tid)); \
    c.lane = c.tid & 63; c.wave = __builtin_amdgcn_readfirstlane(c.tid >> 6); c.gw = c.bx * NWAVES + c.wave; \
    __VA_ARGS__; } if (ph + 1 < hi) xcd_barrier(bar); } ++ph; } while (0)

template <int L> DI void run_layer(const Ctx& c0, const Args& args, const XcdBarrier& bar, const int lo, const int hi, int& ph) {
    unsigned char* ws = args.ws;
    const float* x = args.in[0]; const float* norm_g = args.in[1];
    float* rope = (float*)(ws + WS_ROPE);
    float* RSTD = (float*)(ws + 3 * MiB);
    bf16* HB = (bf16*)(ws + WS_XN);
    bf16* DOUT16 = (bf16*)args.out;
    unsigned char* S = ws + WS_S;
    bf16* WTmix = (bf16*)(ws + WT_MIX); bf16* WTup = (bf16*)(ws + WT_UP); bf16* WTdown = (bf16*)(ws + WT_DOWN);
    bf16* U = (bf16*)S; bf16* HALO = (bf16*)(S + 352 * MiB);
    LAS unsigned char* ring = c0.lds;
    const float* g0 = norm_g + (size_t)(L * 4 + 0) * DM; const float* g1 = g0 + DM; const float* g2 = g0 + 2 * DM; const float* g3 = g0 + 3 * DM;
    bf16* AOUT = (bf16*)S;
#define FFN_JOBS(LL) {args.in[2] + (size_t)(LL) * DM * FFN_U, DM, FFN_U, WTup, MAP_FFNUP, 0, norm_g + (size_t)((LL) * 4 + 2) * DM}, {args.in[5] + (size_t)(LL) * FFN_H * DM, FFN_H, DM, WTdown, MAP_ID, 0, nullptr}
    if constexpr (L == 0) {
        bf16* Wd = WTmix; bf16* Wuq = (bf16*)(ws + WT_MIX + 2 * MiB); bf16* Wukv = (bf16*)(ws + WT_MIX + 4 * MiB); bf16* Wo = (bf16*)(ws + WT_MIX + 6 * MiB);
        bf16* DQKV = (bf16*)S; bf16* CQ = (bf16*)(S + 48 * MiB); bf16* CKV = (bf16*)(S + 72 * MiB); bf16* Q = (bf16*)(S + 88 * MiB); bf16* KF = (bf16*)(S + 184 * MiB);
        bf16* V = (bf16*)(S + 280 * MiB); bf16* O = (bf16*)(S + 344 * MiB);
        PHASE({
            fill_rope(c, rope);
            const TJob jobs[7] = {{args.in[6], DM, 384, Wd, MAP_ID, 0, g0}, {args.in[9], DM, 320, Wd, MAP_ID, 384, g0}, {args.in[8], 384, 1536, Wuq, MAP_ROPEQ, 0, nullptr},
                                  {args.in[11], 256, 2048, Wukv, MAP_ID, 0, nullptr}, {args.in[12], DM, DM, Wo, MAP_ID, 0, nullptr}, FFN_JOBS(0)};
            run_transposes<7>(c, jobs);
            zero_rows(c, Wd, DM, 704, 64);
            pass_first(c, x, HB, RSTD);
        });
        PHASE({ pg8::Gemm g{HB, Wd, MROWS, 768, DM, DM, 256}; pg8::StaticOrder so; so.init(MROWS, 768, c.G, c.bx);
            pg8::gemm_phase(ring, c.tid, g, so, pg8::epi_plain(DQKV, 768, 1.f, RSTD)); });
        PHASE({ pass_mla_mid(c, DQKV, args.in[7], args.in[10], rope, CQ, CKV, KF); });
        PHASE({ pg8::Gemm g{CQ, Wuq, MROWS, 1536, 384, 384, 256}; pg8::StaticOrder so; so.init(MROWS, 1536, c.G, c.bx);
              pg8::gemm_phase(ring, c.tid, g, so, pg8::epi_plain(Q, 1536, 0.07216878364870322f * LOG2E)); });
        PHASE({ pg8::Gemm g{CKV, Wukv, MROWS, 2048, 256, 256, 256}; pg8::StaticOrder so; so.init(MROWS, 2048, c.G, c.bx);
              pg8::EpiMlaKV E{KF, V}; pg8::gemm_phase(ring, c.tid, g, so, E); });
        PHASE({ attention_phase<192, false, true, 1536, 192, 1536, 192, 1024, 128, 1, 1024, 128, 8>(c, Q, KF, V, O, rope, (unsigned*)(ws + WS_CTL)); });
        PHASE({ pg8::Gemm g{O, Wo, MROWS, DM, DM, DM, 256}; pg8::StaticOrder so; so.init(MROWS, DM, c.G, c.bx);
            pg8::gemm_phase(ring, c.tid, g, so, pg8::epi_plain(AOUT, DM, 1.f)); });
    } else if constexpr (L == 1) {
        bf16* Wqkv = WTmix; bf16* Wo = (bf16*)(ws + WT_MIX + 8 * MiB);
        bf16* Qd = (bf16*)S; bf16* Kd = (bf16*)(S + 64 * MiB); bf16* Vd = (bf16*)(S + 128 * MiB); bf16* OS = (bf16*)(S + 192 * MiB); bf16* OC = (bf16*)(S + 320 * MiB);
        PHASE({ pg8::Gemm g{HB, Wqkv, MROWS, 3072, DM, DM, 256}; pg8::StaticOrder so; so.init(MROWS, 3072, c.G, c.bx);
            pg8::EpiSeg<false> E{}; E.p0 = Qd; E.ld0 = DM; E.s0 = 0.125f * LOG2E; E.e0 = 8; E.p1 = Kd; E.ld1 = DM; E.s1 = 1.f; E.e1 = 16; E.p2 = Vd; E.ld2 = DM; E.s2 = 1.f; E.e2 = 100000; E.rowscale = RSTD;
            pg8::gemm_phase(ring, c.tid, g, so, E); });
        PHASE({ pass_kmax(c, Kd, (unsigned*)(ws + WS_CTL)); });
        PHASE({ attention_phase<64, true, false, 1024, 64, 1024, 64, 1024, 128, 2, 2048, 128, 16>(c, Qd, Kd, Vd, OS, rope, (unsigned*)(ws + WS_CTL)); });
        PHASE({ pass_diff_combine(c, OS, args.in[14], args.in[15], OC); });
        PHASE({ pg8::Gemm g{OC, Wo, MROWS, DM, DM, DM, 256}; pg8::StaticOrder so; so.init(MROWS, DM, c.G, c.bx);
            pg8::gemm_phase(ring, c.tid, g, so, pg8::epi_plain(AOUT, DM, 1.f)); });
    } else if constexpr (L == 2) {
        bf16* Win = WTmix; bf16* Wout = (bf16*)(ws + WT_MIX + 8 * MiB);
        bf16* q = (bf16*)S; bf16* k = (bf16*)(S + 32 * MiB); bf16* v = (bf16*)(S + 64 * MiB); bf16* og = (bf16*)(S + 128 * MiB);
        float* gates = (float*)(S + 192 * MiB); float* DEC = (float*)(S + 196 * MiB); bf16* ST = (bf16*)(S + 200 * MiB); bf16* Z = (bf16*)(S + 288 * MiB);
        PHASE({ pg8::Gemm g{HB, Win, MROWS, 3328, DM, DM, 256}; pg8::StaticOrder so; so.init(MROWS, 3328, c.G, c.bx);
            pg8::EpiSeg<true> E{}; E.p0 = q; E.ld0 = 512; E.s0 = 1.f; E.e0 = 4; E.p1 = k; E.ld1 = 512; E.s1 = 0.125f; E.e1 = 8; E.p2 = v; E.ld2 = DM; E.s2 = 1.f; E.e2 = 16; E.p3 = og; E.ld3 = DM; E.s3 = 1.f;
            E.gates = gates; E.gbias = args.in[18]; E.gblk = 24; E.rowscale = RSTD;
            pg8::gemm_phase(ring, c.tid, g, so, E); });
        PHASE({ ml_phase1(c, k, v, gates, ST, DEC); });
        PHASE({ ml_phase2(c, ST, DEC); });
        PHASE({ ml_phase3(c, q, k, v, og, gates, ST, args.in[19], Z); });
        PHASE({ pg8::Gemm g{Z, Wout, MROWS, DM, DM, DM, 256}; pg8::StaticOrder so; so.init(MROWS, DM, c.G, c.bx);
            pg8::gemm_phase(ring, c.tid, g, so, pg8::epi_plain(AOUT, DM, 1.f)); });
    } else {
        bf16* Win = WTmix; bf16* Wo = (bf16*)(ws + WT_MIX + 12 * MiB);
        bf16* q = (bf16*)S; bf16* k = (bf16*)(S + 64 * MiB); bf16* v = (bf16*)(S + 128 * MiB); bf16* gz = (bf16*)(S + 256 * MiB); bf16* RS = DOUT16;
        PHASE({ pg8::Gemm g{HB, Win, MROWS, 6144, DM, DM, 256}; pg8::StaticOrder so; so.init(MROWS, 6144, c.G, c.bx);
            pg8::EpiSeg<false> E{}; E.p0 = q; E.ld0 = DM; E.s0 = 1.f; E.e0 = 8; E.p1 = k; E.ld1 = DM; E.s1 = 0.0625f; E.e1 = 16; E.p2 = v; E.ld2 = 2048; E.s2 = 1.f; E.e2 = 32; E.p3 = gz; E.ld3 = 2048; E.s3 = 1.f; E.rowscale = RSTD;
            pg8::gemm_phase(ring, c.tid, g, so, E); });
        PHASE({ rt_phase2(c, k, v, args.in[22], RS); });
        PHASE({ rt_phase3(c, RS, args.in[22]); });
        PHASE({ rt_phase4(c, q, k, v, gz, RS, args.in[22], args.in[23]); });
        PHASE({ pg8::Gemm g{gz, Wo, MROWS, DM, 2048, 2048, 256}; pg8::StaticOrder so; so.init(MROWS, DM, c.G, c.bx);
            pg8::gemm_phase(ring, c.tid, g, so, pg8::epi_plain(AOUT, DM, 1.f)); });
    }
    PHASE({ pass_res(c, AOUT, g1, HB, RSTD); });
    PHASE({ pg8::Gemm g{HB, WTup, MROWS, FFN_U, DM, DM, 256}; pg8::StaticOrder so; so.init(MROWS, FFN_U, c.G, c.bx);
        pg8::EpiFfnUp E{U, HALO, RSTD}; pg8::gemm_phase(ring, c.tid, g, so, E); });
    PHASE({ pass_conv(c, U, HALO, args.in[3] + (size_t)L * 3 * FFN_U, args.in[4] + (size_t)L * FFN_U); });
    if constexpr (L < 3) {
        PHASE({ pg8::Gemm g{U, WTdown, MROWS, DM, FFN_H, FFN_U, 512}; pg8::StaticOrder so; so.init(MROWS, DM, c.G, c.bx);
            pg8::gemm_phase(ring, c.tid, g, so, pg8::epi_plain(DOUT16, DM, 1.f)); });
        PHASE({
            pass_res(c, DOUT16, g3, HB, RSTD);
            const float* gn = g0 + 4 * DM;
            if constexpr (L == 0) { const TJob jobs[4] = {{args.in[13], DM, 3072, WTmix, MAP_ID, 0, gn}, {args.in[16], DM, DM, (bf16*)(ws + WT_MIX + 8 * MiB), MAP_ID, 0, nullptr}, FFN_JOBS(1)}; run_transposes<4>(c, jobs); }
            else if constexpr (L == 1) { const TJob jobs[4] = {{args.in[17], DM, 3104, WTmix, MAP_ID, 0, gn}, {args.in[20], DM, DM, (bf16*)(ws + WT_MIX + 8 * MiB), MAP_ID, 0, nullptr}, FFN_JOBS(2)}; run_transposes<4>(c, jobs);
                zero_rows(c, WTmix, DM, 3104, 224); }
            else { const TJob jobs[4] = {{args.in[21], DM, 6144, WTmix, MAP_ID, 0, gn}, {args.in[24], 2048, DM, (bf16*)(ws + WT_MIX + 12 * MiB), MAP_ID, 0, nullptr}, FFN_JOBS(3)}; run_transposes<4>(c, jobs); }
        });
    } else {
        PHASE({ pg8::Gemm g{U, WTdown, MROWS, DM, FFN_H, FFN_U, 512}; pg8::StaticOrder so; so.init(MROWS, DM, c.G, c.bx);
            pg8::EpiF32 E{args.out, DM}; pg8::gemm_phase(ring, c.tid, g, so, E); });
        PHASE({ pass_final(c, args.out, g3, HB); });
    }
#undef FFN_JOBS
}

__global__ void __launch_bounds__(NTHREADS, 2) enc_fwd(Args args) {
    extern __shared__ __attribute__((aligned(16))) unsigned char lds_raw[];
    Ctx c;
    c.lds = (LAS unsigned char*)lds_raw;
    c.tid = threadIdx.x; c.lane = c.tid & 63; c.wave = __builtin_amdgcn_readfirstlane(c.tid >> 6);
    c.G = gridDim.x; c.bx = blockIdx.x; c.gw = c.bx * NWAVES + c.wave; c.NGW = c.G * NWAVES;
    volatile LAS unsigned* MISC = (volatile LAS unsigned*)(c.lds + MISC_OFF);
    for (int u = c.tid; u < (LDS_BYTES - LDSCTL_OFF) / 4; u += NTHREADS) ((LAS unsigned*)(c.lds + LDSCTL_OFF))[u] = 0u;
    __syncthreads();
    XcdBarrier bar = xcd_barrier_post((unsigned*)(args.ws + WS_CTL) + 4096, MISC + 8);
    const int lo = args.ph_lo, hi = args.ph_hi;
    int ph = 0;
    run_layer<0>(c, args, bar, lo, hi, ph);
    run_layer<1>(c, args, bar, lo, hi, ph);
    run_layer<2>(c, args, bar, lo, hi, ph);
    run_layer<3>(c, args, bar, lo, hi, ph);
}
#undef PHASE

#ifndef MK_N_LAUNCHES
#define MK_N_LAUNCHES 1
#endif
extern "C" void kernel_launch(void* const* d_in, const int* in_sizes, int n_in, void* d_out, int out_size, void* d_ws, size_t ws_size, hipStream_t stream) {
    static int grid = 0;
    if (grid == 0) {
        if (n_in != 25 || in_sizes[0] != MROWS * DM || out_size != MROWS * DM || ws_size < WS_END) {
            fprintf(stderr, "kernel_launch: unexpected shapes: n_in %d in0 %d out %d ws %zu (need %zu)\n", n_in, n_in > 0 ? in_sizes[0] : -1, out_size, ws_size, (size_t)WS_END); grid = -1; return; }
        int dev = 0, cus = 0, per_cu = 0;
        if (hipGetDevice(&dev) != hipSuccess || hipDeviceGetAttribute(&cus, hipDeviceAttributeMultiprocessorCount, dev) != hipSuccess) { grid = -1; return; }
        if (hipFuncSetAttribute((const void*)enc_fwd, hipFuncAttributeMaxDynamicSharedMemorySize, LDS_BYTES) != hipSuccess) { fprintf(stderr, "kernel_launch: hipFuncSetAttribute failed\n"); grid = -1; return; }
        if (hipOccupancyMaxActiveBlocksPerMultiprocessor(&per_cu, (const void*)enc_fwd, NTHREADS, LDS_BYTES) != hipSuccess || per_cu < 1)
            fprintf(stderr, "kernel_launch: note: occupancy query reports %d workgroups per CU\n", per_cu);
        (void)hipGetLastError();
        grid = cus;
    }
    if (grid < 0) return;
    Args a{};
    for (int i = 0; i < 25; ++i) a.in[i] = (const float*)d_in[i];
    a.out = (float*)d_out; a.ws = (unsigned char*)d_ws;
    if (MK_N_LAUNCHES == 1) {
        (void)hipMemsetAsync((char*)d_ws + WS_CTL, 0, CTL_ZERO_BYTES, stream);
        a.ph_lo = 0; a.ph_hi = NPHASES;
        hipLaunchKernelGGL(enc_fwd, dim3(grid), dim3(NTHREADS), LDS_BYTES, stream, a);
    } else {
        for (int p = 0; p < NPHASES; ++p) {
            (void)hipMemsetAsync((char*)d_ws + WS_CTL, 0, CTL_ZERO_BYTES, stream);
            a.ph_lo = p; a.ph_hi = p + 1;
            hipLaunchKernelGGL(enc_fwd, dim3(grid), dim3(NTHREADS), LDS_BYTES, stream, a);
        }
    }
    const hipError_t le = hipPeekAtLastError();
    if (le != hipSuccess) fprintf(stderr, "kernel_launch: launch failed: %s\n", hipGetErrorName(le));
}
```

```cpp
#include <hip/hip_runtime.h>
#include <cstdio>
#include <cstdint>

#define DI __device__ __forceinline__
#define LAS __attribute__((address_space(3)))
#define GAS __attribute__((address_space(1)))
typedef unsigned short bf16;
typedef short bf16x8 __attribute__((ext_vector_type(8)));
typedef short s16x4 __attribute__((ext_vector_type(4)));
typedef float f32x2 __attribute__((ext_vector_type(2)));
typedef float f32x4 __attribute__((ext_vector_type(4)));
typedef float f32x16 __attribute__((ext_vector_type(16)));
typedef unsigned u32x2 __attribute__((ext_vector_type(2)));
typedef unsigned u32x4 __attribute__((ext_vector_type(4)));
typedef __bf16 bf16x2_t __attribute__((ext_vector_type(2)));

constexpr int BATCH = 4, SEQ = 8192, DM = 1024, MROWS = BATCH * SEQ;
constexpr int FFN_H = 2816, FFN_U = 2 * FFN_H;
constexpr float EPS = 1e-6f, LOG2E = 1.4426950408889634f;
constexpr int NWAVES = 8, NTHREADS = NWAVES * 64;

constexpr size_t MiB = 1u << 20;
constexpr size_t WS_CTL = 0, CTL_ZERO_BYTES = 1 * MiB;
constexpr size_t WS_ROPE = 1 * MiB;
constexpr size_t WS_WT = 4 * MiB;
constexpr size_t WT_MIX = WS_WT, WT_UP = WS_WT + 16 * MiB, WT_DOWN = WS_WT + 28 * MiB;
constexpr size_t WS_XN = 40 * MiB;
constexpr size_t WS_S = 104 * MiB;
constexpr size_t WS_END = 512 * MiB;

DI unsigned pk2(float lo, float hi) { f32x2 v = {lo, hi}; bf16x2_t b = __builtin_convertvector(v, bf16x2_t); return __builtin_bit_cast(unsigned, b); }
DI float bflo(unsigned w) { return __uint_as_float(w << 16); }
DI float bfhi(unsigned w) { return __uint_as_float(w & 0xffff0000u); }
DI float bf2f(bf16 b) { return __uint_as_float((unsigned)b << 16); }
DI bf16 f2bf(float f) { return (bf16)(pk2(f, 0.f) & 0xffffu); }
DI float wave_sum(float v) {
#pragma unroll
    for (int o = 1; o < 64; o <<= 1) v += __shfl_xor(v, o);
    return v;
}
DI float fexp2(float x) { return __builtin_amdgcn_exp2f(x); }
DI float fexp(float x) { return __builtin_amdgcn_exp2f(x * LOG2E); }
DI float frcp(float x) { return __builtin_amdgcn_rcpf(x); }
DI float sigmoidf_(float x) { return frcp(1.f + fexp(-x)); }
DI float log_sigmoid_(float x) { return fminf(x, 0.f) - log1pf(expf(-fabsf(x))); }
DI int crow(int r, int hi) { return (r & 3) + 8 * (r >> 2) + 4 * hi; }
#define MFMA32(a, b, c) __builtin_amdgcn_mfma_f32_32x32x16_bf16((a), (b), (c), 0, 0, 0)

DI bf16x8 frag_row(const LAS bf16* base, int ld, int row0, int k0, int lane) {
    return *(const LAS bf16x8*)(base + (row0 + (lane & 31)) * ld + k0 + 8 * (lane >> 5));
}
typedef short v4i16_t __attribute__((ext_vector_type(4)));
DI s16x4 tr_rd(const LAS bf16* p) { return __builtin_bit_cast(s16x4, __builtin_amdgcn_ds_read_tr16_b64_v4i16((LAS v4i16_t*)p)); }
DI bf16x8 frag_tr(const LAS bf16* base, int ld, int k0, int n0, int lane) {
    const int g = lane >> 4, i = lane & 15, r = i >> 2, c = i & 3, h = lane >> 5;
    const LAS bf16* p = base + (k0 + 8 * h + r) * ld + n0 + 16 * (g & 1) + 4 * c;
    const s16x4 lo = tr_rd(p), hi = tr_rd(p + 4 * ld);
    return (bf16x8){lo[0], lo[1], lo[2], lo[3], hi[0], hi[1], hi[2], hi[3]};
}
DI bf16x8 gfrag_row(const bf16* base, int ld, int row0, int k0, int lane) {
    return *(const bf16x8*)(base + (size_t)(row0 + (lane & 31)) * ld + k0 + 8 * (lane >> 5));
}

namespace pg8 {
typedef unsigned short bf16_t;
constexpr int BM = 256, BK = 64, HALF = 128, HTB = HALF * BK * 2, STAGE_BYTES = 8 * HTB, NXCD = 8, WGM = 8;
__host__ __device__ __forceinline__ int lds_byte(int r, int c) { const int st = (r >> 4) * 2 + (c >> 5), rr = r & 15, cc = c & 31, ob = rr * 64 + cc * 2; return st * 1024 + (ob ^ (((ob >> 9) & 1) << 5)); }
__host__ __device__ __forceinline__ void stage_rc(int b, int& R, int& C) { const int st = b / 1024, sb = b % 1024, swz = sb ^ (((sb >> 9) & 1) << 5); R = (st >> 1) * 16 + swz / 64; C = (st & 1) * 32 + (swz % 64) / 2; }
__host__ __device__ __forceinline__ int perm32(int rho) { const int n = rho >> 4, i = rho & 15; return 8 * (i >> 2) + 4 * n + (i & 3); }

struct Unit { int pm, pn; };
struct Gemm { const bf16_t* A; const bf16_t* Bt; int M, N, K; int lda; int kpairA; };

struct StaticOrder {
    int nM, nN, nwg, G, c;
    __host__ __device__ void init(int M, int N, int G_, int c_) { nM = M / BM; nN = N / BM; nwg = nM * nN; G = G_; c = c_; }
    __host__ __device__ bool next(int i, Unit& u) const {
        const long L = (long)i * G + c; if (L >= nwg) return false;
        int wgid = (int)L; { const int q = nwg / NXCD, r = nwg % NXCD, xcd = wgid % NXCD, off = wgid / NXCD; wgid = (xcd < r ? xcd * (q + 1) : r * (q + 1) + (xcd - r) * q) + off; }
        const int nig = WGM * nN, gid = wgid / nig, fm = gid * WGM, gsz = (nM - fm) < WGM ? (nM - fm) : WGM;
        u.pm = fm + ((wgid % nig) % gsz); u.pn = (wgid % nig) / gsz; return true;
    }
};

DI void store8(bf16_t* p, f32x4 v0, f32x4 v1, float sc) {
    u32x4 w; w.x = pk2(v0[0] * sc, v0[1] * sc); w.y = pk2(v0[2] * sc, v0[3] * sc); w.z = pk2(v1[0] * sc, v1[1] * sc); w.w = pk2(v1[2] * sc, v1[3] * sc);
    *(u32x4*)p = w;
}
template <bool GATES> struct EpiSeg {
    static constexpr bool PERM = true;
    bf16_t *p0, *p1, *p2, *p3; int ld0, ld1, ld2, ld3; int e0, e1, e2; float s0, s1, s2, s3;
    float* gates; const float* gbias; int gblk;
    const float* rowscale;
    DI void operator()(const f32x4 (&acc)[2][2][4][2], const Unit& u, int wr, int wc, int fr, int fq) const {
        const int row0 = u.pm * BM + wr * 64 + fr;
#define RS_(ai, m) (rowscale ? rowscale[row0 + (ai) * HALF + (m) * 16] : 1.f)
#pragma unroll
        for (int bj = 0; bj < 2; ++bj) {
            const int blk = 2 * u.pn + bj;
            if (GATES && blk >= gblk) {
                if (blk == gblk && wc == 0) {
                    const f32x4 b0 = *(const f32x4*)(gbias + 8 * fq), b1 = *(const f32x4*)(gbias + 8 * fq + 4);
#pragma unroll
                    for (int ai = 0; ai < 2; ++ai)
#pragma unroll
                        for (int m = 0; m < 4; ++m) { float* gp = gates + (size_t)(row0 + ai * HALF + m * 16) * 32 + 8 * fq;
                            const float r_ = RS_(ai, m); *(f32x4*)gp = acc[ai][bj][m][0] * r_ + b0; *(f32x4*)(gp + 4) = acc[ai][bj][m][1] * r_ + b1; }
                }
                continue;
            }
            bf16_t* base; int ld, b0; float sc;
            if (blk < e0) { base = p0; ld = ld0; b0 = 0; sc = s0; }
            else if (blk < e1) { base = p1; ld = ld1; b0 = e0; sc = s1; }
            else if (blk < e2) { base = p2; ld = ld2; b0 = e1; sc = s2; }
            else { base = p3; ld = ld3; b0 = e2; sc = s3; }
            bf16_t* cp = base + (blk - b0) * 128 + wc * 32 + 8 * fq;
#pragma unroll
            for (int ai = 0; ai < 2; ++ai)
#pragma unroll
                for (int m = 0; m < 4; ++m) store8(cp + (size_t)(row0 + ai * HALF + m * 16) * ld, acc[ai][bj][m][0], acc[ai][bj][m][1], sc * RS_(ai, m));
        }
#undef RS_
    }
};
DI EpiSeg<false> epi_plain(bf16_t* O, int ld, float sc, const float* rowscale = nullptr) { EpiSeg<false> E{}; E.p0 = O; E.ld0 = ld; E.e0 = 100000; E.e1 = 100000; E.e2 = 100000; E.s0 = sc; E.rowscale = rowscale; return E; }
struct EpiF32 {
    static constexpr bool PERM = true;
    float* O; int ld;
    DI void operator()(const f32x4 (&acc)[2][2][4][2], const Unit& u, int wr, int wc, int fr, int fq) const {
        const int row0 = u.pm * BM + wr * 64 + fr;
#pragma unroll
        for (int bj = 0; bj < 2; ++bj) { float* cp = O + u.pn * 256 + bj * 128 + wc * 32 + 8 * fq;
#pragma unroll
            for (int ai = 0; ai < 2; ++ai)
#pragma unroll
                for (int m = 0; m < 4; ++m) { float* rp = cp + (size_t)(row0 + ai * HALF + m * 16) * ld; *(f32x4*)rp = acc[ai][bj][m][0]; *(f32x4*)(rp + 4) = acc[ai][bj][m][1]; } }
    }
};
struct EpiMlaKV {
    static constexpr bool PERM = true;
    bf16_t* KF; bf16_t* V;
    DI void operator()(const f32x4 (&acc)[2][2][4][2], const Unit& u, int wr, int wc, int fr, int fq) const {
        const int row0 = u.pm * BM + wr * 64 + fr;
#pragma unroll
        for (int bj = 0; bj < 2; ++bj) {
            bf16_t* cp = (bj == 0 ? KF + u.pn * 192 : V + u.pn * 128) + wc * 32 + 8 * fq; const int ld = (bj == 0) ? 1536 : 1024;
#pragma unroll
            for (int ai = 0; ai < 2; ++ai)
#pragma unroll
                for (int m = 0; m < 4; ++m) store8(cp + (size_t)(row0 + ai * HALF + m * 16) * ld, acc[ai][bj][m][0], acc[ai][bj][m][1], 1.f);
        }
    }
};
struct EpiFfnUp {
    static constexpr bool PERM = true;
    bf16_t* U; bf16_t* HALO; const float* rowscale;
    DI void operator()(const f32x4 (&acc)[2][2][4][2], const Unit& u, int wr, int wc, int fr, int fq) const {
        const int row0 = u.pm * BM + wr * 64 + fr;
        float rs[2][4];
#pragma unroll
        for (int ai = 0; ai < 2; ++ai)
#pragma unroll
            for (int m = 0; m < 4; ++m) rs[ai][m] = rowscale[row0 + ai * HALF + m * 16];
#pragma unroll
        for (int bj = 0; bj < 2; ++bj) {
            const int col = u.pn * 256 + bj * 128 + wc * 32 + 8 * fq;
#pragma unroll
            for (int ai = 0; ai < 2; ++ai)
#pragma unroll
                for (int m = 0; m < 4; ++m) {
                    const int row = row0 + ai * HALF + m * 16;
                    store8(U + (size_t)row * FFN_U + col, acc[ai][bj][m][0], acc[ai][bj][m][1], rs[ai][m]);
                    if (fr == 0 || fr == 15) store8(HALO + ((size_t)(row >> 4) * 2 + (fr == 15 ? 1 : 0)) * FFN_U + col, acc[ai][bj][m][0], acc[ai][bj][m][1], rs[ai][m]);
                }
        }
    }
};

template <class Epi>
DI void gemm_phase(LAS unsigned char* lds, const int tid, const Gemm g, const StaticOrder& S, const Epi& E) {
    const int wid = __builtin_amdgcn_readfirstlane(tid >> 6), lane = tid & 63, wr = wid >> 2, wc = wid & 3, fr = lane & 15, fq = lane >> 4;
    const int K = g.K; int nt = K / BK; asm volatile("" : "+s"(nt));
    unsigned voffA[2], voffB[2];
#pragma unroll
    for (int i = 0; i < 2; ++i) { int R, C; stage_rc(tid * 16 + i * 8192, R, C); const int Rb = Epi::PERM ? ((R & ~31) + perm32(R & 31)) : R;
        voffA[i] = (unsigned)(R * g.lda + C) * 2u; voffB[i] = (unsigned)(Rb * K + C) * 2u; }
    const size_t kstep = (size_t)(BK * 2);
    const size_t kpairA = (size_t)g.kpairA;
    const size_t hstepA = (size_t)HALF * g.lda * 2, hstepB = (size_t)HALF * K * 2;
    const size_t tstepA = 2 * hstepA, tstepB = 2 * hstepB;
    const unsigned ldsw = (unsigned)wid * 1024u;
    const int aoff = lds_byte(wr * 64 + fr, fq * 8), boff = lds_byte(wc * 32 + fr, fq * 8);
#define PG8_SA(b, h) (((b) * 2 + (h)) * HTB)
#define PG8_SB(b, h) ((4 + (b) * 2 + (h)) * HTB)
#define PG8_STAGE(bufoff, gbase, voff) do { _Pragma("unroll") for (int _i = 0; _i < 2; ++_i) \
        __builtin_amdgcn_global_load_lds((const unsigned*)((const char*)(gbase) + (voff)[_i]), (LAS unsigned*)(lds + (bufoff) + ldsw + _i * 8192), 16, 0, 0); } while (0)
#define PG8_LDA(dst, b, h) do { _Pragma("unroll") for (int m = 0; m < 4; ++m) _Pragma("unroll") for (int k = 0; k < 2; ++k) dst[m][k] = *(const LAS bf16x8*)(lds + PG8_SA(b, h) + aoff + m * 2048 + k * 1024); } while (0)
#define PG8_LDB(dst, b, h) do { _Pragma("unroll") for (int n = 0; n < 2; ++n) _Pragma("unroll") for (int k = 0; k < 2; ++k) dst[n][k] = *(const LAS bf16x8*)(lds + PG8_SB(b, h) + boff + n * 2048 + k * 1024); } while (0)
#define PG8_MMA(ai, bj, At, Bt) do { __builtin_amdgcn_s_setprio(1); _Pragma("unroll") for (int m = 0; m < 4; ++m) _Pragma("unroll") for (int n = 0; n < 2; ++n) _Pragma("unroll") for (int k = 0; k < 2; ++k) \
        acc[ai][bj][m][n] = __builtin_amdgcn_mfma_f32_16x16x32_bf16(Bt[n][k], At[m][k], acc[ai][bj][m][n], 0, 0, 0); __builtin_amdgcn_s_setprio(0); } while (0)
#define PG8_WAIT_V(n) asm volatile("s_waitcnt vmcnt(" #n ")" ::: "memory")
#define PG8_WAIT_L(n) asm volatile("s_waitcnt lgkmcnt(" #n ")" ::: "memory")
#define PG8_BAR __builtin_amdgcn_s_barrier()
#define PG8_SCHED __builtin_amdgcn_sched_barrier(0)
    Unit cur, nxt; int ui = 0;
    if (!S.next(0, cur)) return;
    f32x4 acc[2][2][4][2];
#pragma unroll
    for (int a = 0; a < 2; ++a)
#pragma unroll
        for (int b = 0; b < 2; ++b)
#pragma unroll
            for (int m = 0; m < 4; ++m)
#pragma unroll
                for (int n = 0; n < 2; ++n) acc[a][b][m][n] = (f32x4){0.f, 0.f, 0.f, 0.f};
    bf16x8 At[4][2], B0[2][2], B1[2][2];
    const char* cA = (const char*)g.A + (size_t)cur.pm * tstepA; const char* cB = (const char*)g.Bt + (size_t)cur.pn * tstepB;
    PG8_STAGE(PG8_SB(0, 0), cB, voffB); PG8_STAGE(PG8_SB(0, 1), cB + hstepB, voffB); PG8_STAGE(PG8_SA(0, 0), cA, voffA); PG8_STAGE(PG8_SA(0, 1), cA + hstepA, voffA);
    if (wr == 1) PG8_BAR;
    PG8_WAIT_V(2); PG8_BAR;
    PG8_STAGE(PG8_SB(1, 0), cB + kstep, voffB); PG8_STAGE(PG8_SA(1, 0), cA + kstep, voffA); PG8_STAGE(PG8_SB(1, 1), cB + hstepB + kstep, voffB);
    PG8_WAIT_V(6); PG8_BAR;
    for (;;) {
        const bool has_next = S.next(ui + 1, nxt);
        const char* nA = has_next ? (const char*)g.A + (size_t)nxt.pm * tstepA : cA; const char* nB = has_next ? (const char*)g.Bt + (size_t)nxt.pn * tstepB : cB;
#pragma unroll 1
        for (int t = 0; t < nt; t += 2) {
            const bool last = (t == nt - 2);
            const char* a1 = cA + (size_t)(t >> 1) * kpairA + kstep;
            const char* a2 = last ? nA : cA + (size_t)((t >> 1) + 1) * kpairA; const char* b2 = last ? nB : cB + (size_t)(t + 2) * kstep;
            const char* a3 = a2 + kstep; const char* b3 = b2 + kstep;
            PG8_LDB(B0, 0, 0); PG8_LDB(B1, 0, 1); PG8_SCHED; PG8_LDA(At, 0, 0); PG8_STAGE(PG8_SA(1, 1), a1 + hstepA, voffA);
            PG8_WAIT_V(8); PG8_WAIT_L(0); PG8_BAR; PG8_MMA(0, 0, At, B0); PG8_MMA(0, 1, At, B1); PG8_BAR; PG8_SCHED;
            PG8_LDA(At, 0, 1); PG8_STAGE(PG8_SB(0, 0), b2, voffB); PG8_STAGE(PG8_SB(0, 1), b2 + hstepB, voffB); PG8_STAGE(PG8_SA(0, 0), a2, voffA);
            PG8_WAIT_V(8); PG8_WAIT_L(0); PG8_BAR; PG8_MMA(1, 0, At, B0); PG8_MMA(1, 1, At, B1); PG8_BAR; PG8_SCHED;
            PG8_LDB(B0, 1, 0); PG8_LDB(B1, 1, 1); PG8_SCHED; PG8_LDA(At, 1, 0); PG8_STAGE(PG8_SA(0, 1), a2 + hstepA, voffA);
            PG8_WAIT_V(8); PG8_WAIT_L(0); PG8_BAR; PG8_MMA(0, 0, At, B0); PG8_MMA(0, 1, At, B1); PG8_BAR; PG8_SCHED;
            PG8_LDA(At, 1, 1); PG8_STAGE(PG8_SB(1, 0), b3, voffB); PG8_STAGE(PG8_SB(1, 1), b3 + hstepB, voffB); PG8_STAGE(PG8_SA(1, 0), a3, voffA);
            PG8_WAIT_V(8); PG8_WAIT_L(0); PG8_BAR; PG8_MMA(1, 0, At, B0); PG8_MMA(1, 1, At, B1); PG8_BAR; PG8_SCHED;
        }
        if (wr == 0) PG8_BAR;
        E(acc, cur, wr, wc, fr, fq);
        if (!has_next) break;
#pragma unroll
        for (int a = 0; a < 2; ++a)
#pragma unroll
            for (int b = 0; b < 2; ++b)
#pragma unroll
                for (int m = 0; m < 4; ++m)
#pragma unroll
                    for (int n = 0; n < 2; ++n) acc[a][b][m][n] = (f32x4){0.f, 0.f, 0.f, 0.f};
        cur = nxt; cA = nA; cB = nB; ++ui;
        if (wr == 1) PG8_BAR;
    }
    PG8_WAIT_V(0);
    PG8_BAR;
#undef PG8_SA
#undef PG8_SB
#undef PG8_STAGE
#undef PG8_LDA
#undef PG8_LDB
#undef PG8_MMA
#undef PG8_WAIT_V
#undef PG8_WAIT_L
#undef PG8_BAR
#undef PG8_SCHED
}
}

namespace att {
constexpr int NW = 8, QBLK = 32, KVBLK = 64, DV = 128;
constexpr float THR2 = 8.f;
#define SBAR() __builtin_amdgcn_sched_barrier(0)
DI unsigned cvtpk(float lo, float hi) { unsigned r; asm volatile("v_cvt_pk_bf16_f32 %0, %1, %2" : "=v"(r) : "v"(lo), "v"(hi)); return r; }
DI void partialSM(f32x16& p0, f32x16& p1, float& m_reg, float& mn, float& alpha) {
    float pmax = p0[0];
#pragma unroll
    for (int r = 1; r < 16; ++r) pmax = fmaxf(pmax, p0[r]);
#pragma unroll
    for (int r = 0; r < 16; ++r) pmax = fmaxf(pmax, p1[r]);
    { auto rr = __builtin_amdgcn_permlane32_swap(__float_as_uint(pmax), __float_as_uint(pmax), false, false);
      pmax = fmaxf(__uint_as_float(rr[0]), __uint_as_float(rr[1])); }
    if (__builtin_expect(__all(pmax - m_reg <= THR2), 1)) { mn = m_reg; alpha = 1.f; }
    else { mn = fmaxf(m_reg, pmax); alpha = __builtin_amdgcn_exp2f(m_reg - mn); m_reg = mn; }
#pragma unroll
    for (int r = 0; r < 16; ++r) p0[r] = p0[r] - mn;
#pragma unroll
    for (int r = 0; r < 16; ++r) p1[r] = p1[r] - mn;
#pragma unroll
    for (int r = 0; r < 16; ++r) p0[r] = __builtin_amdgcn_exp2f(p0[r]);
}
DI void finishSM(f32x16& p0, f32x16& p1, float alpha, float& l_reg, bf16x8& pa0, bf16x8& pa1, bf16x8& pa2, bf16x8& pa3) {
#pragma unroll
    for (int r = 0; r < 16; ++r) p1[r] = __builtin_amdgcn_exp2f(p1[r]);
    float ps = 0;
#pragma unroll
    for (int r = 0; r < 16; ++r) ps += p0[r];
#pragma unroll
    for (int r = 0; r < 16; ++r) ps += p1[r];
    { auto rr = __builtin_amdgcn_permlane32_swap(__float_as_uint(ps), __float_as_uint(ps), false, false);
      ps = __uint_as_float(rr[0]) + __uint_as_float(rr[1]); }
    l_reg = l_reg * alpha + ps;
#define PK4(P, BASE, OUT) do { unsigned a0 = cvtpk(P[BASE + 0], P[BASE + 1]), a1 = cvtpk(P[BASE + 2], P[BASE + 3]);   \
    unsigned b0 = cvtpk(P[BASE + 4], P[BASE + 5]), b1 = cvtpk(P[BASE + 6], P[BASE + 7]);                              \
    auto r0 = __builtin_amdgcn_permlane32_swap(a0, b0, false, false); auto r1 = __builtin_amdgcn_permlane32_swap(a1, b1, false, false); \
    u32x4 w = {r0[0], r1[0], r0[1], r1[1]}; OUT = *reinterpret_cast<bf16x8*>(&w); } while (0)
    PK4(p0, 0, pa0); PK4(p0, 8, pa1); PK4(p1, 0, pa2); PK4(p1, 8, pa3);
#undef PK4
}
DI int v_st(int k, int c) { const int kk = (k & ~0xC) | ((k & 4) << 1) | ((k & 8) >> 1); return ((kk >> 3) * 4 + (c >> 5)) * 512 + ((kk & 7) * 32 + (c & 31)) * 2; }
DI int v_rd_base(int lane) { return ((lane & 3) << 3) | (((lane >> 2) & 3) << 6) | (((lane >> 4) & 1) << 5) | (((lane >> 5) & 1) << 8); }
constexpr int v_rd_off(int d0, int ks, int half) { return d0 * 512 + ks * 4096 + half * 2048; }
template <int OFF> DI s16x4 tr_read(int vb) {
    s16x4 r; asm volatile("ds_read_b64_tr_b16 %0, %1 offset:%2" : "=&v"(r) : "v"(vb), "i"(OFF) : "memory"); return r;
}
template <int D0> DI void pv_one(f32x16& od, int vb, bf16x8 pa0, bf16x8 pa1, bf16x8 pa2, bf16x8 pa3) {
    const s16x4 l0 = tr_read<v_rd_off(D0, 0, 0)>(vb), h0 = tr_read<v_rd_off(D0, 0, 1)>(vb), l1 = tr_read<v_rd_off(D0, 1, 0)>(vb), h1 = tr_read<v_rd_off(D0, 1, 1)>(vb);
    const s16x4 l2 = tr_read<v_rd_off(D0, 2, 0)>(vb), h2 = tr_read<v_rd_off(D0, 2, 1)>(vb), l3 = tr_read<v_rd_off(D0, 3, 0)>(vb), h3 = tr_read<v_rd_off(D0, 3, 1)>(vb);
    asm volatile("s_waitcnt lgkmcnt(0)" ::: "memory"); SBAR();
#define PK(L, H) (bf16x8){L[0], L[1], L[2], L[3], H[0], H[1], H[2], H[3]}
    od = MFMA32(pa0, PK(l0, h0), od);
    od = MFMA32(pa1, PK(l1, h1), od);
    od = MFMA32(pa2, PK(l2, h2), od);
    od = MFMA32(pa3, PK(l3, h3), od);
#undef PK
}
DI void pv_d0(f32x16* o, int vb, bf16x8 pa0, bf16x8 pa1, bf16x8 pa2, bf16x8 pa3) {
    pv_one<0>(o[0], vb, pa0, pa1, pa2, pa3); pv_one<1>(o[1], vb, pa0, pa1, pa2, pa3); pv_one<2>(o[2], vb, pa0, pa1, pa2, pa3); pv_one<3>(o[3], vb, pa0, pa1, pa2, pa3);
}

template <int DQK> struct Cfg {
    static constexpr int KROWB = DQK * 2 + 16;
    static constexpr int SHM_V = KVBLK * DV * 2, SHM_K = KVBLK * KROWB;
    static constexpr int SHM = 2 * SHM_V + 2 * SHM_K + NW * 64 * 4 + NW * 4096;
    static constexpr int NKC = DQK / 64;
    static constexpr int CPR = DQK / 8;
};
template <int DQK, bool ALIBI, bool ROPE, int ldq, int ldk, int ldv, int ldo>
DI void attn_unit(const bf16* __restrict__ Qb, const bf16* __restrict__ Kh, const bf16* __restrict__ Vh,
                  bf16* __restrict__ Ob, int seq, float slope2, int qpos0, const float* __restrict__ rope, char* lds, const int tid_in, const float kmax) {
    using C = Cfg<DQK>;
    constexpr int ND = DQK / 16;
    int tid = tid_in; asm volatile("" : "+v"(tid));
    const int wid = tid >> 6, lane = tid & 63, r32 = lane & 31, hi = lane >> 5;
    char* V_lds = lds; char* K_lds = lds + 2 * C::SHM_V;
    float* ws = (float*)(lds + 2 * C::SHM_V + 2 * C::SHM_K) + wid * 64; float* li_l = ws; float* al_l = ws + 32;
    float m_reg = -1e30f, l_reg = 0; f32x16 o[4] = {}; bf16x8 qr[ND];
    const bf16* Qw = Qb + (long)(wid * QBLK + r32) * ldq + hi * 8;
#pragma unroll
    for (int d0 = 0; d0 < ND; ++d0) qr[d0] = *reinterpret_cast<const bf16x8*>(Qw + d0 * 16);
    char* qrope = lds + 2 * C::SHM_V + 2 * C::SHM_K + NW * 64 * 4 + wid * 4096 + lane * 16;
    if (ROPE) {
        const float* rp = rope + (size_t)(qpos0 + wid * QBLK + r32) * 64;
#pragma unroll
        for (int d0 = ND - 4; d0 < ND; ++d0) {
            const f32x4 c0 = *(const f32x4*)(rp + (8 * (d0 - (ND - 4)) + 4 * hi) * 2), c1 = *(const f32x4*)(rp + (8 * (d0 - (ND - 4)) + 4 * hi) * 2 + 4);
            const u32x4 w = __builtin_bit_cast(u32x4, qr[d0]); u32x4 o_;
            { const float a = bflo(w[0]), b = bfhi(w[0]); o_[0] = pk2(a * c0[0] - b * c0[1], a * c0[1] + b * c0[0]); }
            { const float a = bflo(w[1]), b = bfhi(w[1]); o_[1] = pk2(a * c0[2] - b * c0[3], a * c0[3] + b * c0[2]); }
            { const float a = bflo(w[2]), b = bfhi(w[2]); o_[2] = pk2(a * c1[0] - b * c1[1], a * c1[1] + b * c1[0]); }
            { const float a = bflo(w[3]), b = bfhi(w[3]); o_[3] = pk2(a * c1[2] - b * c1[3], a * c1[3] + b * c1[2]); }
            *(u32x4*)(qrope + (d0 - (ND - 4)) * 1024) = o_;
        }
    }
    const int sr = tid >> 4, sc = (tid & 15) * 8, vst0 = v_st(sr, sc), vst1 = v_st(32 + sr, sc);
    int krow[C::NKC], kcol[C::NKC], kdst[C::NKC];
#pragma unroll
    for (int i = 0; i < C::NKC; ++i) { const int c = tid + 512 * i; krow[i] = c / C::CPR; kcol[i] = (c % C::CPR) * 8; kdst[i] = krow[i] * C::KROWB + kcol[i] * 2; }
    const int vb0 = (int)(uintptr_t)V_lds + v_rd_base(lane);
    const float qposh = (float)(qpos0 + wid * QBLK + r32 - 4 * hi);
    constexpr int SD = (DQK <= 64) ? 2 : 1;
    struct { bf16x8 vs0, vs1, ks[C::NKC]; } st_[SD];
#define SLOAD(s_, k0) do { st_[s_].vs0 = *reinterpret_cast<const bf16x8*>(&Vh[(long)((k0) + sr) * ldv + sc]); st_[s_].vs1 = *reinterpret_cast<const bf16x8*>(&Vh[(long)((k0) + 32 + sr) * ldv + sc]); \
    _Pragma("unroll") for (int i_ = 0; i_ < C::NKC; ++i_) st_[s_].ks[i_] = *reinterpret_cast<const bf16x8*>(&Kh[(long)((k0) + krow[i_]) * ldk + kcol[i_]]); } while (0)
#define SWRITE(s_, b) do { *(bf16x8*)(V_lds + (b) * C::SHM_V + vst0) = st_[s_].vs0; *(bf16x8*)(V_lds + (b) * C::SHM_V + vst1) = st_[s_].vs1; \
    _Pragma("unroll") for (int i_ = 0; i_ < C::NKC; ++i_) *(bf16x8*)(K_lds + (b) * C::SHM_K + kdst[i_]) = st_[s_].ks[i_]; } while (0)
#define SWAIT() asm volatile("s_waitcnt vmcnt(0)" ::: "memory")
#define RESC(a) do { if (__any((a) < 1.f)) { if (hi == 0) al_l[r32] = (a); asm volatile("s_waitcnt lgkmcnt(0)" ::: "memory"); \
    _Pragma("unroll") for (int d = 0; d < 4; ++d) _Pragma("unroll") for (int r = 0; r < 16; ++r) o[d][r] *= al_l[crow(r, hi)]; } } while (0)
#define KLD(i_, KB, d0_) do { const int cb_ = ((d0_) * 16 + hi * 8) * 2; kb0[i_] = *reinterpret_cast<const bf16x8*>((KB) + r32 * C::KROWB + cb_); kb1[i_] = *reinterpret_cast<const bf16x8*>((KB) + (32 + r32) * C::KROWB + cb_); } while (0)
#define QKT(P0, P1, KB, k0) do { P0 = f32x16{}; P1 = f32x16{}; bf16x8 kb0[3], kb1[3]; \
    KLD(0, KB, 0); KLD(1, KB, 1); \
    _Pragma("unroll") for (int d0 = 0; d0 < ND; ++d0) { \
        if (d0 + 2 < ND) KLD((d0 + 2) % 3, KB, d0 + 2); \
        SBAR(); \
        const bf16x8 qf_ = (ROPE && d0 >= ND - 4) ? *reinterpret_cast<const bf16x8*>(qrope + (d0 - (ND - 4)) * 1024) : qr[d0]; \
        P0 = MFMA32(kb0[d0 % 3], qf_, P0); P1 = MFMA32(kb1[d0 % 3], qf_, P1); SBAR(); } \
    if (ALIBI) { const float kb_ = qposh - (float)(k0); \
        _Pragma("unroll") for (int r = 0; r < 16; ++r) { const float d_ = kb_ - (float)((r & 3) + 8 * (r >> 2)); P0[r] -= slope2 * fabsf(d_); P1[r] -= slope2 * fabsf(d_ - 32.f); } } } while (0)
    f32x16 pA0, pA1; float mnA, alA; bf16x8 pa0, pa1, pa2, pa3; int NT = seq / KVBLK; int jlo = 0;
    if (ALIBI) {
        float sq = 0.f;
#pragma unroll
        for (int d0 = 0; d0 < ND; ++d0) { const u32x4 w = __builtin_bit_cast(u32x4, qr[d0]);
#pragma unroll
            for (int q4 = 0; q4 < 4; ++q4) sq += bflo(w[q4]) * bflo(w[q4]) + bfhi(w[q4]) * bfhi(w[q4]); }
        sq += __shfl_xor(sq, 32);
#pragma unroll
        for (int o_ = 1; o_ < 32; o_ <<= 1) sq = fmaxf(sq, __shfl_xor(sq, o_));
        if (lane == 0) ws[63] = sq;
        __syncthreads();
        float qm = 0.f;
#pragma unroll
        for (int w_ = 0; w_ < NW; ++w_) qm = fmaxf(qm, ((const float*)(lds + 2 * C::SHM_V + 2 * C::SHM_K))[w_ * 64 + 63]);
        const float bound = 2.f * sqrtf(qm) * kmax * 1.01f + 40.f;
        const float dc = fminf(bound / slope2, 16384.f);
        const int dcut = (int)dc + 1;
        const int a_ = qpos0 - dcut; jlo = a_ > 0 ? (a_ >> 6) : 0;
        const int b_ = (qpos0 + QBLK * NW - 1 + dcut) >> 6; NT = b_ + 1 < NT ? b_ + 1 : NT;
    }
    const int nT = NT - jlo;
    SLOAD(0, jlo * KVBLK); SWAIT(); SWRITE(0, 0);
    if (1 < nT) SLOAD(SD - 1, (jlo + 1) * KVBLK);
    if (SD == 2 && 2 < nT) SLOAD(0, (jlo + 2) * KVBLK);
    __syncthreads();
#define STG(t, P) do { if ((t) + 1 < nT) { if (SD == 1) SWAIT(); SWRITE((SD == 2 ? (P) : 0), (P)); } if ((t) + 1 + SD < nT) SLOAD((SD == 2 ? (P) : 0), (jlo + (t) + 1 + SD) * KVBLK); } while (0)
#define H1(t, B) do { SBAR(); QKT(pA0, pA1, K_lds + (B) * C::SHM_K, (jlo + (t)) * KVBLK); partialSM(pA0, pA1, m_reg, mnA, alA); RESC(alA); } while (0)
#define H2(t, B) do { finishSM(pA0, pA1, alA, l_reg, pa0, pa1, pa2, pa3); SBAR(); pv_d0(o, vb0 + (B) * C::SHM_V, pa0, pa1, pa2, pa3); } while (0)
    if (__builtin_amdgcn_readfirstlane(wid) < 4) {
        int t = 0;
#pragma unroll 1
        for (; t + 1 < nT; t += 2) { H1(t, 0); __syncthreads(); STG(t, 1); H2(t, 0); __syncthreads(); H1(t + 1, 1); __syncthreads(); STG(t + 1, 0); H2(t + 1, 1); __syncthreads(); }
        if (t < nT) { H1(t, 0); __syncthreads(); STG(t, 1); H2(t, 0); __syncthreads(); }
        __syncthreads();
    } else {
        __syncthreads();
        int t = 0;
#pragma unroll 1
        for (; t + 1 < nT; t += 2) { STG(t, 1); H1(t, 0); __syncthreads(); H2(t, 0); __syncthreads(); STG(t + 1, 0); H1(t + 1, 1); __syncthreads(); H2(t + 1, 1); __syncthreads(); }
        if (t < nT) { STG(t, 1); H1(t, 0); __syncthreads(); H2(t, 0); __syncthreads(); }
    }
#undef STG
#undef H1
#undef H2
    if (hi == 0) li_l[r32] = l_reg; asm volatile("s_waitcnt lgkmcnt(0)" ::: "memory");
    float rli[16];
#pragma unroll
    for (int r = 0; r < 16; ++r) rli[r] = __builtin_amdgcn_rcpf(li_l[crow(r, hi)]);
    bf16* Ow = Ob + (long)(wid * QBLK) * ldo;
#pragma unroll
    for (int r = 0; r < 16; ++r) { const int orow = crow(r, hi);
#pragma unroll
        for (int d0 = 0; d0 < 4; ++d0) Ow[(long)orow * ldo + d0 * 32 + r32] = f2bf(o[d0][r] * rli[r]); }
    __syncthreads();
#undef SLOAD
#undef SWRITE
#undef SWAIT
#undef RESC
#undef QKT
#undef KLD
}
#undef SBAR
}

#define XB_TMO      128
#define XB_XCNT(j)  (256  + 64 * (j))
#define XB_XSUB(j)  (1280 + 64 * (j))
#define XB_XGEN(j)  (2304 + 64 * (j))
#define XB_TOP      3328
#define XB_TOPGEN   3392
#define XCD_BAR_WORDS 3456
#define XB_SPIN_CAP (1u << 18)
DI unsigned xb_ld(unsigned* p)              { return __hip_atomic_load(p, __ATOMIC_RELAXED, __HIP_MEMORY_SCOPE_AGENT); }
DI unsigned xb_add(unsigned* p, unsigned v) { return __hip_atomic_fetch_add(p, v, __ATOMIC_RELAXED, __HIP_MEMORY_SCOPE_AGENT); }
DI unsigned xb_xcc_id() { return (unsigned)__builtin_amdgcn_s_getreg((3 << 11) | 20) & 0xFu; }
#define XB_SPIN(cond, bar) do { unsigned _sp = 0; while (cond) { __builtin_amdgcn_s_sleep(1); \
    if ((++_sp & 255u) == 0u) { if (xb_ld(&(bar)[XB_TMO])) break; if (_sp > XB_SPIN_CAP) { atomicAdd(&(bar)[XB_TMO], 1u); break; } } } } while (0)
struct XcdBarrier { unsigned* bar; unsigned x; volatile LAS unsigned* st; };
DI XcdBarrier xcd_barrier_post(unsigned* bar, volatile LAS unsigned* st) {
    XcdBarrier b; b.bar = bar; b.x = xb_xcc_id(); b.st = st;
    if (threadIdx.x == 0) (void)xb_add(&bar[XB_XCNT(b.x)], 1u);
    return b;
}
DI void xcd_barrier_complete(unsigned* bar, unsigned x, unsigned& nloc, unsigned& nx) {
    const unsigned G = gridDim.x * gridDim.y * gridDim.z;
    unsigned sum, cnt, mine, sp = 0u;
    for (;;) {
        sum = 0u; cnt = 0u; mine = 0u;
#pragma unroll
        for (unsigned j = 0; j < 16; ++j) { const unsigned c = xb_ld(&bar[XB_XCNT(j)]); sum += c; cnt += (c > 0u) ? 1u : 0u; mine = (j == x) ? c : mine; }
        if (sum == G) break;
        __builtin_amdgcn_s_sleep(1);
        if ((++sp & 255u) == 0u) { if (xb_ld(&bar[XB_TMO])) break; if (sp > XB_SPIN_CAP) { atomicAdd(&bar[XB_TMO], 1u); break; } }
    }
    nloc = mine > 0u ? mine : 1u; nx = cnt > 0u ? cnt : 1u;
}
DI void xcd_barrier(const XcdBarrier& b) {
    asm volatile("s_waitcnt vmcnt(0)" ::: "memory");
    __syncthreads();
    if (threadIdx.x == 0) {
        unsigned* bar = b.bar;
        __builtin_amdgcn_s_waitcnt(0);
        unsigned nloc = b.st[0], nx = b.st[1];
        if (nloc == 0u) { xcd_barrier_complete(bar, b.x, nloc, nx); b.st[0] = nloc; b.st[1] = nx; }
        const unsigned old = xb_add(&bar[XB_XSUB(b.x)], 1u);
        const unsigned gen = old / nloc;
        if (old + 1u == (gen + 1u) * nloc) {
            __builtin_amdgcn_fence(__ATOMIC_RELEASE, "agent");
            asm volatile("s_waitcnt vmcnt(0)" ::: "memory");
            const unsigned og = xb_add(&bar[XB_TOP], 1u);
            const unsigned tg = og / nx;
            if (og + 1u == (tg + 1u) * nx) xb_add(&bar[XB_TOPGEN], 1u);
            else XB_SPIN(xb_ld(&bar[XB_TOPGEN]) == tg, bar);
            __builtin_amdgcn_fence(__ATOMIC_ACQUIRE, "agent");
            xb_add(&bar[XB_XGEN(b.x)], 1u);
            asm volatile("s_waitcnt vmcnt(0)" ::: "memory");
        } else {
            XB_SPIN(xb_ld(&bar[XB_XGEN(b.x)]) == gen, bar);
            __builtin_amdgcn_fence(__ATOMIC_ACQUIRE, "agent");
            asm volatile("s_waitcnt vmcnt(0)" ::: "memory");
        }
    }
    __syncthreads();
}

constexpr int RING_BYTES = 131072;
constexpr int LDSCTL_OFF = RING_BYTES, MISC_OFF = LDSCTL_OFF + 320;
constexpr int LDS_BYTES = 147456;

struct Ctx { LAS unsigned char* lds; int tid, lane, wave, G, bx, gw, NGW; };

enum { MAP_ID = 0, MAP_ROPEQ = 1, MAP_FFNUP = 2 };
DI int map_row(int kind, int n) {
    if (kind == MAP_ROPEQ) { const int h = n / 192, r = n % 192; if (r < 128) return n; const int i = r - 128; return h * 192 + 128 + ((i < 32) ? 2 * i : 2 * (i - 32) + 1); }
    if (kind == MAP_FFNUP) { if (n < FFN_H) return (n >> 7) * 256 + (n & 127); const int c = n - FFN_H; return (c >> 7) * 256 + 128 + (c & 127); }
    return n;
}
DI void transpose_item(const float* W, int K, int N, bf16* WT, int kind, int row_off, const float* kscale, LAS float* scr, int item, int lane) {
    const int nblk = N / 32, kb = item / nblk, nb = item % nblk, k0 = 64 * kb, n0 = 32 * nb;
#pragma unroll 8
    for (int i = 0; i < 32; ++i) { const int kk = 2 * i + (lane >> 5); const float sc_ = kscale ? kscale[k0 + kk] : 1.f; scr[kk * 33 + (lane & 31)] = W[(size_t)(k0 + kk) * N + n0 + (lane & 31)] * sc_; }
    asm volatile("s_waitcnt lgkmcnt(0)" ::: "memory");
    const int c = lane & 7;
#pragma unroll
    for (int j = 0; j < 4; ++j) { const int n = (lane >> 3) + 8 * j; const LAS float* s = scr + (8 * c) * 33 + n;
        u32x4 o; o.x = pk2(s[0 * 33], s[1 * 33]); o.y = pk2(s[2 * 33], s[3 * 33]); o.z = pk2(s[4 * 33], s[5 * 33]); o.w = pk2(s[6 * 33], s[7 * 33]);
        *(u32x4*)(WT + (size_t)(row_off + map_row(kind, n0 + n)) * K + k0 + 8 * c) = o; }
    asm volatile("s_waitcnt lgkmcnt(0)" ::: "memory");
}
struct TJob { const float* W; int K, N; bf16* WT; int kind, row_off; const float* kscale; };
template <int NJ> DI void run_transposes(const Ctx& c, const TJob (&jobs)[NJ]) {
    LAS float* scr = (LAS float*)(c.lds + c.wave * 16384);
    int total = 0;
#pragma unroll
    for (int j = 0; j < NJ; ++j) total += (jobs[j].K / 64) * (jobs[j].N / 32);
    for (int it = c.gw; it < total; it += c.NGW) {
        int r = it;
#pragma unroll
        for (int j = 0; j < NJ; ++j) { const int n = (jobs[j].K / 64) * (jobs[j].N / 32);
            if (r >= 0 && r < n) transpose_item(jobs[j].W, jobs[j].K, jobs[j].N, jobs[j].WT, jobs[j].kind, jobs[j].row_off, jobs[j].kscale, scr, r, c.lane);
            r -= n; }
    }
}
DI void zero_rows(const Ctx& c, bf16* WT, int K, int row0, int nrows) {
    for (int r = c.gw; r < nrows; r += c.NGW) { u32x4* p = (u32x4*)(WT + (size_t)(row0 + r) * K);
        for (int i = c.lane; i < K / 8; i += 64) p[i] = (u32x4){0u, 0u, 0u, 0u}; }
}

DI void load_row_f32(const float* row, int lane, f32x4 (&v)[4]) {
#pragma unroll
    for (int j = 0; j < 4; ++j) v[j] = *((const f32x4*)row + lane + 64 * j);
}
DI void load_row_bf16(const bf16* row, int lane, f32x4 (&v)[4]) {
#pragma unroll
    for (int j = 0; j < 4; ++j) { const u32x2 w = *((const u32x2*)row + lane + 64 * j); v[j] = (f32x4){bflo(w.x), bfhi(w.x), bflo(w.y), bfhi(w.y)}; }
}
DI void store_row_bf16(bf16* row, int lane, const f32x4 (&v)[4]) {
#pragma unroll
    for (int j = 0; j < 4; ++j) { u32x2 w; w.x = pk2(v[j][0], v[j][1]); w.y = pk2(v[j][2], v[j][3]); *((u32x2*)row + lane + 64 * j) = w; }
}
DI float sumsq4(const f32x4 (&v)[4]) { float s = 0.f;
#pragma unroll
    for (int j = 0; j < 4; ++j) s += (v[j][0] * v[j][0] + v[j][1] * v[j][1]) + (v[j][2] * v[j][2] + v[j][3] * v[j][3]);
    return s; }
DI void pass_first(const Ctx& c, const float* x, bf16* HB, float* RSTD) {
    for (int m = c.gw; m < MROWS; m += c.NGW) {
        f32x4 v[4]; load_row_f32(x + (size_t)m * DM, c.lane, v);
        const float ss = wave_sum(sumsq4(v));
        store_row_bf16(HB + (size_t)m * DM, c.lane, v);
        if (c.lane == 0) RSTD[m] = rsqrtf(ss * (1.f / DM) + EPS);
    }
}
DI void pass_res(const Ctx& c, const bf16* a, const float* g1, bf16* HB, float* RSTD) {
    f32x4 g1v[4]; load_row_f32(g1, c.lane, g1v);
    for (int m = c.gw; m < MROWS; m += c.NGW) {
        f32x4 v[4], b[4]; load_row_bf16(a + (size_t)m * DM, c.lane, v); load_row_bf16(HB + (size_t)m * DM, c.lane, b);
        const float rstd = rsqrtf(wave_sum(sumsq4(v)) * (1.f / DM) + EPS);
#pragma unroll
        for (int j = 0; j < 4; ++j) b[j] = b[j] + v[j] * rstd * g1v[j];
        const float ss = wave_sum(sumsq4(b));
        store_row_bf16(HB + (size_t)m * DM, c.lane, b);
        if (c.lane == 0) RSTD[m] = rsqrtf(ss * (1.f / DM) + EPS);
    }
}
DI void pass_final(const Ctx& c, float* out, const float* g1, const bf16* HB) {
    f32x4 g1v[4]; load_row_f32(g1, c.lane, g1v);
    for (int m = c.gw; m < MROWS; m += c.NGW) {
        f32x4 v[4], b[4]; load_row_f32(out + (size_t)m * DM, c.lane, v); load_row_bf16(HB + (size_t)m * DM, c.lane, b);
        const float rstd = rsqrtf(wave_sum(sumsq4(v)) * (1.f / DM) + EPS);
#pragma unroll
        for (int j = 0; j < 4; ++j) { b[j] = b[j] + v[j] * rstd * g1v[j]; *((f32x4*)(out + (size_t)m * DM) + c.lane + 64 * j) = b[j]; }
    }
}

__device__ const double ROPE_INV[32] = {
    1.0, 0.7498942093324559, 0.5623413251903491, 0.4216965034285822, 0.31622776601683794, 0.23713737056616552, 0.1778279410038923, 0.1333521432163324,
    0.1, 0.07498942093324558, 0.05623413251903491, 0.042169650342858224, 0.03162277660168379, 0.023713737056616554, 0.01778279410038923, 0.01333521432163324,
    0.01, 0.007498942093324558, 0.005623413251903491, 0.004216965034285823, 0.0031622776601683794, 0.0023713737056616554, 0.0017782794100389228, 0.001333521432163324,
    0.001, 0.0007498942093324559, 0.0005623413251903491, 0.00042169650342858224, 0.00031622776601683794, 0.00023713737056616554, 0.00017782794100389227, 0.0001333521432163324};
DI void fill_rope(const Ctx& c, float* rope) {
    for (int i = c.bx * NTHREADS + c.tid; i < SEQ * 32; i += c.G * NTHREADS) {
        const int pos = i >> 5, k = i & 31;
        const double t = (double)pos * ROPE_INV[k] * 0.15915494309189535;
        const float fr = (float)(t - (double)(long long)t);
        rope[2 * i] = __builtin_amdgcn_cosf(fr); rope[2 * i + 1] = __builtin_amdgcn_sinf(fr);
    }
}
DI void pass_mla_mid(const Ctx& c, const bf16* DQKV, const float* gq, const float* gkv, const float* rope, bf16* CQ, bf16* CKV, bf16* KF) {
    float gqv[6], gkvv[4];
#pragma unroll
    for (int i = 0; i < 6; ++i) gqv[i] = gq[c.lane + 64 * i];
#pragma unroll
    for (int i = 0; i < 4; ++i) gkvv[i] = gkv[c.lane + 64 * i];
    for (int m = c.gw; m < MROWS; m += c.NGW) {
        const bf16* row = DQKV + (size_t)m * 768;
        float xq[6], xk[4]; float sq = 0.f, sk = 0.f;
#pragma unroll
        for (int i = 0; i < 6; ++i) { xq[i] = bf2f(row[c.lane + 64 * i]); sq += xq[i] * xq[i]; }
#pragma unroll
        for (int i = 0; i < 4; ++i) { xk[i] = bf2f(row[384 + c.lane + 64 * i]); sk += xk[i] * xk[i]; }
        const float rq = rsqrtf(wave_sum(sq) * (1.f / 384.f) + EPS), rk = rsqrtf(wave_sum(sk) * (1.f / 256.f) + EPS);
#pragma unroll
        for (int i = 0; i < 6; ++i) CQ[(size_t)m * 384 + c.lane + 64 * i] = f2bf(xq[i] * rq * gqv[i]);
#pragma unroll
        for (int i = 0; i < 4; ++i) CKV[(size_t)m * 256 + c.lane + 64 * i] = f2bf(xk[i] * rk * gkvv[i]);
        const int i = c.lane & 31; const float x1 = bf2f(row[640 + i]), x2 = bf2f(row[672 + i]);
        const float* rp = rope + ((size_t)(m & (SEQ - 1)) * 32 + i) * 2; const float cs = rp[0], sn = rp[1];
        const float ov = (c.lane < 32) ? (x1 * cs - x2 * sn) : (x1 * sn + x2 * cs);
        const bf16 ob = f2bf(ov); const int idx = 2 * i + (c.lane >> 5);
#pragma unroll
        for (int h = 0; h < 8; ++h) KF[(size_t)m * 1536 + h * 192 + 128 + idx] = ob;
    }
}
constexpr int CW_KMAX = 8192, CW_QCTR = 8448;
DI void pass_kmax(const Ctx& c, const bf16* Kd, unsigned* ctl) {
    LAS float* red = (LAS float*)c.lds;
    for (int rb = c.bx; rb < MROWS / 128; rb += c.G) {
        float mx = 0.f;
        for (int i = 0; i < 16; ++i) {
            const bf16* row = Kd + (size_t)(rb * 128 + c.wave * 16 + i) * 1024 + 16 * c.lane;
            const u32x4 a = *(const u32x4*)row, b = *(const u32x4*)(row + 8);
            float s = 0.f;
#pragma unroll
            for (int q = 0; q < 4; ++q) s += bflo(a[q]) * bflo(a[q]) + bfhi(a[q]) * bfhi(a[q]) + bflo(b[q]) * bflo(b[q]) + bfhi(b[q]) * bfhi(b[q]);
            s += __shfl_xor(s, 1); s += __shfl_xor(s, 2);
            mx = fmaxf(mx, s);
        }
        __syncthreads();
        if ((c.lane & 3) == 0) red[c.wave * 16 + (c.lane >> 2)] = mx;
        __syncthreads();
        if (c.tid < 16) { float m = 0.f;
#pragma unroll
            for (int w = 0; w < NWAVES; ++w) m = fmaxf(m, red[w * 16 + c.tid]);
            atomicMax(ctl + CW_KMAX + ((rb * 128) / SEQ) * 16 + c.tid, __float_as_uint(sqrtf(m))); }
    }
}
template <int DQK, bool ALIBI, bool ROPE, int ldq, int qhs, int ldk, int khs, int ldv, int vhs, int vdiv, int ldo, int ohs, int nheads>
DI void attention_phase(const Ctx& c, const bf16* Q, const bf16* K, const bf16* V, bf16* O, const float* rope, unsigned* ctl) {
    constexpr int NU = BATCH * nheads * 32;
    if (!ALIBI) {
        for (int u = c.bx; u < NU; u += c.G) {
            const int xcd = u & 7, slot = (u >> 3) & 31, rnd = u >> 8, bh = xcd + 8 * rnd, qb = slot;
            const int b = bh / nheads, h = bh % nheads;
            const size_t row0 = (size_t)b * SEQ;
            att::attn_unit<DQK, ALIBI, ROPE, ldq, ldk, ldv, ldo>(Q + (row0 + qb * 256) * ldq + h * qhs, K + row0 * ldk + h * khs, V + row0 * ldv + (h / vdiv) * vhs,
                                       O + (row0 + qb * 256) * ldo + h * ohs, SEQ, 0.f, qb * 256, rope, (char*)c.lds, c.tid, 0.f);
        }
    } else {
        volatile LAS unsigned* qw = (volatile LAS unsigned*)(c.lds + LDSCTL_OFF);
        for (;;) {
            if (c.tid == 0) qw[0] = __hip_atomic_fetch_add(ctl + CW_QCTR, 1u, __ATOMIC_RELAXED, __HIP_MEMORY_SCOPE_AGENT);
            __syncthreads();
            const int u = (int)qw[0];
            __syncthreads();
            if (u >= NU) break;
            const int hh = 7 - (u >> 8), r = u & 255, b = r >> 6, sub = (r >> 5) & 1, qb = r & 31, h = 2 * hh + sub;
            const size_t row0 = (size_t)b * SEQ;
            const float slope2 = exp2f(-(float)(hh + 1)) * LOG2E;
            const float kmax = __uint_as_float(__hip_atomic_load(ctl + CW_KMAX + b * 16 + h, __ATOMIC_RELAXED, __HIP_MEMORY_SCOPE_AGENT));
            att::attn_unit<DQK, ALIBI, ROPE, ldq, ldk, ldv, ldo>(Q + (row0 + qb * 256) * ldq + h * qhs, K + row0 * ldk + h * khs, V + row0 * ldv + (h / vdiv) * vhs,
                                       O + (row0 + qb * 256) * ldo + h * ohs, SEQ, slope2, qb * 256, rope, (char*)c.lds, c.tid, kmax);
        }
    }
}

DI void pass_diff_combine(const Ctx& c, const bf16* OS, const float* lamp, const float* subg, bf16* OC) {
    const float lam_init = 0.8f - 0.6f * expf(-0.3f * 1.0f);
    const float sa = wave_sum(lamp[c.lane] * lamp[64 + c.lane]), sb = wave_sum(lamp[128 + c.lane] * lamp[192 + c.lane]);
    const float lam = expf(sa) - expf(sb) + lam_init;
    const int h = c.lane >> 3, e0 = (c.lane & 7) * 16;
    float gv[16];
#pragma unroll
    for (int i = 0; i < 16; ++i) gv[i] = subg[e0 + i] * (1.f - lam_init);
    for (int m = c.gw; m < MROWS; m += c.NGW) {
        const bf16* r1 = OS + (size_t)m * 2048 + (2 * h) * 128 + e0; const bf16* r2 = r1 + 128;
        const u32x4 a0 = *(const u32x4*)r1, a1 = *(const u32x4*)(r1 + 8), b0 = *(const u32x4*)r2, b1 = *(const u32x4*)(r2 + 8);
        float o[16]; float ss = 0.f;
#pragma unroll
        for (int i = 0; i < 4; ++i) { o[2 * i] = bflo(a0[i]) - lam * bflo(b0[i]); o[2 * i + 1] = bfhi(a0[i]) - lam * bfhi(b0[i]);
            o[8 + 2 * i] = bflo(a1[i]) - lam * bflo(b1[i]); o[8 + 2 * i + 1] = bfhi(a1[i]) - lam * bfhi(b1[i]); }
#pragma unroll
        for (int i = 0; i < 16; ++i) ss += o[i] * o[i];
        ss += __shfl_xor(ss, 1); ss += __shfl_xor(ss, 2); ss += __shfl_xor(ss, 4);
        const float rstd = rsqrtf(ss * (1.f / 128.f) + EPS);
        u32x4 w0, w1;
#pragma unroll
        for (int i = 0; i < 4; ++i) { w0[i] = pk2(o[2 * i] * rstd * gv[2 * i], o[2 * i + 1] * rstd * gv[2 * i + 1]); w1[i] = pk2(o[8 + 2 * i] * rstd * gv[8 + 2 * i], o[8 + 2 * i + 1] * rstd * gv[8 + 2 * i + 1]); }
        bf16* op = OC + (size_t)m * 1024 + h * 128 + e0; *(u32x4*)op = w0; *(u32x4*)(op + 8) = w1;
    }
}

DI float gelu_tanh(float x) { const float z = 0.7978845608028654f * (x + 0.044715f * x * x * x); return x * frcp(1.f + fexp(-2.f * z)); }
DI void pass_conv(const Ctx& c, bf16* U, const bf16* HALO, const float* cw, const float* cb) {
    const int NSTRIP = MROWS / 16;
    for (int s = c.gw; s < NSTRIP; s += c.NGW) {
        const int t0 = s * 16; const bool first = (t0 & (SEQ - 1)) == 0, lastst = ((t0 + 16) & (SEQ - 1)) == 0;
#pragma unroll 1
        for (int it = 0; it < 11; ++it) {
            const int cc = c.lane + 64 * it, ch = 4 * cc, gcol = (ch >> 7) * 256 + (ch & 127);
            u32x2 ug[18], uv[18];
            { const bf16* hp = HALO + ((size_t)(first ? s : s - 1) * 2 + 1) * FFN_U + gcol; ug[0] = *(const u32x2*)hp; uv[0] = *(const u32x2*)(hp + 128); }
#pragma unroll
            for (int r = 0; r < 16; ++r) { const bf16* up = U + (size_t)(t0 + r) * FFN_U + gcol; ug[r + 1] = *(const u32x2*)up; uv[r + 1] = *(const u32x2*)(up + 128); }
            { const bf16* hp = HALO + ((size_t)(lastst ? s : s + 1) * 2) * FFN_U + gcol; ug[17] = *(const u32x2*)hp; uv[17] = *(const u32x2*)(hp + 128); }
            if (first) { ug[0] = (u32x2){0u, 0u}; uv[0] = ug[0]; }
            if (lastst) { ug[17] = (u32x2){0u, 0u}; uv[17] = ug[17]; }
            const f32x4 wg0 = *(const f32x4*)(cw + ch), wg1 = *(const f32x4*)(cw + FFN_U + ch), wg2 = *(const f32x4*)(cw + 2 * FFN_U + ch), bg = *(const f32x4*)(cb + ch);
            const f32x4 wv0 = *(const f32x4*)(cw + FFN_H + ch), wv1 = *(const f32x4*)(cw + FFN_U + FFN_H + ch), wv2 = *(const f32x4*)(cw + 2 * FFN_U + FFN_H + ch), bv = *(const f32x4*)(cb + FFN_H + ch);
#pragma unroll
            for (int r = 0; r < 16; ++r) {
                const u32x2 pg = ug[r], cg = ug[r + 1], ng = ug[r + 2], pv = uv[r], cv = uv[r + 1], nv = uv[r + 2];
                f32x4 g_, v_;
                g_[0] = bg[0] + wg0[0] * bflo(pg.x) + wg1[0] * bflo(cg.x) + wg2[0] * bflo(ng.x); g_[1] = bg[1] + wg0[1] * bfhi(pg.x) + wg1[1] * bfhi(cg.x) + wg2[1] * bfhi(ng.x);
                g_[2] = bg[2] + wg0[2] * bflo(pg.y) + wg1[2] * bflo(cg.y) + wg2[2] * bflo(ng.y); g_[3] = bg[3] + wg0[3] * bfhi(pg.y) + wg1[3] * bfhi(cg.y) + wg2[3] * bfhi(ng.y);
                v_[0] = bv[0] + wv0[0] * bflo(pv.x) + wv1[0] * bflo(cv.x) + wv2[0] * bflo(nv.x); v_[1] = bv[1] + wv0[1] * bfhi(pv.x) + wv1[1] * bfhi(cv.x) + wv2[1] * bfhi(nv.x);
                v_[2] = bv[2] + wv0[2] * bflo(pv.y) + wv1[2] * bflo(cv.y) + wv2[2] * bflo(nv.y); v_[3] = bv[3] + wv0[3] * bfhi(pv.y) + wv1[3] * bfhi(cv.y) + wv2[3] * bfhi(nv.y);
                u32x2 o; o.x = pk2(gelu_tanh(g_[0]) * v_[0], gelu_tanh(g_[1]) * v_[1]); o.y = pk2(gelu_tanh(g_[2]) * v_[2], gelu_tanh(g_[3]) * v_[3]);
                *(u32x2*)(U + (size_t)(t0 + r) * FFN_U + gcol) = o;
            }
        }
    }
}

constexpr int ML_CH = 128, ML_NC = SEQ / ML_CH, ML_H = 8, ML_DK = 64, ML_DV = 128, ML_EX = 160;
constexpr int ML_LDK = 72, ML_LDT = 96, ML_LDV = 160, ML_LDP = 136;
struct MlLds { LAS bf16* kA; LAS bf16* kB; LAS bf16* vx; LAS bf16* P; LAS bf16* Cs; LAS float* sc; };
DI void ml_gates(const Ctx& c, const float* gates, int row0, int h, LAS float* sc) {
    if (c.tid < 128) { const float* g = gates + (size_t)(row0 + c.tid) * 32 + h;
        sc[c.tid] = g[0]; sc[128 + c.tid] = log_sigmoid_(g[8]); sc[256 + c.tid] = g[16]; sc[384 + c.tid] = log_sigmoid_(g[24]); }
    __syncthreads();
    if (c.tid == 0) { float a = 0.f;
#pragma unroll 4
        for (int t = 0; t < 128; ++t) { a += sc[128 + t]; sc[512 + t] = a; } }
    if (c.tid == 64) { float a = 0.f;
#pragma unroll 4
        for (int t = 127; t >= 0; --t) { a += sc[384 + t]; sc[640 + t] = a; } }
    __syncthreads();
}
DI void ml_load_v(const Ctx& c, const bf16* v, int row0, int h, LAS bf16* vx) {
#pragma unroll
    for (int i = 0; i < 4; ++i) { const int ch = c.tid + 512 * i, r = ch >> 4, cc = (ch & 15) * 8;
        *(LAS u32x4*)(vx + r * ML_LDV + cc) = *(const u32x4*)(v + (size_t)(row0 + r) * 1024 + h * 128 + cc); }
    if (c.tid < 128) { LAS bf16* p = vx + c.tid * ML_LDV + 128;
        *(LAS u32x4*)p = (u32x4){0x00003f80u, 0u, 0u, 0u}; *(LAS u32x4*)(p + 8) = (u32x4){0u, 0u, 0u, 0u}; *(LAS u32x4*)(p + 16) = (u32x4){0u, 0u, 0u, 0u}; *(LAS u32x4*)(p + 24) = (u32x4){0u, 0u, 0u, 0u}; }
}
DI void ml_phase1(const Ctx& c, const bf16* k, const bf16* v, const float* gates, bf16* ST, float* DEC) {
    LAS bf16* kA = (LAS bf16*)c.lds; LAS bf16* kB = kA + 128 * ML_LDT; LAS bf16* vx = kB + 128 * ML_LDT; LAS float* sc = (LAS float*)(vx + 128 * ML_LDV);
    const int NU = BATCH * ML_H * ML_NC;
    for (int u = c.bx; u < NU; u += c.G) {
        const int ck = u % ML_NC, h = (u / ML_NC) % ML_H, b = u / (ML_NC * ML_H); const int row0 = b * SEQ + ck * ML_CH;
        ml_gates(c, gates, row0, h, sc);
        const float bl = sc[512 + 127], B0 = sc[640];
#pragma unroll
        for (int i = 0; i < 2; ++i) { const int ch = c.tid + 512 * i, r = ch >> 3, cc = (ch & 7) * 8;
            const u32x4 w = *(const u32x4*)(k + (size_t)(row0 + r) * 512 + h * 64 + cc);
            const float wF = fexp(bl - sc[512 + r] + sc[r]), wB = fexp(B0 - sc[640 + r] + sc[256 + r]);
            u32x4 a, bb;
#pragma unroll
            for (int q = 0; q < 4; ++q) { a[q] = pk2(bflo(w[q]) * wF, bfhi(w[q]) * wF); bb[q] = pk2(bflo(w[q]) * wB, bfhi(w[q]) * wB); }
            *(LAS u32x4*)(kA + r * ML_LDT + cc) = a; *(LAS u32x4*)(kB + r * ML_LDT + cc) = bb; }
        ml_load_v(c, v, row0, h, vx);
        __syncthreads();
#pragma unroll 1
        for (int id = c.wave; id < 20; id += 8) {
            const int dir = id / 10, rem = id % 10, db = rem / 5, eb = rem % 5;
            const LAS bf16* kw = dir ? kB : kA;
            f32x16 acc = {};
#pragma unroll 2
            for (int ks = 0; ks < 8; ++ks) acc = MFMA32(frag_tr(kw, ML_LDT, 16 * ks, 32 * db, c.lane), frag_tr(vx, ML_LDV, 16 * ks, 32 * eb, c.lane), acc);
            bf16* dst = ST + ((size_t)((b * ML_H + h) * 2 + dir) * ML_NC + ck) * (ML_DK * ML_EX);
            const int n = c.lane & 31, hi = c.lane >> 5;
#pragma unroll
            for (int r = 0; r < 16; ++r) dst[(32 * db + crow(r, hi)) * ML_EX + 32 * eb + n] = f2bf(acc[r]);
        }
        if (c.tid == 0) { float* d = DEC + (size_t)((b * ML_H + h) * 2) * ML_NC + ck; d[0] = fexp(bl); d[ML_NC] = fexp(B0); }
        __syncthreads();
    }
}
DI void ml_phase2(const Ctx& c, bf16* ST, const float* DEC) {
    constexpr int NG = ML_DK * ML_EX / 8;
    const int NTASK = BATCH * ML_H * 2 * NG;
    for (int t = c.bx * NTHREADS + c.tid; t < NTASK; t += c.G * NTHREADS) {
        const int g = t % NG, chain = t / NG, dir = chain & 1;
        bf16* base = ST + (size_t)chain * ML_NC * (ML_DK * ML_EX) + g * 8; const float* dec = DEC + (size_t)chain * ML_NC;
        float carry[8];
#pragma unroll
        for (int i = 0; i < 8; ++i) carry[i] = 0.f;
        for (int s = 0; s < ML_NC; ++s) {
            const int ck = dir ? (ML_NC - 1 - s) : s;
            u32x4* p = (u32x4*)(base + (size_t)ck * (ML_DK * ML_EX)); const u32x4 a = *p; const float d = dec[ck];
            u32x4 o;
#pragma unroll
            for (int q = 0; q < 4; ++q) { o[q] = pk2(carry[2 * q], carry[2 * q + 1]); carry[2 * q] = d * carry[2 * q] + bflo(a[q]); carry[2 * q + 1] = d * carry[2 * q + 1] + bfhi(a[q]); }
            *p = o;
        }
    }
}
DI void ml_phase3(const Ctx& c, const bf16* q, const bf16* k, const bf16* v, const bf16* og, const float* gates, const bf16* ST, const float* ng, bf16* Z) {
    LAS bf16* kl = (LAS bf16*)c.lds; LAS bf16* vx = kl + 128 * ML_LDK; LAS bf16* P = vx + 128 * ML_LDV; LAS bf16* Cs = P + 128 * ML_LDP; LAS float* sc = (LAS float*)(Cs + 64 * ML_LDV);
    LAS bf16* hb = P;
    const int NU = BATCH * ML_H * ML_NC;
    const int n = c.lane & 31, hi = c.lane >> 5, tb = c.wave & 3, wg2 = c.wave >> 2;
    for (int u = c.bx; u < NU; u += c.G) {
        const int ck = u % ML_NC, h = (u / ML_NC) % ML_H, b = u / (ML_NC * ML_H); const int row0 = b * SEQ + ck * ML_CH;
        ml_gates(c, gates, row0, h, sc);
#pragma unroll
        for (int i = 0; i < 2; ++i) { const int ch = c.tid + 512 * i, r = ch >> 3, cc = (ch & 7) * 8;
            *(LAS u32x4*)(kl + r * ML_LDK + cc) = *(const u32x4*)(k + (size_t)(row0 + r) * 512 + h * 64 + cc); }
        ml_load_v(c, v, row0, h, vx);
        const bf16* qg = q + (size_t)row0 * 512 + h * 64;
        bf16x8 qf[4];
#pragma unroll
        for (int kd = 0; kd < 4; ++kd) qf[kd] = gfrag_row(qg, 512, 32 * tb, 16 * kd, c.lane);
        f32x16 hs[2] = {};
#pragma unroll 1
        for (int dir = 0; dir < 2; ++dir) {
            const bf16* st = ST + ((size_t)((b * ML_H + h) * 2 + dir) * ML_NC + ck) * (ML_DK * ML_EX);
            for (int ch = c.tid; ch < 64 * 20; ch += NTHREADS) { const int r = ch / 20, cc = (ch % 20) * 8; *(LAS u32x4*)(Cs + r * ML_LDV + cc) = *(const u32x4*)(st + r * ML_EX + cc); }
            __syncthreads();
            const int ioff = dir ? 256 : 0, boff = dir ? 640 : 512;
            const float bt = sc[boff + 32 * tb + n];
#pragma unroll 1
            for (int sb2 = 0; sb2 < 2; ++sb2) {
                const int sb = 2 * wg2 + sb2;
                f32x16 a = {};
#pragma unroll
                for (int kd = 0; kd < 4; ++kd) a = MFMA32(frag_row(kl, ML_LDK, 32 * sb, 16 * kd, c.lane), qf[kd], a);
                const int t = 32 * tb + n;
#pragma unroll
                for (int g4 = 0; g4 < 4; ++g4) {
                    const int s0 = 32 * sb + 8 * g4 + 4 * hi;
                    float w[4];
#pragma unroll
                    for (int j = 0; j < 4; ++j) { const int s = s0 + j; const bool keep = dir ? (s >= t) : (s <= t);
                        const float e = fexp(fminf(bt - sc[boff + s], 0.f) + sc[ioff + s]); w[j] = keep ? a[4 * g4 + j] * e : 0.f; }
                    u32x2 o; o.x = pk2(w[0], w[1]); o.y = pk2(w[2], w[3]);
                    *(LAS u32x2*)(P + t * ML_LDP + s0) = o;
                }
            }
            __syncthreads();
            f32x16 acc[3] = {}, aci[3] = {};
#pragma unroll 2
            for (int ks = 0; ks < 8; ++ks) { const bf16x8 A = frag_row(P, ML_LDP, 32 * tb, 16 * ks, c.lane);
#pragma unroll
                for (int e = 0; e < 3; ++e) { const int et = (e == 2) ? 4 : 2 * wg2 + e; acc[e] = MFMA32(A, frag_tr(vx, ML_LDV, 16 * ks, 32 * et, c.lane), acc[e]); } }
#pragma unroll
            for (int kd = 0; kd < 4; ++kd) {
#pragma unroll
                for (int e = 0; e < 3; ++e) { const int et = (e == 2) ? 4 : 2 * wg2 + e; aci[e] = MFMA32(qf[kd], frag_tr(Cs, ML_LDV, 16 * kd, 32 * et, c.lane), aci[e]); } }
#pragma unroll
            for (int r = 0; r < 16; ++r) {
                const float eb_ = fexp(sc[boff + 32 * tb + crow(r, hi)]);
                const float t2 = acc[2][r] + eb_ * aci[2][r];
                const float den = __shfl(t2, hi * 32);
                const float inv = frcp(fmaxf(fabsf(den), 1.f));
                hs[0][r] += (acc[0][r] + eb_ * aci[0][r]) * inv; hs[1][r] += (acc[1][r] + eb_ * aci[1][r]) * inv;
            }
            __syncthreads();
        }
#pragma unroll
        for (int e = 0; e < 2; ++e)
#pragma unroll
            for (int r = 0; r < 16; ++r) hb[(32 * tb + crow(r, hi)) * ML_LDP + 32 * (2 * wg2 + e) + n] = f2bf(hs[e][r]);
        __syncthreads();
        const float g0 = ng[h * 128 + 2 * c.lane], g1 = ng[h * 128 + 2 * c.lane + 1];
        for (int rr = 0; rr < 16; ++rr) {
            const int t = 16 * c.wave + rr; const unsigned w = *(const LAS unsigned*)(hb + t * ML_LDP + 2 * c.lane);
            const float x0 = bflo(w), x1 = bfhi(w);
            const float mean = wave_sum(x0 + x1) * (1.f / 128.f); const float d0 = x0 - mean, d1 = x1 - mean;
            const float rstd = rsqrtf(wave_sum(d0 * d0 + d1 * d1) * (1.f / 128.f) + EPS);
            const unsigned ow = *(const unsigned*)(og + (size_t)(row0 + t) * 1024 + h * 128 + 2 * c.lane);
            *(unsigned*)(Z + (size_t)(row0 + t) * 1024 + h * 128 + 2 * c.lane) = pk2(d0 * rstd * g0 * sigmoidf_(bflo(ow)), d1 * rstd * g1 * sigmoidf_(bfhi(ow)));
        }
        __syncthreads();
    }
}

constexpr int RT_CH = 512, RT_NC = SEQ / RT_CH, RT_H = 4, RT_DK = 256, RT_DV = 512;
constexpr int RT_LDK = 264, RT_LDB = 544, RT_LDA = 72, RT_LD2 = 288;
DI void rt_phase2(const Ctx& c, const bf16* k, const bf16* v, const float* dlogit, bf16* RS) {
    LAS bf16* kw = (LAS bf16*)c.lds; LAS bf16* vh = kw + 64 * RT_LD2;
    const int NU = BATCH * RT_H * 2 * RT_NC;
    const int n = c.lane & 31, hi = c.lane >> 5;
    for (int u = c.bx; u < NU; u += c.G) {
        const int ck = u % RT_NC, dir = (u / RT_NC) & 1, h = (u / (2 * RT_NC)) % RT_H, b = u / (2 * RT_NC * RT_H);
        const int row0 = b * SEQ + ck * RT_CH;
        const float lg2 = log_sigmoid_(dlogit[dir * 4 + h]) * LOG2E;
        bf16* dst = RS + ((size_t)((b * RT_H + h) * 2 + dir) * RT_NC + ck) * (RT_DK * RT_DV);
        for (int half = 0; half < 2; ++half) {
            f32x16 acc[8] = {};
            u32x4 pk_[4], pv_[4];
#define R2_PREFETCH(sb_) do { int ot = c.tid; asm volatile("" : "+v"(ot)); \
            _Pragma("unroll") for (int i = 0; i < 4; ++i) { const int ch = ot + 512 * i, r = ch >> 5, cc = (ch & 31) * 8; const int s = 64 * (sb_) + r; \
                pk_[i] = *(const u32x4*)(k + (size_t)(row0 + s) * 1024 + h * 256 + cc); pv_[i] = *(const u32x4*)(v + (size_t)(row0 + s) * 2048 + h * 512 + half * 256 + cc); } } while (0)
            R2_PREFETCH(0);
#pragma unroll 1
            for (int sb = 0; sb < RT_CH / 64; ++sb) {
                __syncthreads();
                { int ot = c.tid; asm volatile("" : "+v"(ot));
#pragma unroll
                  for (int i = 0; i < 4; ++i) { const int ch = ot + 512 * i, r = ch >> 5, cc = (ch & 31) * 8; const int s = 64 * sb + r;
                    const float w = fexp2(lg2 * (float)(dir ? s : (RT_CH - 1 - s)));
                    u32x4 o;
#pragma unroll
                    for (int q = 0; q < 4; ++q) o[q] = pk2(bflo(pk_[i][q]) * w, bfhi(pk_[i][q]) * w);
                    *(LAS u32x4*)(kw + r * RT_LD2 + cc) = o;
                    *(LAS u32x4*)(vh + r * RT_LD2 + cc) = pv_[i]; } }
                if (sb + 1 < RT_CH / 64) R2_PREFETCH(sb + 1);
                __syncthreads();
#pragma unroll 1
                for (int ks = 0; ks < 4; ++ks) { const bf16x8 A = frag_tr(kw, RT_LD2, 16 * ks, 32 * c.wave, c.lane);
#pragma unroll
                    for (int et = 0; et < 8; ++et) { acc[et] = MFMA32(A, frag_tr(vh, RT_LD2, 16 * ks, 32 * et, c.lane), acc[et]); if (et == 3) __builtin_amdgcn_sched_barrier(0); } }
            }
#undef R2_PREFETCH
#pragma unroll
            for (int et = 0; et < 8; ++et)
#pragma unroll
                for (int r = 0; r < 16; ++r) dst[(size_t)(32 * c.wave + crow(r, hi)) * RT_DV + half * 256 + 32 * et + n] = f2bf(acc[et][r]);
        }
        __syncthreads();
    }
}
DI void rt_phase3(const Ctx& c, bf16* RS, const float* dlogit) {
    constexpr int NG = RT_DK * RT_DV / 8;
    const int NTASK = BATCH * RT_H * 2 * NG;
    for (int t = c.bx * NTHREADS + c.tid; t < NTASK; t += c.G * NTHREADS) {
        const int g = t % NG, chain = t / NG, dir = chain & 1, h = (chain >> 1) % RT_H;
        const float gch = fexp2(log_sigmoid_(dlogit[dir * 4 + h]) * LOG2E * (float)RT_CH);
        bf16* base = RS + (size_t)chain * RT_NC * (RT_DK * RT_DV) + (size_t)g * 8;
        float carry[8];
#pragma unroll
        for (int i = 0; i < 8; ++i) carry[i] = 0.f;
#pragma unroll
        for (int s = 0; s < RT_NC; ++s) {
            const int ck = dir ? (RT_NC - 1 - s) : s;
            u32x4* p = (u32x4*)(base + (size_t)ck * (RT_DK * RT_DV)); const u32x4 a = *p;
            u32x4 o;
#pragma unroll
            for (int q = 0; q < 4; ++q) { o[q] = pk2(carry[2 * q], carry[2 * q + 1]); carry[2 * q] = gch * carry[2 * q] + bflo(a[q]); carry[2 * q + 1] = gch * carry[2 * q + 1] + bfhi(a[q]); }
            *p = o;
        }
    }
}
DI void rt_phase4(const Ctx& c, const bf16* q, const bf16* k, const bf16* v, bf16* gz, const bf16* RS, const float* dlogit, const float* ng, const bool wr = true) {
    LAS bf16* kt = (LAS bf16*)c.lds; LAS bf16* Bt = kt + 64 * RT_LDK; LAS bf16* At = Bt + 64 * RT_LDB; LAS float* red = (LAS float*)(At + 128 * RT_LDA);
    constexpr int NI = RT_CH / 64, NQ = RT_CH / 128, NS = NI + 8;
    const int NU = BATCH * RT_H * RT_NC * NQ;
    const int n = c.lane & 31, hi = c.lane >> 5, tb = c.wave & 3, eh = c.wave >> 2;
    for (int u = c.bx; u < NU; u += c.G) {
        const int tq = u % NQ, ck = (u / NQ) % RT_NC, h = (u / (NQ * RT_NC)) % RT_H, b = u / (NQ * RT_NC * RT_H);
        const int rowc = b * SEQ + ck * RT_CH, rowq = rowc + tq * 128;
        const float lf2 = log_sigmoid_(dlogit[h]) * LOG2E, lb2 = log_sigmoid_(dlogit[4 + h]) * LOG2E;
        const bf16* qg = q + (size_t)rowq * 1024 + h * 256;
        f32x16 acc[8] = {};
        u32x4 sb_[8], sk_[4];
#define RT_PREFETCH(st) do { int ot = c.tid; asm volatile("" : "+v"(ot)); \
        if ((st) < NI) { const int s0_ = 64 * (st); \
            _Pragma("unroll") for (int i = 0; i < 4; ++i) { const int ch = ot + 512 * i, r = ch >> 5, cc = (ch & 31) * 8; sk_[i] = *(const u32x4*)(k + (size_t)(rowc + s0_ + r) * 1024 + h * 256 + cc); } \
            _Pragma("unroll") for (int i = 0; i < 8; ++i) { const int ch = ot + 512 * i, r = ch >> 6, cc = (ch & 63) * 8; sb_[i] = *(const u32x4*)(v + (size_t)(rowc + s0_ + r) * 2048 + h * 512 + cc); } \
        } else { const int dir_ = ((st) - NI) >> 2, d0_ = 64 * (((st) - NI) & 3); \
            const bf16* rs_ = RS + ((size_t)((b * RT_H + h) * 2 + dir_) * RT_NC + ck) * (RT_DK * RT_DV) + (size_t)d0_ * RT_DV; \
            _Pragma("unroll") for (int i = 0; i < 8; ++i) { const int ch = ot + 512 * i, r = ch >> 6, cc = (ch & 63) * 8; sb_[i] = *(const u32x4*)(rs_ + (size_t)r * RT_DV + cc); } \
            _Pragma("unroll") for (int i = 0; i < 2; ++i) { const int ch = ot + 512 * i, r = ch >> 3, cc = (ch & 7) * 8; sk_[i] = *(const u32x4*)(qg + (size_t)r * 1024 + d0_ + cc); } } } while (0)
        RT_PREFETCH(0);
#pragma unroll 1
        for (int step = 0; step < NS; ++step) {
            __syncthreads();
            { int ot = c.tid; asm volatile("" : "+v"(ot));
#pragma unroll
              for (int i = 0; i < 8; ++i) { const int ch = ot + 512 * i, r = ch >> 6, cc = (ch & 63) * 8; *(LAS u32x4*)(Bt + r * RT_LDB + cc) = sb_[i]; }
              if (step < NI) {
#pragma unroll
                  for (int i = 0; i < 4; ++i) { const int ch = ot + 512 * i, r = ch >> 5, cc = (ch & 31) * 8; *(LAS u32x4*)(kt + r * RT_LDK + cc) = sk_[i]; }
              } else {
                  const int dir = (step - NI) >> 2;
#pragma unroll
                  for (int i = 0; i < 2; ++i) { const int ch = ot + 512 * i, r = ch >> 3, cc = (ch & 7) * 8; const int tpos = 128 * tq + r;
                      const float xi = dir ? fexp2(lb2 * (float)(RT_CH - tpos)) : fexp2(lf2 * (float)(tpos + 1));
                      u32x4 o;
#pragma unroll
                      for (int q4 = 0; q4 < 4; ++q4) o[q4] = pk2(bflo(sk_[i][q4]) * xi, bfhi(sk_[i][q4]) * xi);
                      *(LAS u32x4*)(At + r * RT_LDA + cc) = o; }
              } }
            if (step >= NI && step + 1 < NS) RT_PREFETCH(step + 1);
            __syncthreads();
            if (step < NI) {
                const int s0 = 64 * step;
                f32x16 a = {};
#pragma unroll 4
                for (int kd = 0; kd < 16; ++kd) a = MFMA32(frag_row(kt, RT_LDK, 32 * eh, 16 * kd, c.lane), gfrag_row(qg, 1024, 32 * tb, 16 * kd, c.lane), a);
                const int tl = 32 * tb + n, tpos = 128 * tq + tl;
#pragma unroll
                for (int g4 = 0; g4 < 4; ++g4) {
                    const int sl = 32 * eh + 8 * g4 + 4 * hi;
                    float w[4];
#pragma unroll
                    for (int j = 0; j < 4; ++j) { const float rel = (float)(tpos - (s0 + sl + j));
                        const float mk = (rel >= 0.f ? fexp2(rel * lf2) : 0.f) + (rel <= 0.f ? fexp2(-rel * lb2) : 0.f); w[j] = a[4 * g4 + j] * mk; }
                    u32x2 o; o.x = pk2(w[0], w[1]); o.y = pk2(w[2], w[3]);
                    *(LAS u32x2*)(At + tl * RT_LDA + sl) = o;
                }
                RT_PREFETCH(step + 1);
                __syncthreads();
            }
#pragma unroll 1
            for (int ks = 0; ks < 4; ++ks) { const bf16x8 A = frag_row(At, RT_LDA, 32 * tb, 16 * ks, c.lane);
#pragma unroll
                for (int et = 0; et < 8; ++et) { acc[et] = MFMA32(A, frag_tr(Bt, RT_LDB, 16 * ks, 32 * (8 * eh + et), c.lane), acc[et]); if (et == 3) __builtin_amdgcn_sched_barrier(0); } }
        }
#undef RT_PREFETCH
#pragma unroll
        for (int r = 0; r < 16; ++r) {
            float s1 = 0.f, s2 = 0.f;
#pragma unroll
            for (int et = 0; et < 8; ++et) { s1 += acc[et][r]; s2 += acc[et][r] * acc[et][r]; }
#pragma unroll
            for (int o = 1; o < 32; o <<= 1) { s1 += __shfl_xor(s1, o); s2 += __shfl_xor(s2, o); }
            if (n == 0) { red[((32 * tb + crow(r, hi)) * 2 + eh) * 2] = s1; red[((32 * tb + crow(r, hi)) * 2 + eh) * 2 + 1] = s2; }
        }
        __syncthreads();
#pragma unroll
        for (int r = 0; r < 16; ++r) {
            const int tl = 32 * tb + crow(r, hi);
            const float s1 = red[(tl * 2) * 2] + red[(tl * 2 + 1) * 2], s2 = red[(tl * 2) * 2 + 1] + red[(tl * 2 + 1) * 2 + 1];
            const float mean = s1 * (1.f / 512.f), var = fmaxf(s2 * (1.f / 512.f) - mean * mean, 0.f), rstd = rsqrtf(var + EPS);
            bf16* gp = gz + (size_t)(rowq + tl) * 2048 + h * 512 + 256 * eh + n;
#pragma unroll
            for (int et = 0; et < 8; ++et) { const float gt = bf2f(gp[32 * et]); const float y = (acc[et][r] - mean) * rstd * ng[h * 512 + 256 * eh + 32 * et + n];
                if (wr) gp[32 * et] = f2bf(y * gt * sigmoidf_(gt)); }
        }
        __syncthreads();
    }
}

struct Args { const float* in[25]; float* out; unsigned char* ws; int ph_lo, ph_hi; };
constexpr int NPHASES = 64;
#define PHASE(...) do { if (ph >= lo && ph < hi) { { Ctx c = c0; c.lane = (int)__builtin_amdgcn_mbcnt_hi(~0u, __builtin_amdgcn_mbcnt_lo(~0u, 0u)); c.tid = c0.wave * 64 + c.lane; asm volatile("" : "+v"(c.tid)); \
    c.lane = c.tid & 63; c.wave = __builtin_amdgcn_readfirstlane(c.tid >> 6); c.gw = c.bx * NWAVES + c.wave; \
    __VA_ARGS__; } if (ph + 1 < hi) xcd_barrier(bar); } ++ph; } while (0)

template <int L> DI void run_layer(const Ctx& c0, const Args& args, const XcdBarrier& bar, const int lo, const int hi, int& ph) {
    unsigned char* ws = args.ws;
    const float* x = args.in[0]; const float* norm_g = args.in[1];
    float* rope = (float*)(ws + WS_ROPE);
    float* RSTD = (float*)(ws + 3 * MiB);
    bf16* HB = (bf16*)(ws + WS_XN);
    bf16* DOUT16 = (bf16*)args.out;
    unsigned char* S = ws + WS_S;
    bf16* WTmix = (bf16*)(ws + WT_MIX); bf16* WTup = (bf16*)(ws + WT_UP); bf16* WTdown = (bf16*)(ws + WT_DOWN);
    bf16* U = (bf16*)S; bf16* HALO = (bf16*)(S + 352 * MiB);
    LAS unsigned char* ring = c0.lds;
    const float* g0 = norm_g + (size_t)(L * 4 + 0) * DM; const float* g1 = g0 + DM; const float* g2 = g0 + 2 * DM; const float* g3 = g0 + 3 * DM;
    bf16* AOUT = (bf16*)S;
#define FFN_JOBS(LL) {args.in[2] + (size_t)(LL) * DM * FFN_U, DM, FFN_U, WTup, MAP_FFNUP, 0, norm_g + (size_t)((LL) * 4 + 2) * DM}, {args.in[5] + (size_t)(LL) * FFN_H * DM, FFN_H, DM, WTdown, MAP_ID, 0, nullptr}
    if constexpr (L == 0) {
        bf16* Wd = WTmix; bf16* Wuq = (bf16*)(ws + WT_MIX + 2 * MiB); bf16* Wukv = (bf16*)(ws + WT_MIX + 4 * MiB); bf16* Wo = (bf16*)(ws + WT_MIX + 6 * MiB);
        bf16* DQKV = (bf16*)S; bf16* CQ = (bf16*)(S + 48 * MiB); bf16* CKV = (bf16*)(S + 72 * MiB); bf16* Q = (bf16*)(S + 88 * MiB); bf16* KF = (bf16*)(S + 184 * MiB);
        bf16* V = (bf16*)(S + 280 * MiB); bf16* O = (bf16*)(S + 344 * MiB);
        PHASE({
            fill_rope(c, rope);
            const TJob jobs[7] = {{args.in[6], DM, 384, Wd, MAP_ID, 0, g0}, {args.in[9], DM, 320, Wd, MAP_ID, 384, g0}, {args.in[8], 384, 1536, Wuq, MAP_ROPEQ, 0, nullptr},
                                  {args.in[11], 256, 2048, Wukv, MAP_ID, 0, nullptr}, {args.in[12], DM, DM, Wo, MAP_ID, 0, nullptr}, FFN_JOBS(0)};
            run_transposes<7>(c, jobs);
            zero_rows(c, Wd, DM, 704, 64);
            pass_first(c, x, HB, RSTD);
        });
        PHASE({ pg8::Gemm g{HB, Wd, MROWS, 768, DM, DM, 256}; pg8::StaticOrder so; so.init(MROWS, 768, c.G, c.bx);
            pg8::gemm_phase(ring, c.tid, g, so, pg8::epi_plain(DQKV, 768, 1.f, RSTD)); });
        PHASE({ pass_mla_mid(c, DQKV, args.in[7], args.in[10], rope, CQ, CKV, KF); });
        PHASE({ pg8::Gemm g{CQ, Wuq, MROWS, 1536, 384, 384, 256}; pg8::StaticOrder so; so.init(MROWS, 1536, c.G, c.bx);
              pg8::gemm_phase(ring, c.tid, g, so, pg8::epi_plain(Q, 1536, 0.07216878364870322f * LOG2E)); });
        PHASE({ pg8::Gemm g{CKV, Wukv, MROWS, 2048, 256, 256, 256}; pg8::StaticOrder so; so.init(MROWS, 2048, c.G, c.bx);
              pg8::EpiMlaKV E{KF, V}; pg8::gemm_phase(ring, c.tid, g, so, E); });
        PHASE({ attention_phase<192, false, true, 1536, 192, 1536, 192, 1024, 128, 1, 1024, 128, 8>(c, Q, KF, V, O, rope, (unsigned*)(ws + WS_CTL)); });
        PHASE({ pg8::Gemm g{O, Wo, MROWS, DM, DM, DM, 256}; pg8::StaticOrder so; so.init(MROWS, DM, c.G, c.bx);
            pg8::gemm_phase(ring, c.tid, g, so, pg8::epi_plain(AOUT, DM, 1.f)); });
    } else if constexpr (L == 1) {
        bf16* Wqkv = WTmix; bf16* Wo = (bf16*)(ws + WT_MIX + 8 * MiB);
        bf16* Qd = (bf16*)S; bf16* Kd = (bf16*)(S + 64 * MiB); bf16* Vd = (bf16*)(S + 128 * MiB); bf16* OS = (bf16*)(S + 192 * MiB); bf16* OC = (bf16*)(S + 320 * MiB);
        PHASE({ pg8::Gemm g{HB, Wqkv, MROWS, 3072, DM, DM, 256}; pg8::StaticOrder so; so.init(MROWS, 3072, c.G, c.bx);
            pg8::EpiSeg<false> E{}; E.p0 = Qd; E.ld0 = DM; E.s0 = 0.125f * LOG2E; E.e0 = 8; E.p1 = Kd; E.ld1 = DM; E.s1 = 1.f; E.e1 = 16; E.p2 = Vd; E.ld2 = DM; E.s2 = 1.f; E.e2 = 100000; E.rowscale = RSTD;
            pg8::gemm_phase(ring, c.tid, g, so, E); });
        PHASE({ pass_kmax(c, Kd, (unsigned*)(ws + WS_CTL)); });
        PHASE({ attention_phase<64, true, false, 1024, 64, 1024, 64, 1024, 128, 2, 2048, 128, 16>(c, Qd, Kd, Vd, OS, rope, (unsigned*)(ws + WS_CTL)); });
        PHASE({ pass_diff_combine(c, OS, args.in[14], args.in[15], OC); });
        PHASE({ pg8::Gemm g{OC, Wo, MROWS, DM, DM, DM, 256}; pg8::StaticOrder so; so.init(MROWS, DM, c.G, c.bx);
            pg8::gemm_phase(ring, c.tid, g, so, pg8::epi_plain(AOUT, DM, 1.f)); });
    } else if constexpr (L == 2) {
        bf16* Win = WTmix; bf16* Wout = (bf16*)(ws + WT_MIX + 8 * MiB);
        bf16* q = (bf16*)S; bf16* k = (bf16*)(S + 32 * MiB); bf16* v = (bf16*)(S + 64 * MiB); bf16* og = (bf16*)(S + 128 * MiB);
        float* gates = (float*)(S + 192 * MiB); float* DEC = (float*)(S + 196 * MiB); bf16* ST = (bf16*)(S + 200 * MiB); bf16* Z = (bf16*)(S + 288 * MiB);
        PHASE({ pg8::Gemm g{HB, Win, MROWS, 3328, DM, DM, 256}; pg8::StaticOrder so; so.init(MROWS, 3328, c.G, c.bx);
            pg8::EpiSeg<true> E{}; E.p0 = q; E.ld0 = 512; E.s0 = 1.f; E.e0 = 4; E.p1 = k; E.ld1 = 512; E.s1 = 0.125f; E.e1 = 8; E.p2 = v; E.ld2 = DM; E.s2 = 1.f; E.e2 = 16; E.p3 = og; E.ld3 = DM; E.s3 = 1.f;
            E.gates = gates; E.gbias = args.in[18]; E.gblk = 24; E.rowscale = RSTD;
            pg8::gemm_phase(ring, c.tid, g, so, E); });
        PHASE({ ml_phase1(c, k, v, gates, ST, DEC); });
        PHASE({ ml_phase2(c, ST, DEC); });
        PHASE({ ml_phase3(c, q, k, v, og, gates, ST, args.in[19], Z); });
        PHASE({ pg8::Gemm g{Z, Wout, MROWS, DM, DM, DM, 256}; pg8::StaticOrder so; so.init(MROWS, DM, c.G, c.bx);
            pg8::gemm_phase(ring, c.tid, g, so, pg8::epi_plain(AOUT, DM, 1.f)); });
    } else {
        bf16* Win = WTmix; bf16* Wo = (bf16*)(ws + WT_MIX + 12 * MiB);
        bf16* q = (bf16*)S; bf16* k = (bf16*)(S + 64 * MiB); bf16* v = (bf16*)(S + 128 * MiB); bf16* gz = (bf16*)(S + 256 * MiB); bf16* RS = DOUT16;
        PHASE({ pg8::Gemm g{HB, Win, MROWS, 6144, DM, DM, 256}; pg8::StaticOrder so; so.init(MROWS, 6144, c.G, c.bx);
            pg8::EpiSeg<false> E{}; E.p0 = q; E.ld0 = DM; E.s0 = 1.f; E.e0 = 8; E.p1 = k; E.ld1 = DM; E.s1 = 0.0625f; E.e1 = 16; E.p2 = v; E.ld2 = 2048; E.s2 = 1.f; E.e2 = 32; E.p3 = gz; E.ld3 = 2048; E.s3 = 1.f; E.rowscale = RSTD;
            pg8::gemm_phase(ring, c.tid, g, so, E); });
        PHASE({ rt_phase2(c, k, v, args.in[22], RS); });
        PHASE({ rt_phase3(c, RS, args.in[22]); });
        PHASE({ rt_phase4(c, q, k, v, gz, RS, args.in[22], args.in[23]); });
        PHASE({ pg8::Gemm g{gz, Wo, MROWS, DM, 2048, 2048, 256}; pg8::StaticOrder so; so.init(MROWS, DM, c.G, c.bx);
            pg8::gemm_phase(ring, c.tid, g, so, pg8::epi_plain(AOUT, DM, 1.f)); });
    }
    PHASE({ pass_res(c, AOUT, g1, HB, RSTD); });
    PHASE({ pg8::Gemm g{HB, WTup, MROWS, FFN_U, DM, DM, 256}; pg8::StaticOrder so; so.init(MROWS, FFN_U, c.G, c.bx);
        pg8::EpiFfnUp E{U, HALO, RSTD}; pg8::gemm_phase(ring, c.tid, g, so, E); });
    PHASE({ pass_conv(c, U, HALO, args.in[3] + (size_t)L * 3 * FFN_U, args.in[4] + (size_t)L * FFN_U); });
    if constexpr (L < 3) {
        PHASE({ pg8::Gemm g{U, WTdown, MROWS, DM, FFN_H, FFN_U, 512}; pg8::StaticOrder so; so.init(MROWS, DM, c.G, c.bx);
            pg8::gemm_phase(ring, c.tid, g, so, pg8::epi_plain(DOUT16, DM, 1.f)); });
        PHASE({
            pass_res(c, DOUT16, g3, HB, RSTD);
            const float* gn = g0 + 4 * DM;
            if constexpr (L == 0) { const TJob jobs[4] = {{args.in[13], DM, 3072, WTmix, MAP_ID, 0, gn}, {args.in[16], DM, DM, (bf16*)(ws + WT_MIX + 8 * MiB), MAP_ID, 0, nullptr}, FFN_JOBS(1)}; run_transposes<4>(c, jobs); }
            else if constexpr (L == 1) { const TJob jobs[4] = {{args.in[17], DM, 3104, WTmix, MAP_ID, 0, gn}, {args.in[20], DM, DM, (bf16*)(ws + WT_MIX + 8 * MiB), MAP_ID, 0, nullptr}, FFN_JOBS(2)}; run_transposes<4>(c, jobs);
                zero_rows(c, WTmix, DM, 3104, 224); }
            else { const TJob jobs[4] = {{args.in[21], DM, 6144, WTmix, MAP_ID, 0, gn}, {args.in[24], 2048, DM, (bf16*)(ws + WT_MIX + 12 * MiB), MAP_ID, 0, nullptr}, FFN_JOBS(3)}; run_transposes<4>(c, jobs); }
        });
    } else {
        PHASE({ pg8::Gemm g{U, WTdown, MROWS, DM, FFN_H, FFN_U, 512}; pg8::StaticOrder so; so.init(MROWS, DM, c.G, c.bx);
            pg8::EpiF32 E{args.out, DM}; pg8::gemm_phase(ring, c.tid, g, so, E); });
        PHASE({ pass_final(c, args.out, g3, HB); });
    }
#undef FFN_JOBS
}

__global__ void __launch_bounds__(NTHREADS, 2) enc_fwd(Args args) {
    extern __shared__ __attribute__((aligned(16))) unsigned char lds_raw[];
    Ctx c;
    c.lds = (LAS unsigned char*)lds_raw;
    c.tid = threadIdx.x; c.lane = c.tid & 63; c.wave = __builtin_amdgcn_readfirstlane(c.tid >> 6);
    c.G = gridDim.x; c.bx = blockIdx.x; c.gw = c.bx * NWAVES + c.wave; c.NGW = c.G * NWAVES;
    volatile LAS unsigned* MISC = (volatile LAS unsigned*)(c.lds + MISC_OFF);
    for (int u = c.tid; u < (LDS_BYTES - LDSCTL_OFF) / 4; u += NTHREADS) ((LAS unsigned*)(c.lds + LDSCTL_OFF))[u] = 0u;
    __syncthreads();
    XcdBarrier bar = xcd_barrier_post((unsigned*)(args.ws + WS_CTL) + 4096, MISC + 8);
    const int lo = args.ph_lo, hi = args.ph_hi;
    int ph = 0;
    run_layer<0>(c, args, bar, lo, hi, ph);
    run_layer<1>(c, args, bar, lo, hi, ph);
    run_layer<2>(c, args, bar, lo, hi, ph);
    run_layer<3>(c, args, bar, lo, hi, ph);
}
#undef PHASE

#ifndef MK_N_LAUNCHES
#define MK_N_LAUNCHES 1
#endif
extern "C" void kernel_launch(void* const* d_in, const int* in_sizes, int n_in, void* d_out, int out_size, void* d_ws, size_t ws_size, hipStream_t stream) {
    static int grid = 0;
    if (grid == 0) {
        if (n_in != 25 || in_sizes[0] != MROWS * DM || out_size != MROWS * DM || ws_size < WS_END) {
            fprintf(stderr, "kernel_launch: unexpected shapes: n_in %d in0 %d out %d ws %zu (need %zu)\n", n_in, n_in > 0 ? in_sizes[0] : -1, out_size, ws_size, (size_t)WS_END); grid = -1; return; }
        int dev = 0, cus = 0, per_cu = 0;
        if (hipGetDevice(&dev) != hipSuccess || hipDeviceGetAttribute(&cus, hipDeviceAttributeMultiprocessorCount, dev) != hipSuccess) { grid = -1; return; }
        if (hipFuncSetAttribute((const void*)enc_fwd, hipFuncAttributeMaxDynamicSharedMemorySize, LDS_BYTES) != hipSuccess) { fprintf(stderr, "kernel_launch: hipFuncSetAttribute failed\n"); grid = -1; return; }
        if (hipOccupancyMaxActiveBlocksPerMultiprocessor(&per_cu, (const void*)enc_fwd, NTHREADS, LDS_BYTES) != hipSuccess || per_cu < 1)
            fprintf(stderr, "kernel_launch: note: occupancy query reports %d workgroups per CU\n", per_cu);
        (void)hipGetLastError();
        grid = cus;
    }
    if (grid < 0) return;
    Args a{};
    for (int i = 0; i < 25; ++i) a.in[i] = (const float*)d_in[i];
    a.out = (float*)d_out; a.ws = (unsigned char*)d_ws;
    if (MK_N_LAUNCHES == 1) {
        (void)hipMemsetAsync((char*)d_ws + WS_CTL, 0, CTL_ZERO_BYTES, stream);
        a.ph_lo = 0; a.ph_hi = NPHASES;
        hipLaunchKernelGGL(enc_fwd, dim3(grid), dim3(NTHREADS), LDS_BYTES, stream, a);
    } else {
        for (int p = 0; p < NPHASES; ++p) {
            (void)hipMemsetAsync((char*)d_ws + WS_CTL, 0, CTL_ZERO_BYTES, stream);
            a.ph_lo = p; a.ph_hi = p + 1;
            hipLaunchKernelGGL(enc_fwd, dim3(grid), dim3(NTHREADS), LDS_BYTES, stream, a);
        }
    }
    const hipError_t le = hipPeekAtLastError();
    if (le != hipSuccess) fprintf(stderr, "kernel_launch: launch failed: %s\n", hipGetErrorName(le));
}
```

```cpp
#include <hip/hip_runtime.h>
#include <cstdio>
#include <cstdint>

#define DI __device__ __forceinline__
#define LAS __attribute__((address_space(3)))
#define GAS __attribute__((address_space(1)))
typedef unsigned short bf16;
typedef short bf16x8 __attribute__((ext_vector_type(8)));
typedef short s16x4 __attribute__((ext_vector_type(4)));
typedef float f32x2 __attribute__((ext_vector_type(2)));
typedef float f32x4 __attribute__((ext_vector_type(4)));
typedef float f32x16 __attribute__((ext_vector_type(16)));
typedef unsigned u32x2 __attribute__((ext_vector_type(2)));
typedef unsigned u32x4 __attribute__((ext_vector_type(4)));
typedef __bf16 bf16x2_t __attribute__((ext_vector_type(2)));

constexpr int BATCH = 4, SEQ = 8192, DM = 1024, MROWS = BATCH * SEQ;
constexpr int FFN_H = 2816, FFN_U = 2 * FFN_H;
constexpr float EPS = 1e-6f, LOG2E = 1.4426950408889634f;
constexpr int NWAVES = 8, NTHREADS = NWAVES * 64;

constexpr size_t MiB = 1u << 20;
constexpr size_t WS_CTL = 0, CTL_ZERO_BYTES = 1 * MiB;
constexpr size_t WS_ROPE = 1 * MiB;
constexpr size_t WS_WT = 4 * MiB;
constexpr size_t WT_MIX = WS_WT, WT_UP = WS_WT + 16 * MiB, WT_DOWN = WS_WT + 28 * MiB;
constexpr size_t WS_XN = 40 * MiB;
constexpr size_t WS_S = 104 * MiB;
constexpr size_t WS_END = 512 * MiB;

DI unsigned pk2(float lo, float hi) { f32x2 v = {lo, hi}; bf16x2_t b = __builtin_convertvector(v, bf16x2_t); return __builtin_bit_cast(unsigned, b); }
DI float bflo(unsigned w) { return __uint_as_float(w << 16); }
DI float bfhi(unsigned w) { return __uint_as_float(w & 0xffff0000u); }
DI float bf2f(bf16 b) { return __uint_as_float((unsigned)b << 16); }
DI bf16 f2bf(float f) { return (bf16)(pk2(f, 0.f) & 0xffffu); }
DI float wave_sum(float v) {
#pragma unroll
    for (int o = 1; o < 64; o <<= 1) v += __shfl_xor(v, o);
    return v;
}
DI float fexp2(float x) { return __builtin_amdgcn_exp2f(x); }
DI float fexp(float x) { return __builtin_amdgcn_exp2f(x * LOG2E); }
DI float frcp(float x) { return __builtin_amdgcn_rcpf(x); }
DI float sigmoidf_(float x) { return frcp(1.f + fexp(-x)); }
DI float log_sigmoid_(float x) { return fminf(x, 0.f) - log1pf(expf(-fabsf(x))); }
DI int crow(int r, int hi) { return (r & 3) + 8 * (r >> 2) + 4 * hi; }
#define MFMA32(a, b, c) __builtin_amdgcn_mfma_f32_32x32x16_bf16((a), (b), (c), 0, 0, 0)

DI bf16x8 frag_row(const LAS bf16* base, int ld, int row0, int k0, int lane) {
    return *(const LAS bf16x8*)(base + (row0 + (lane & 31)) * ld + k0 + 8 * (lane >> 5));
}
typedef short v4i16_t __attribute__((ext_vector_type(4)));
DI s16x4 tr_rd(const LAS bf16* p) { return __builtin_bit_cast(s16x4, __builtin_amdgcn_ds_read_tr16_b64_v4i16((LAS v4i16_t*)p)); }
DI bf16x8 frag_tr(const LAS bf16* base, int ld, int k0, int n0, int lane) {
    const int g = lane >> 4, i = lane & 15, r = i >> 2, c = i & 3, h = lane >> 5;
    const LAS bf16* p = base + (k0 + 8 * h + r) * ld + n0 + 16 * (g & 1) + 4 * c;
    const s16x4 lo = tr_rd(p), hi = tr_rd(p + 4 * ld);
    return (bf16x8){lo[0], lo[1], lo[2], lo[3], hi[0], hi[1], hi[2], hi[3]};
}
DI bf16x8 gfrag_row(const bf16* base, int ld, int row0, int k0, int lane) {
    return *(const bf16x8*)(base + (size_t)(row0 + (lane & 31)) * ld + k0 + 8 * (lane >> 5));
}

namespace pg8 {
typedef unsigned short bf16_t;
constexpr int BM = 256, BK = 64, HALF = 128, HTB = HALF * BK * 2, STAGE_BYTES = 8 * HTB, NXCD = 8, WGM = 8;
__host__ __device__ __forceinline__ int lds_byte(int r, int c) { const int st = (r >> 4) * 2 + (c >> 5), rr = r & 15, cc = c & 31, ob = rr * 64 + cc * 2; return st * 1024 + (ob ^ (((ob >> 9) & 1) << 5)); }
__host__ __device__ __forceinline__ void stage_rc(int b, int& R, int& C) { const int st = b / 1024, sb = b % 1024, swz = sb ^ (((sb >> 9) & 1) << 5); R = (st >> 1) * 16 + swz / 64; C = (st & 1) * 32 + (swz % 64) / 2; }
__host__ __device__ __forceinline__ int perm32(int rho) { const int n = rho >> 4, i = rho & 15; return 8 * (i >> 2) + 4 * n + (i & 3); }

struct Unit { int pm, pn; };
struct Gemm { const bf16_t* A; const bf16_t* Bt; int M, N, K; int lda; int kpairA; };

struct StaticOrder {
    int nM, nN, nwg, G, c;
    __host__ __device__ void init(int M, int N, int G_, int c_) { nM = M / BM; nN = N / BM; nwg = nM * nN; G = G_; c = c_; }
    __host__ __device__ bool next(int i, Unit& u) const {
        const long L = (long)i * G + c; if (L >= nwg) return false;
        int wgid = (int)L; { const int q = nwg / NXCD, r = nwg % NXCD, xcd = wgid % NXCD, off = wgid / NXCD; wgid = (xcd < r ? xcd * (q + 1) : r * (q + 1) + (xcd - r) * q) + off; }
        const int nig = WGM * nN, gid = wgid / nig, fm = gid * WGM, gsz = (nM - fm) < WGM ? (nM - fm) : WGM;
        u.pm = fm + ((wgid % nig) % gsz); u.pn = (wgid % nig) / gsz; return true;
    }
};

DI void store8(bf16_t* p, f32x4 v0, f32x4 v1, float sc) {
    u32x4 w; w.x = pk2(v0[0] * sc, v0[1] * sc); w.y = pk2(v0[2] * sc, v0[3] * sc); w.z = pk2(v1[0] * sc, v1[1] * sc); w.w = pk2(v1[2] * sc, v1[3] * sc);
    *(u32x4*)p = w;
}
template <bool GATES> struct EpiSeg {
    static constexpr bool PERM = true, MUTATES = false;
    bf16_t *p0, *p1, *p2, *p3; int ld0, ld1, ld2, ld3; int e0, e1, e2; float s0, s1, s2, s3;
    float* gates; const float* gbias; int gblk;
    const float* rowscale;
    DI void operator()(const f32x4 (&acc)[2][2][4][2], const Unit& u, int wr, int wc, int fr, int fq) const {
        const int row0 = u.pm * BM + wr * 64 + fr;
#define RS_(ai, m) (rowscale ? rowscale[row0 + (ai) * HALF + (m) * 16] : 1.f)
#pragma unroll
        for (int bj = 0; bj < 2; ++bj) {
            const int blk = 2 * u.pn + bj;
            if (GATES && blk >= gblk) {
                if (blk == gblk && wc == 0) {
                    const f32x4 b0 = *(const f32x4*)(gbias + 8 * fq), b1 = *(const f32x4*)(gbias + 8 * fq + 4);
#pragma unroll
                    for (int ai = 0; ai < 2; ++ai)
#pragma unroll
                        for (int m = 0; m < 4; ++m) { float* gp = gates + (size_t)(row0 + ai * HALF + m * 16) * 32 + 8 * fq;
                            const float r_ = RS_(ai, m); *(f32x4*)gp = acc[ai][bj][m][0] * r_ + b0; *(f32x4*)(gp + 4) = acc[ai][bj][m][1] * r_ + b1; }
                }
                continue;
            }
            bf16_t* base; int ld, b0; float sc;
            if (blk < e0) { base = p0; ld = ld0; b0 = 0; sc = s0; }
            else if (blk < e1) { base = p1; ld = ld1; b0 = e0; sc = s1; }
            else if (blk < e2) { base = p2; ld = ld2; b0 = e1; sc = s2; }
            else { base = p3; ld = ld3; b0 = e2; sc = s3; }
            bf16_t* cp = base + (blk - b0) * 128 + wc * 32 + 8 * fq;
#pragma unroll
            for (int ai = 0; ai < 2; ++ai)
#pragma unroll
                for (int m = 0; m < 4; ++m) store8(cp + (size_t)(row0 + ai * HALF + m * 16) * ld, acc[ai][bj][m][0], acc[ai][bj][m][1], sc * RS_(ai, m));
        }
#undef RS_
    }
};
DI EpiSeg<false> epi_plain(bf16_t* O, int ld, float sc, const float* rowscale = nullptr) { EpiSeg<false> E{}; E.p0 = O; E.ld0 = ld; E.e0 = 100000; E.e1 = 100000; E.e2 = 100000; E.s0 = sc; E.rowscale = rowscale; return E; }
struct EpiF32 {
    static constexpr bool PERM = true, MUTATES = false;
    float* O; int ld;
    DI void operator()(const f32x4 (&acc)[2][2][4][2], const Unit& u, int wr, int wc, int fr, int fq) const {
        const int row0 = u.pm * BM + wr * 64 + fr;
#pragma unroll
        for (int bj = 0; bj < 2; ++bj) { float* cp = O + u.pn * 256 + bj * 128 + wc * 32 + 8 * fq;
#pragma unroll
            for (int ai = 0; ai < 2; ++ai)
#pragma unroll
                for (int m = 0; m < 4; ++m) { float* rp = cp + (size_t)(row0 + ai * HALF + m * 16) * ld; *(f32x4*)rp = acc[ai][bj][m][0]; *(f32x4*)(rp + 4) = acc[ai][bj][m][1]; } }
    }
};
struct EpiMlaKV {
    static constexpr bool PERM = true, MUTATES = false;
    bf16_t* KF; bf16_t* V;
    DI void operator()(const f32x4 (&acc)[2][2][4][2], const Unit& u, int wr, int wc, int fr, int fq) const {
        const int row0 = u.pm * BM + wr * 64 + fr;
#pragma unroll
        for (int bj = 0; bj < 2; ++bj) {
            bf16_t* cp = (bj == 0 ? KF + u.pn * 192 : V + u.pn * 128) + wc * 32 + 8 * fq; const int ld = (bj == 0) ? 1536 : 1024;
#pragma unroll
            for (int ai = 0; ai < 2; ++ai)
#pragma unroll
                for (int m = 0; m < 4; ++m) store8(cp + (size_t)(row0 + ai * HALF + m * 16) * ld, acc[ai][bj][m][0], acc[ai][bj][m][1], 1.f);
        }
    }
};
struct EpiFfnUp {
    static constexpr bool PERM = true, MUTATES = false;
    bf16_t* U; bf16_t* HALO; const float* rowscale;
    DI void operator()(const f32x4 (&acc)[2][2][4][2], const Unit& u, int wr, int wc, int fr, int fq) const {
        const int row0 = u.pm * BM + wr * 64 + fr;
        float rs[2][4];
#pragma unroll
        for (int ai = 0; ai < 2; ++ai)
#pragma unroll
            for (int m = 0; m < 4; ++m) rs[ai][m] = rowscale[row0 + ai * HALF + m * 16];
#pragma unroll
        for (int bj = 0; bj < 2; ++bj) {
            const int col = u.pn * 256 + bj * 128 + wc * 32 + 8 * fq;
#pragma unroll
            for (int ai = 0; ai < 2; ++ai)
#pragma unroll
                for (int m = 0; m < 4; ++m) {
                    const int row = row0 + ai * HALF + m * 16;
                    store8(U + (size_t)row * FFN_U + col, acc[ai][bj][m][0], acc[ai][bj][m][1], rs[ai][m]);
                    if (fr == 0 || fr == 15) store8(HALO + ((size_t)(row >> 4) * 2 + (fr == 15 ? 1 : 0)) * FFN_U + col, acc[ai][bj][m][0], acc[ai][bj][m][1], rs[ai][m]);
                }
        }
    }
};

template <int CTRL> DI float dpp_f(float oldv, float src) { return __int_as_float(__builtin_amdgcn_update_dpp(__float_as_int(oldv), __float_as_int(src), CTRL, 0xF, 0xF, false)); }
DI float gelu_tanh_(float x) { const float z = 0.7978845608028654f * (x + 0.044715f * x * x * x); return x * __builtin_amdgcn_rcpf(1.f + __builtin_amdgcn_exp2f(-2.f * 1.4426950408889634f * z)); }
constexpr int EDGE_LDS_OFF = 131072;
struct EpiFfnConv {
    static constexpr bool PERM = true, MUTATES = true;
    bf16_t* HH; float* HALO2; const float* rowscale; const float* cw; const float* cb;
    template <bool FIRST, bool LAST> DI static f32x4 conv4(const f32x4 cur, const f32x4 pm_, const f32x4 nm_, const f32x4 w0, const f32x4 w1, const f32x4 w2, const f32x4 bb) {
        f32x4 t_;
#pragma unroll
        for (int j = 0; j < 4; ++j) {
            const float bu = FIRST ? pm_[j] : dpp_f<0x121>(0.f, pm_[j]);
            const float up = dpp_f<0x111>(bu, cur[j]);
            const float bd = LAST ? nm_[j] : dpp_f<0x12F>(0.f, nm_[j]);
            const float dn = dpp_f<0x101>(bd, cur[j]);
            t_[j] = bb[j] + w0[j] * up + w1[j] * cur[j] + w2[j] * dn;
        }
        return t_;
    }
    DI void run(const f32x4 (&acc)[2][2][4][2], const Unit& u, int wr, int wc, int fr, int fq, int ui, LAS unsigned char* lds) const {
        const int row0 = u.pm * BM + wr * 64 + fr;
        LAS float* E = (LAS float*)(lds + EDGE_LDS_OFF + (ui & 1) * 8192);
        const int ecol = wc * 32 + 8 * fq;
        float rs[2][4];
#pragma unroll
        for (int ai = 0; ai < 2; ++ai)
#pragma unroll
            for (int m = 0; m < 4; ++m) rs[ai][m] = rowscale[row0 + ai * HALF + m * 16];
#pragma unroll
        for (int ai = 0; ai < 2; ++ai) { const int sp = 2 * ai + wr;
            if (fr == 0) {
#pragma unroll
                for (int bj = 0; bj < 2; ++bj)
#pragma unroll
                    for (int n = 0; n < 2; ++n) *(LAS f32x4*)(E + (2 * sp) * 256 + bj * 128 + ecol + 4 * n) = acc[ai][bj][0][n] * rs[ai][0]; }
            if (fr == 15) {
#pragma unroll
                for (int bj = 0; bj < 2; ++bj)
#pragma unroll
                    for (int n = 0; n < 2; ++n) *(LAS f32x4*)(E + (2 * sp + 1) * 256 + bj * 128 + ecol + 4 * n) = acc[ai][bj][3][n] * rs[ai][3]; } }
        if (wr == 0 && fr < 2) {
#pragma unroll
            for (int bj = 0; bj < 2; ++bj)
#pragma unroll
                for (int n = 0; n < 2; ++n) *(f32x4*)(HALO2 + ((size_t)u.pm * 4 + fr) * FFN_U + u.pn * 256 + bj * 128 + ecol + 4 * n) = acc[0][bj][0][n] * rs[0][0]; }
        if (wr == 1 && fr >= 14) {
#pragma unroll
            for (int bj = 0; bj < 2; ++bj)
#pragma unroll
                for (int n = 0; n < 2; ++n) *(f32x4*)(HALO2 + ((size_t)u.pm * 4 + 2 + (fr - 14)) * FFN_U + u.pn * 256 + bj * 128 + ecol + 4 * n) = acc[1][bj][3][n] * rs[1][3]; }
        asm volatile("s_waitcnt lgkmcnt(0)" ::: "memory"); __builtin_amdgcn_s_barrier(); asm volatile("" ::: "memory");
#pragma unroll
        for (int n = 0; n < 2; ++n) {
            __builtin_amdgcn_sched_barrier(0);
            const int ch = u.pn * 128 + ecol + 4 * n;
            const f32x4 g0 = *(const f32x4*)(cw + ch), g1 = *(const f32x4*)(cw + FFN_U + ch), g2 = *(const f32x4*)(cw + 2 * FFN_U + ch), gb = *(const f32x4*)(cb + ch);
            const f32x4 v0 = *(const f32x4*)(cw + FFN_H + ch), v1 = *(const f32x4*)(cw + FFN_U + FFN_H + ch), v2 = *(const f32x4*)(cw + 2 * FFN_U + FFN_H + ch), vb = *(const f32x4*)(cb + FFN_H + ch);
#define FC_STEP(AI, M) step<AI, M>(acc, rs, E, ecol, n, wr, fr, row0, ch, g0, g1, g2, gb, v0, v1, v2, vb)
            FC_STEP(0, 0); FC_STEP(0, 1); FC_STEP(0, 2); FC_STEP(0, 3); FC_STEP(1, 0); FC_STEP(1, 1); FC_STEP(1, 2); FC_STEP(1, 3);
#undef FC_STEP
        }
    }
    template <int AI, int M> DI void step(const f32x4 (&acc)[2][2][4][2], const float (&rs)[2][4], const LAS float* E, int ecol, int n, int wr, int fr, int row0, int ch,
                                          const f32x4 g0, const f32x4 g1, const f32x4 g2, const f32x4 gb, const f32x4 v0, const f32x4 v1, const f32x4 v2, const f32x4 vb) const {
        const int sp = 2 * AI + wr;
        f32x4 cg, cv;
        if constexpr (M == 0) {
            const LAS float* ep = E + (2 * (sp > 0 ? sp - 1 : 0) + 1) * 256 + ecol + 4 * n;
            cg = conv4<true, false>(acc[AI][0][0][n] * rs[AI][0], *(const LAS f32x4*)ep, acc[AI][0][1][n] * rs[AI][1], g0, g1, g2, gb);
            cv = conv4<true, false>(acc[AI][1][0][n] * rs[AI][0], *(const LAS f32x4*)(ep + 128), acc[AI][1][1][n] * rs[AI][1], v0, v1, v2, vb);
        } else if constexpr (M == 3) {
            const LAS float* ep = E + (2 * (sp < 3 ? sp + 1 : 3)) * 256 + ecol + 4 * n;
            cg = conv4<false, true>(acc[AI][0][3][n] * rs[AI][3], acc[AI][0][2][n] * rs[AI][2], *(const LAS f32x4*)ep, g0, g1, g2, gb);
            cv = conv4<false, true>(acc[AI][1][3][n] * rs[AI][3], acc[AI][1][2][n] * rs[AI][2], *(const LAS f32x4*)(ep + 128), v0, v1, v2, vb);
        } else {
            cg = conv4<false, false>(acc[AI][0][M][n] * rs[AI][M], acc[AI][0][M - 1][n] * rs[AI][M - 1], acc[AI][0][M + 1][n] * rs[AI][M + 1], g0, g1, g2, gb);
            cv = conv4<false, false>(acc[AI][1][M][n] * rs[AI][M], acc[AI][1][M - 1][n] * rs[AI][M - 1], acc[AI][1][M + 1][n] * rs[AI][M + 1], v0, v1, v2, vb);
        }
        const int row = row0 + AI * HALF + M * 16;
        const bool skip = (AI == 0 && M == 0 && wr == 0 && fr == 0) || (AI == 1 && M == 3 && wr == 1 && fr == 15);
        u32x2 o; o.x = pk2(gelu_tanh_(cg[0]) * cv[0], gelu_tanh_(cg[1]) * cv[1]); o.y = pk2(gelu_tanh_(cg[2]) * cv[2], gelu_tanh_(cg[3]) * cv[3]);
        if (!skip) *(u32x2*)(HH + (size_t)row * FFN_H + ch) = o;
        __builtin_amdgcn_sched_barrier(0);
    }
};
DI void ffn_fix_rows(const int lane, const int gw, const int NGW, const int p_lo, const int p_hi, const float* HALO2, const float* cw, const float* cb, bf16_t* HH) {
    for (int t = 2 * p_lo + gw; t < 2 * p_hi; t += NGW) {
        const int p = t >> 1, bot = t & 1;
        const float* rc = HALO2 + ((size_t)p * 4 + (bot ? 3 : 0)) * FFN_U;
        const float* rp = bot ? HALO2 + ((size_t)p * 4 + 2) * FFN_U : HALO2 + ((size_t)(p > 0 ? p - 1 : 0) * 4 + 3) * FFN_U;
        const float* rn = bot ? HALO2 + ((size_t)(p < MROWS / 256 - 1 ? p + 1 : p) * 4 + 0) * FFN_U : HALO2 + ((size_t)p * 4 + 1) * FFN_U;
        const bool zp = !bot && (p % (SEQ / 256) == 0), zn = bot && ((p + 1) % (SEQ / 256) == 0);
        const int row = p * 256 + (bot ? 255 : 0);
        for (int it = 0; it < 11; ++it) {
            const int ch = 4 * (lane + 64 * it), gcol = (ch >> 7) * 256 + (ch & 127);
            f32x4 gp = *(const f32x4*)(rp + gcol), gc = *(const f32x4*)(rc + gcol), gn = *(const f32x4*)(rn + gcol);
            f32x4 vp = *(const f32x4*)(rp + gcol + 128), vc = *(const f32x4*)(rc + gcol + 128), vn = *(const f32x4*)(rn + gcol + 128);
            if (zp) { gp = (f32x4){0.f, 0.f, 0.f, 0.f}; vp = gp; }
            if (zn) { gn = (f32x4){0.f, 0.f, 0.f, 0.f}; vn = gn; }
            const f32x4 wg0 = *(const f32x4*)(cw + ch), wg1 = *(const f32x4*)(cw + FFN_U + ch), wg2 = *(const f32x4*)(cw + 2 * FFN_U + ch), bg = *(const f32x4*)(cb + ch);
            const f32x4 wv0 = *(const f32x4*)(cw + FFN_H + ch), wv1 = *(const f32x4*)(cw + FFN_U + FFN_H + ch), wv2 = *(const f32x4*)(cw + 2 * FFN_U + FFN_H + ch), bv = *(const f32x4*)(cb + FFN_H + ch);
            float o_[4];
#pragma unroll
            for (int j = 0; j < 4; ++j) { const float g_ = bg[j] + wg0[j] * gp[j] + wg1[j] * gc[j] + wg2[j] * gn[j], v_ = bv[j] + wv0[j] * vp[j] + wv1[j] * vc[j] + wv2[j] * vn[j]; o_[j] = gelu_tanh_(g_) * v_; }
            u32x2 o; o.x = pk2(o_[0], o_[1]); o.y = pk2(o_[2], o_[3]);
            *(u32x2*)(HH + (size_t)row * FFN_H + ch) = o;
        }
    }
}

template <class Epi>
DI void gemm_phase(LAS unsigned char* lds, const int tid, const Gemm g, const StaticOrder& S, const Epi& E) {
    const int wid = __builtin_amdgcn_readfirstlane(tid >> 6), lane = tid & 63, wr = wid >> 2, wc = wid & 3, fr = lane & 15, fq = lane >> 4;
    const int K = g.K; int nt = K / BK; asm volatile("" : "+s"(nt));
    unsigned voffA[2], voffB[2];
#pragma unroll
    for (int i = 0; i < 2; ++i) { int R, C; stage_rc(tid * 16 + i * 8192, R, C); const int Rb = Epi::PERM ? ((R & ~31) + perm32(R & 31)) : R;
        voffA[i] = (unsigned)(R * g.lda + C) * 2u; voffB[i] = (unsigned)(Rb * K + C) * 2u; }
    const size_t kstep = (size_t)(BK * 2);
    const size_t kpairA = (size_t)g.kpairA;
    const size_t hstepA = (size_t)HALF * g.lda * 2, hstepB = (size_t)HALF * K * 2;
    const size_t tstepA = 2 * hstepA, tstepB = 2 * hstepB;
    const unsigned ldsw = (unsigned)wid * 1024u;
    const int aoff = lds_byte(wr * 64 + fr, fq * 8), boff = lds_byte(wc * 32 + fr, fq * 8);
#define PG8_SA(b, h) (((b) * 2 + (h)) * HTB)
#define PG8_SB(b, h) ((4 + (b) * 2 + (h)) * HTB)
#define PG8_STAGE(bufoff, gbase, voff) do { _Pragma("unroll") for (int _i = 0; _i < 2; ++_i) \
        __builtin_amdgcn_global_load_lds((const unsigned*)((const char*)(gbase) + (voff)[_i]), (LAS unsigned*)(lds + (bufoff) + ldsw + _i * 8192), 16, 0, 0); } while (0)
#define PG8_LDA(dst, b, h) do { _Pragma("unroll") for (int m = 0; m < 4; ++m) _Pragma("unroll") for (int k = 0; k < 2; ++k) dst[m][k] = *(const LAS bf16x8*)(lds + PG8_SA(b, h) + aoff + m * 2048 + k * 1024); } while (0)
#define PG8_LDB(dst, b, h) do { _Pragma("unroll") for (int n = 0; n < 2; ++n) _Pragma("unroll") for (int k = 0; k < 2; ++k) dst[n][k] = *(const LAS bf16x8*)(lds + PG8_SB(b, h) + boff + n * 2048 + k * 1024); } while (0)
#define PG8_MMA(ai, bj, At, Bt) do { __builtin_amdgcn_s_setprio(1); _Pragma("unroll") for (int m = 0; m < 4; ++m) _Pragma("unroll") for (int n = 0; n < 2; ++n) _Pragma("unroll") for (int k = 0; k < 2; ++k) \
        acc[ai][bj][m][n] = __builtin_amdgcn_mfma_f32_16x16x32_bf16(Bt[n][k], At[m][k], acc[ai][bj][m][n], 0, 0, 0); __builtin_amdgcn_s_setprio(0); } while (0)
#define PG8_WAIT_V(n) asm volatile("s_waitcnt vmcnt(" #n ")" ::: "memory")
#define PG8_WAIT_L(n) asm volatile("s_waitcnt lgkmcnt(" #n ")" ::: "memory")
#define PG8_BAR __builtin_amdgcn_s_barrier()
#define PG8_SCHED __builtin_amdgcn_sched_barrier(0)
    Unit cur, nxt; int ui = 0;
    if (!S.next(0, cur)) return;
    f32x4 acc[2][2][4][2];
#pragma unroll
    for (int a = 0; a < 2; ++a)
#pragma unroll
        for (int b = 0; b < 2; ++b)
#pragma unroll
            for (int m = 0; m < 4; ++m)
#pragma unroll
                for (int n = 0; n < 2; ++n) acc[a][b][m][n] = (f32x4){0.f, 0.f, 0.f, 0.f};
    bf16x8 At[4][2], B0[2][2], B1[2][2];
    const char* cA = (const char*)g.A + (size_t)cur.pm * tstepA; const char* cB = (const char*)g.Bt + (size_t)cur.pn * tstepB;
    PG8_STAGE(PG8_SB(0, 0), cB, voffB); PG8_STAGE(PG8_SB(0, 1), cB + hstepB, voffB); PG8_STAGE(PG8_SA(0, 0), cA, voffA); PG8_STAGE(PG8_SA(0, 1), cA + hstepA, voffA);
    if (wr == 1) PG8_BAR;
    PG8_WAIT_V(2); PG8_BAR;
    PG8_STAGE(PG8_SB(1, 0), cB + kstep, voffB); PG8_STAGE(PG8_SA(1, 0), cA + kstep, voffA); PG8_STAGE(PG8_SB(1, 1), cB + hstepB + kstep, voffB);
    PG8_WAIT_V(6); PG8_BAR;
    for (;;) {
        const bool has_next = S.next(ui + 1, nxt);
        const char* nA = has_next ? (const char*)g.A + (size_t)nxt.pm * tstepA : cA; const char* nB = has_next ? (const char*)g.Bt + (size_t)nxt.pn * tstepB : cB;
#pragma unroll 1
        for (int t = 0; t < nt; t += 2) {
            const bool last = (t == nt - 2);
            const char* a1 = cA + (size_t)(t >> 1) * kpairA + kstep;
            const char* a2 = last ? nA : cA + (size_t)((t >> 1) + 1) * kpairA; const char* b2 = last ? nB : cB + (size_t)(t + 2) * kstep;
            const char* a3 = a2 + kstep; const char* b3 = b2 + kstep;
            PG8_LDB(B0, 0, 0); PG8_LDB(B1, 0, 1); PG8_SCHED; PG8_LDA(At, 0, 0); PG8_STAGE(PG8_SA(1, 1), a1 + hstepA, voffA);
            PG8_WAIT_V(8); PG8_WAIT_L(0); PG8_BAR; PG8_MMA(0, 0, At, B0); PG8_MMA(0, 1, At, B1); PG8_BAR; PG8_SCHED;
            PG8_LDA(At, 0, 1); PG8_STAGE(PG8_SB(0, 0), b2, voffB); PG8_STAGE(PG8_SB(0, 1), b2 + hstepB, voffB); PG8_STAGE(PG8_SA(0, 0), a2, voffA);
            PG8_WAIT_V(8); PG8_WAIT_L(0); PG8_BAR; PG8_MMA(1, 0, At, B0); PG8_MMA(1, 1, At, B1); PG8_BAR; PG8_SCHED;
            PG8_LDB(B0, 1, 0); PG8_LDB(B1, 1, 1); PG8_SCHED; PG8_LDA(At, 1, 0); PG8_STAGE(PG8_SA(0, 1), a2 + hstepA, voffA);
            PG8_WAIT_V(8); PG8_WAIT_L(0); PG8_BAR; PG8_MMA(0, 0, At, B0); PG8_MMA(0, 1, At, B1); PG8_BAR; PG8_SCHED;
            PG8_LDA(At, 1, 1); PG8_STAGE(PG8_SB(1, 0), b3, voffB); PG8_STAGE(PG8_SB(1, 1), b3 + hstepB, voffB); PG8_STAGE(PG8_SA(1, 0), a3, voffA);
            PG8_WAIT_V(8); PG8_WAIT_L(0); PG8_BAR; PG8_MMA(1, 0, At, B0); PG8_MMA(1, 1, At, B1); PG8_BAR; PG8_SCHED;
        }
        if (wr == 0) PG8_BAR;
        if constexpr (Epi::MUTATES) E.run(acc, cur, wr, wc, fr, fq, ui, lds); else E(acc, cur, wr, wc, fr, fq);
        if (!has_next) break;
#pragma unroll
        for (int a = 0; a < 2; ++a)
#pragma unroll
            for (int b = 0; b < 2; ++b)
#pragma unroll
                for (int m = 0; m < 4; ++m)
#pragma unroll
                    for (int n = 0; n < 2; ++n) acc[a][b][m][n] = (f32x4){0.f, 0.f, 0.f, 0.f};
        cur = nxt; cA = nA; cB = nB; ++ui;
        if (wr == 1) PG8_BAR;
    }
    PG8_WAIT_V(0);
    PG8_BAR;
#undef PG8_SA
#undef PG8_SB
#undef PG8_STAGE
#undef PG8_LDA
#undef PG8_LDB
#undef PG8_MMA
#undef PG8_WAIT_V
#undef PG8_WAIT_L
#undef PG8_BAR
#undef PG8_SCHED
}
}

namespace att {
constexpr int NW = 8, QBLK = 32, KVBLK = 64, DV = 128;
constexpr float THR2 = 8.f;
#define SBAR() __builtin_amdgcn_sched_barrier(0)
DI unsigned cvtpk(float lo, float hi) { unsigned r; asm volatile("v_cvt_pk_bf16_f32 %0, %1, %2" : "=v"(r) : "v"(lo), "v"(hi)); return r; }
DI void partialSM(f32x16& p0, f32x16& p1, float& m_reg, float& mn, float& alpha) {
    float pmax = p0[0];
#pragma unroll
    for (int r = 1; r < 16; ++r) pmax = fmaxf(pmax, p0[r]);
#pragma unroll
    for (int r = 0; r < 16; ++r) pmax = fmaxf(pmax, p1[r]);
    { auto rr = __builtin_amdgcn_permlane32_swap(__float_as_uint(pmax), __float_as_uint(pmax), false, false);
      pmax = fmaxf(__uint_as_float(rr[0]), __uint_as_float(rr[1])); }
    if (__builtin_expect(__all(pmax - m_reg <= THR2), 1)) { mn = m_reg; alpha = 1.f; }
    else { mn = fmaxf(m_reg, pmax); alpha = __builtin_amdgcn_exp2f(m_reg - mn); m_reg = mn; }
#pragma unroll
    for (int r = 0; r < 16; ++r) p0[r] = p0[r] - mn;
#pragma unroll
    for (int r = 0; r < 16; ++r) p1[r] = p1[r] - mn;
#pragma unroll
    for (int r = 0; r < 16; ++r) p0[r] = __builtin_amdgcn_exp2f(p0[r]);
}
DI void finishSM(f32x16& p0, f32x16& p1, float alpha, float& l_reg, bf16x8& pa0, bf16x8& pa1, bf16x8& pa2, bf16x8& pa3) {
#pragma unroll
    for (int r = 0; r < 16; ++r) p1[r] = __builtin_amdgcn_exp2f(p1[r]);
    float ps = 0;
#pragma unroll
    for (int r = 0; r < 16; ++r) ps += p0[r];
#pragma unroll
    for (int r = 0; r < 16; ++r) ps += p1[r];
    { auto rr = __builtin_amdgcn_permlane32_swap(__float_as_uint(ps), __float_as_uint(ps), false, false);
      ps = __uint_as_float(rr[0]) + __uint_as_float(rr[1]); }
    l_reg = l_reg * alpha + ps;
#define PK4(P, BASE, OUT) do { unsigned a0 = cvtpk(P[BASE + 0], P[BASE + 1]), a1 = cvtpk(P[BASE + 2], P[BASE + 3]);   \
    unsigned b0 = cvtpk(P[BASE + 4], P[BASE + 5]), b1 = cvtpk(P[BASE + 6], P[BASE + 7]);                              \
    auto r0 = __builtin_amdgcn_permlane32_swap(a0, b0, false, false); auto r1 = __builtin_amdgcn_permlane32_swap(a1, b1, false, false); \
    u32x4 w = {r0[0], r1[0], r0[1], r1[1]}; OUT = *reinterpret_cast<bf16x8*>(&w); } while (0)
    PK4(p0, 0, pa0); PK4(p0, 8, pa1); PK4(p1, 0, pa2); PK4(p1, 8, pa3);
#undef PK4
}
DI int v_st(int k, int c) { const int kk = (k & ~0xC) | ((k & 4) << 1) | ((k & 8) >> 1); return ((kk >> 3) * 4 + (c >> 5)) * 512 + ((kk & 7) * 32 + (c & 31)) * 2; }
DI int v_rd_base(int lane) { return ((lane & 3) << 3) | (((lane >> 2) & 3) << 6) | (((lane >> 4) & 1) << 5) | (((lane >> 5) & 1) << 8); }
constexpr int v_rd_off(int d0, int ks, int half) { return d0 * 512 + ks * 4096 + half * 2048; }
template <int OFF> DI s16x4 tr_read(int vb) {
    s16x4 r; asm volatile("ds_read_b64_tr_b16 %0, %1 offset:%2" : "=&v"(r) : "v"(vb), "i"(OFF) : "memory"); return r;
}
template <int D0> DI void pv_one(f32x16& od, int vb, bf16x8 pa0, bf16x8 pa1, bf16x8 pa2, bf16x8 pa3) {
    const s16x4 l0 = tr_read<v_rd_off(D0, 0, 0)>(vb), h0 = tr_read<v_rd_off(D0, 0, 1)>(vb), l1 = tr_read<v_rd_off(D0, 1, 0)>(vb), h1 = tr_read<v_rd_off(D0, 1, 1)>(vb);
    const s16x4 l2 = tr_read<v_rd_off(D0, 2, 0)>(vb), h2 = tr_read<v_rd_off(D0, 2, 1)>(vb), l3 = tr_read<v_rd_off(D0, 3, 0)>(vb), h3 = tr_read<v_rd_off(D0, 3, 1)>(vb);
    asm volatile("s_waitcnt lgkmcnt(0)" ::: "memory"); SBAR();
#define PK(L, H) (bf16x8){L[0], L[1], L[2], L[3], H[0], H[1], H[2], H[3]}
    od = MFMA32(pa0, PK(l0, h0), od);
    od = MFMA32(pa1, PK(l1, h1), od);
    od = MFMA32(pa2, PK(l2, h2), od);
    od = MFMA32(pa3, PK(l3, h3), od);
#undef PK
}
DI void pv_d0(f32x16* o, int vb, bf16x8 pa0, bf16x8 pa1, bf16x8 pa2, bf16x8 pa3) {
    pv_one<0>(o[0], vb, pa0, pa1, pa2, pa3); pv_one<1>(o[1], vb, pa0, pa1, pa2, pa3); pv_one<2>(o[2], vb, pa0, pa1, pa2, pa3); pv_one<3>(o[3], vb, pa0, pa1, pa2, pa3);
}

template <int DQK> struct Cfg {
    static constexpr int KROWB = DQK * 2 + 16;
    static constexpr int SHM_V = KVBLK * DV * 2, SHM_K = KVBLK * KROWB;
    static constexpr int SHM = 2 * SHM_V + 2 * SHM_K + NW * 64 * 4 + NW * 4096;
    static constexpr int NKC = DQK / 64;
    static constexpr int CPR = DQK / 8;
};
template <int DQK, bool ALIBI, bool ROPE, int ldq, int ldk, int ldv, int ldo>
DI void attn_unit(const bf16* __restrict__ Qb, const bf16* __restrict__ Kh, const bf16* __restrict__ Vh,
                  bf16* __restrict__ Ob, int seq, float slope2, int qpos0, const float* __restrict__ rope, char* lds, const int tid_in, const float kmax) {
    using C = Cfg<DQK>;
    constexpr int ND = DQK / 16;
    int tid = tid_in; asm volatile("" : "+v"(tid));
    const int wid = tid >> 6, lane = tid & 63, r32 = lane & 31, hi = lane >> 5;
    char* V_lds = lds; char* K_lds = lds + 2 * C::SHM_V;
    float* ws = (float*)(lds + 2 * C::SHM_V + 2 * C::SHM_K) + wid * 64; float* li_l = ws; float* al_l = ws + 32;
    float m_reg = -1e30f, l_reg = 0; f32x16 o[4] = {}; bf16x8 qr[ND];
    const bf16* Qw = Qb + (long)(wid * QBLK + r32) * ldq + hi * 8;
#pragma unroll
    for (int d0 = 0; d0 < ND; ++d0) qr[d0] = *reinterpret_cast<const bf16x8*>(Qw + d0 * 16);
    char* qrope = lds + 2 * C::SHM_V + 2 * C::SHM_K + NW * 64 * 4 + wid * 4096 + lane * 16;
    if (ROPE) {
        const float* rp = rope + (size_t)(qpos0 + wid * QBLK + r32) * 64;
#pragma unroll
        for (int d0 = ND - 4; d0 < ND; ++d0) {
            const f32x4 c0 = *(const f32x4*)(rp + (8 * (d0 - (ND - 4)) + 4 * hi) * 2), c1 = *(const f32x4*)(rp + (8 * (d0 - (ND - 4)) + 4 * hi) * 2 + 4);
            const u32x4 w = __builtin_bit_cast(u32x4, qr[d0]); u32x4 o_;
            { const float a = bflo(w[0]), b = bfhi(w[0]); o_[0] = pk2(a * c0[0] - b * c0[1], a * c0[1] + b * c0[0]); }
            { const float a = bflo(w[1]), b = bfhi(w[1]); o_[1] = pk2(a * c0[2] - b * c0[3], a * c0[3] + b * c0[2]); }
            { const float a = bflo(w[2]), b = bfhi(w[2]); o_[2] = pk2(a * c1[0] - b * c1[1], a * c1[1] + b * c1[0]); }
            { const float a = bflo(w[3]), b = bfhi(w[3]); o_[3] = pk2(a * c1[2] - b * c1[3], a * c1[3] + b * c1[2]); }
            *(u32x4*)(qrope + (d0 - (ND - 4)) * 1024) = o_;
        }
    }
    const int sr = tid >> 4, sc = (tid & 15) * 8, vst0 = v_st(sr, sc), vst1 = v_st(32 + sr, sc);
    int krow[C::NKC], kcol[C::NKC], kdst[C::NKC];
#pragma unroll
    for (int i = 0; i < C::NKC; ++i) { const int c = tid + 512 * i; krow[i] = c / C::CPR; kcol[i] = (c % C::CPR) * 8; kdst[i] = krow[i] * C::KROWB + kcol[i] * 2; }
    const int vb0 = (int)(uintptr_t)V_lds + v_rd_base(lane);
    const float qposh = (float)(qpos0 + wid * QBLK + r32 - 4 * hi);
    constexpr int SD = (DQK <= 64) ? 2 : 1;
    struct { bf16x8 vs0, vs1, ks[C::NKC]; } st_[SD];
#define SLOAD(s_, k0) do { st_[s_].vs0 = *reinterpret_cast<const bf16x8*>(&Vh[(long)((k0) + sr) * ldv + sc]); st_[s_].vs1 = *reinterpret_cast<const bf16x8*>(&Vh[(long)((k0) + 32 + sr) * ldv + sc]); \
    _Pragma("unroll") for (int i_ = 0; i_ < C::NKC; ++i_) st_[s_].ks[i_] = *reinterpret_cast<const bf16x8*>(&Kh[(long)((k0) + krow[i_]) * ldk + kcol[i_]]); } while (0)
#define SWRITE(s_, b) do { *(bf16x8*)(V_lds + (b) * C::SHM_V + vst0) = st_[s_].vs0; *(bf16x8*)(V_lds + (b) * C::SHM_V + vst1) = st_[s_].vs1; \
    _Pragma("unroll") for (int i_ = 0; i_ < C::NKC; ++i_) *(bf16x8*)(K_lds + (b) * C::SHM_K + kdst[i_]) = st_[s_].ks[i_]; } while (0)
#define SWAIT() asm volatile("s_waitcnt vmcnt(0)" ::: "memory")
#define RESC(a) do { if (__any((a) < 1.f)) { if (hi == 0) al_l[r32] = (a); asm volatile("s_waitcnt lgkmcnt(0)" ::: "memory"); \
    _Pragma("unroll") for (int d = 0; d < 4; ++d) _Pragma("unroll") for (int r = 0; r < 16; ++r) o[d][r] *= al_l[crow(r, hi)]; } } while (0)
#define KLD(i_, KB, d0_) do { const int cb_ = ((d0_) * 16 + hi * 8) * 2; kb0[i_] = *reinterpret_cast<const bf16x8*>((KB) + r32 * C::KROWB + cb_); kb1[i_] = *reinterpret_cast<const bf16x8*>((KB) + (32 + r32) * C::KROWB + cb_); } while (0)
#define QKT(P0, P1, KB, k0) do { P0 = f32x16{}; P1 = f32x16{}; bf16x8 kb0[3], kb1[3]; \
    KLD(0, KB, 0); KLD(1, KB, 1); \
    _Pragma("unroll") for (int d0 = 0; d0 < ND; ++d0) { \
        if (d0 + 2 < ND) KLD((d0 + 2) % 3, KB, d0 + 2); \
        SBAR(); \
        const bf16x8 qf_ = (ROPE && d0 >= ND - 4) ? *reinterpret_cast<const bf16x8*>(qrope + (d0 - (ND - 4)) * 1024) : qr[d0]; \
        P0 = MFMA32(kb0[d0 % 3], qf_, P0); P1 = MFMA32(kb1[d0 % 3], qf_, P1); SBAR(); } \
    if (ALIBI) { const float kb_ = qposh - (float)(k0); \
        _Pragma("unroll") for (int r = 0; r < 16; ++r) { const float d_ = kb_ - (float)((r & 3) + 8 * (r >> 2)); P0[r] -= slope2 * fabsf(d_); P1[r] -= slope2 * fabsf(d_ - 32.f); } } } while (0)
    f32x16 pA0, pA1; float mnA, alA; bf16x8 pa0, pa1, pa2, pa3; int NT = seq / KVBLK; int jlo = 0;
    if (ALIBI) {
        float sq = 0.f;
#pragma unroll
        for (int d0 = 0; d0 < ND; ++d0) { const u32x4 w = __builtin_bit_cast(u32x4, qr[d0]);
#pragma unroll
            for (int q4 = 0; q4 < 4; ++q4) sq += bflo(w[q4]) * bflo(w[q4]) + bfhi(w[q4]) * bfhi(w[q4]); }
        sq += __shfl_xor(sq, 32);
#pragma unroll
        for (int o_ = 1; o_ < 32; o_ <<= 1) sq = fmaxf(sq, __shfl_xor(sq, o_));
        if (lane == 0) ws[63] = sq;
        __syncthreads();
        float qm = 0.f;
#pragma unroll
        for (int w_ = 0; w_ < NW; ++w_) qm = fmaxf(qm, ((const float*)(lds + 2 * C::SHM_V + 2 * C::SHM_K))[w_ * 64 + 63]);
        const float bound = 2.f * sqrtf(qm) * kmax * 1.01f + 40.f;
        const float dc = fminf(bound / slope2, 16384.f);
        const int dcut = (int)dc + 1;
        const int a_ = qpos0 - dcut; jlo = a_ > 0 ? (a_ >> 6) : 0;
        const int b_ = (qpos0 + QBLK * NW - 1 + dcut) >> 6; NT = b_ + 1 < NT ? b_ + 1 : NT;
    }
    const int nT = NT - jlo;
    SLOAD(0, jlo * KVBLK); SWAIT(); SWRITE(0, 0);
    if (1 < nT) SLOAD(SD - 1, (jlo + 1) * KVBLK);
    if (SD == 2 && 2 < nT) SLOAD(0, (jlo + 2) * KVBLK);
    __syncthreads();
#define STG(t, P) do { if ((t) + 1 < nT) { if (SD == 1) SWAIT(); SWRITE((SD == 2 ? (P) : 0), (P)); } if ((t) + 1 + SD < nT) SLOAD((SD == 2 ? (P) : 0), (jlo + (t) + 1 + SD) * KVBLK); } while (0)
#define H1(t, B) do { SBAR(); QKT(pA0, pA1, K_lds + (B) * C::SHM_K, (jlo + (t)) * KVBLK); partialSM(pA0, pA1, m_reg, mnA, alA); RESC(alA); } while (0)
#define H2(t, B) do { finishSM(pA0, pA1, alA, l_reg, pa0, pa1, pa2, pa3); SBAR(); pv_d0(o, vb0 + (B) * C::SHM_V, pa0, pa1, pa2, pa3); } while (0)
    if (__builtin_amdgcn_readfirstlane(wid) < 4) {
        int t = 0;
#pragma unroll 1
        for (; t + 1 < nT; t += 2) { H1(t, 0); __syncthreads(); STG(t, 1); H2(t, 0); __syncthreads(); H1(t + 1, 1); __syncthreads(); STG(t + 1, 0); H2(t + 1, 1); __syncthreads(); }
        if (t < nT) { H1(t, 0); __syncthreads(); STG(t, 1); H2(t, 0); __syncthreads(); }
        __syncthreads();
    } else {
        __syncthreads();
        int t = 0;
#pragma unroll 1
        for (; t + 1 < nT; t += 2) { STG(t, 1); H1(t, 0); __syncthreads(); H2(t, 0); __syncthreads(); STG(t + 1, 0); H1(t + 1, 1); __syncthreads(); H2(t + 1, 1); __syncthreads(); }
        if (t < nT) { STG(t, 1); H1(t, 0); __syncthreads(); H2(t, 0); __syncthreads(); }
    }
#undef STG
#undef H1
#undef H2
    if (hi == 0) li_l[r32] = l_reg; asm volatile("s_waitcnt lgkmcnt(0)" ::: "memory");
    float rli[16];
#pragma unroll
    for (int r = 0; r < 16; ++r) rli[r] = __builtin_amdgcn_rcpf(li_l[crow(r, hi)]);
    bf16* Ow = Ob + (long)(wid * QBLK) * ldo;
#pragma unroll
    for (int r = 0; r < 16; ++r) { const int orow = crow(r, hi);
#pragma unroll
        for (int d0 = 0; d0 < 4; ++d0) Ow[(long)orow * ldo + d0 * 32 + r32] = f2bf(o[d0][r] * rli[r]); }
    __syncthreads();
#undef SLOAD
#undef SWRITE
#undef SWAIT
#undef RESC
#undef QKT
#undef KLD
}
#undef SBAR
}

#define XB_TMO      128
#define XB_XCNT(j)  (256  + 64 * (j))
#define XB_XSUB(j)  (1280 + 64 * (j))
#define XB_XGEN(j)  (2304 + 64 * (j))
#define XB_TOP      3328
#define XB_TOPGEN   3392
#define XCD_BAR_WORDS 3456
#define XB_SPIN_CAP (1u << 18)
DI unsigned xb_ld(unsigned* p)              { return __hip_atomic_load(p, __ATOMIC_RELAXED, __HIP_MEMORY_SCOPE_AGENT); }
DI unsigned xb_add(unsigned* p, unsigned v) { return __hip_atomic_fetch_add(p, v, __ATOMIC_RELAXED, __HIP_MEMORY_SCOPE_AGENT); }
DI unsigned xb_xcc_id() { return (unsigned)__builtin_amdgcn_s_getreg((3 << 11) | 20) & 0xFu; }
#define XB_SPIN(cond, bar) do { unsigned _sp = 0; while (cond) { __builtin_amdgcn_s_sleep(1); \
    if ((++_sp & 255u) == 0u) { if (xb_ld(&(bar)[XB_TMO])) break; if (_sp > XB_SPIN_CAP) { atomicAdd(&(bar)[XB_TMO], 1u); break; } } } } while (0)
struct XcdBarrier { unsigned* bar; unsigned x; volatile LAS unsigned* st; };
DI XcdBarrier xcd_barrier_post(unsigned* bar, volatile LAS unsigned* st) {
    XcdBarrier b; b.bar = bar; b.x = xb_xcc_id(); b.st = st;
    if (threadIdx.x == 0) (void)xb_add(&bar[XB_XCNT(b.x)], 1u);
    return b;
}
DI void xcd_barrier_complete(unsigned* bar, unsigned x, unsigned& nloc, unsigned& nx) {
    const unsigned G = gridDim.x * gridDim.y * gridDim.z;
    unsigned sum, cnt, mine, sp = 0u;
    for (;;) {
        sum = 0u; cnt = 0u; mine = 0u;
#pragma unroll
        for (unsigned j = 0; j < 16; ++j) { const unsigned c = xb_ld(&bar[XB_XCNT(j)]); sum += c; cnt += (c > 0u) ? 1u : 0u; mine = (j == x) ? c : mine; }
        if (sum == G) break;
        __builtin_amdgcn_s_sleep(1);
        if ((++sp & 255u) == 0u) { if (xb_ld(&bar[XB_TMO])) break; if (sp > XB_SPIN_CAP) { atomicAdd(&bar[XB_TMO], 1u); break; } }
    }
    nloc = mine > 0u ? mine : 1u; nx = cnt > 0u ? cnt : 1u;
}
DI void xcd_barrier(const XcdBarrier& b) {
    asm volatile("s_waitcnt vmcnt(0)" ::: "memory");
    __syncthreads();
    if (threadIdx.x == 0) {
        unsigned* bar = b.bar;
        __builtin_amdgcn_s_waitcnt(0);
        unsigned nloc = b.st[0], nx = b.st[1];
        if (nloc == 0u) { xcd_barrier_complete(bar, b.x, nloc, nx); b.st[0] = nloc; b.st[1] = nx; }
        const unsigned old = xb_add(&bar[XB_XSUB(b.x)], 1u);
        const unsigned gen = old / nloc;
        if (old + 1u == (gen + 1u) * nloc) {
            __builtin_amdgcn_fence(__ATOMIC_RELEASE, "agent");
            asm volatile("s_waitcnt vmcnt(0)" ::: "memory");
            const unsigned og = xb_add(&bar[XB_TOP], 1u);
            const unsigned tg = og / nx;
            if (og + 1u == (tg + 1u) * nx) xb_add(&bar[XB_TOPGEN], 1u);
            else XB_SPIN(xb_ld(&bar[XB_TOPGEN]) == tg, bar);
            __builtin_amdgcn_fence(__ATOMIC_ACQUIRE, "agent");
            xb_add(&bar[XB_XGEN(b.x)], 1u);
            asm volatile("s_waitcnt vmcnt(0)" ::: "memory");
        } else {
            XB_SPIN(xb_ld(&bar[XB_XGEN(b.x)]) == gen, bar);
            __builtin_amdgcn_fence(__ATOMIC_ACQUIRE, "agent");
            asm volatile("s_waitcnt vmcnt(0)" ::: "memory");
        }
    }
    __syncthreads();
}

constexpr int LDS_BYTES = 163840;
constexpr int LDSCTL_OFF = LDS_BYTES - 1024, MISC_OFF = LDSCTL_OFF + 320;

struct Ctx { LAS unsigned char* lds; int tid, lane, wave, G, bx, gw, NGW; };

enum { MAP_ID = 0, MAP_ROPEQ = 1, MAP_FFNUP = 2 };
DI int map_row(int kind, int n) {
    if (kind == MAP_ROPEQ) { const int h = n / 192, r = n % 192; if (r < 128) return n; const int i = r - 128; return h * 192 + 128 + ((i < 32) ? 2 * i : 2 * (i - 32) + 1); }
    if (kind == MAP_FFNUP) { if (n < FFN_H) return (n >> 7) * 256 + (n & 127); const int c = n - FFN_H; return (c >> 7) * 256 + 128 + (c & 127); }
    return n;
}
DI void transpose_item(const float* W, int K, int N, bf16* WT, int kind, int row_off, const float* kscale, LAS float* scr, int item, int lane) {
    const int nblk = N / 32, kb = item / nblk, nb = item % nblk, k0 = 64 * kb, n0 = 32 * nb;
#pragma unroll 8
    for (int i = 0; i < 32; ++i) { const int kk = 2 * i + (lane >> 5); const float sc_ = kscale ? kscale[k0 + kk] : 1.f; scr[kk * 33 + (lane & 31)] = W[(size_t)(k0 + kk) * N + n0 + (lane & 31)] * sc_; }
    asm volatile("s_waitcnt lgkmcnt(0)" ::: "memory");
    const int c = lane & 7;
#pragma unroll
    for (int j = 0; j < 4; ++j) { const int n = (lane >> 3) + 8 * j; const LAS float* s = scr + (8 * c) * 33 + n;
        u32x4 o; o.x = pk2(s[0 * 33], s[1 * 33]); o.y = pk2(s[2 * 33], s[3 * 33]); o.z = pk2(s[4 * 33], s[5 * 33]); o.w = pk2(s[6 * 33], s[7 * 33]);
        *(u32x4*)(WT + (size_t)(row_off + map_row(kind, n0 + n)) * K + k0 + 8 * c) = o; }
    asm volatile("s_waitcnt lgkmcnt(0)" ::: "memory");
}
struct TJob { const float* W; int K, N; bf16* WT; int kind, row_off; const float* kscale; };
template <int NJ> DI void run_transposes(const Ctx& c, const TJob (&jobs)[NJ]) {
    LAS float* scr = (LAS float*)(c.lds + c.wave * 16384);
    int total = 0;
#pragma unroll
    for (int j = 0; j < NJ; ++j) total += (jobs[j].K / 64) * (jobs[j].N / 32);
    for (int it = c.gw; it < total; it += c.NGW) {
        int r = it;
#pragma unroll
        for (int j = 0; j < NJ; ++j) { const int n = (jobs[j].K / 64) * (jobs[j].N / 32);
            if (r >= 0 && r < n) transpose_item(jobs[j].W, jobs[j].K, jobs[j].N, jobs[j].WT, jobs[j].kind, jobs[j].row_off, jobs[j].kscale, scr, r, c.lane);
            r -= n; }
    }
}
DI void zero_rows(const Ctx& c, bf16* WT, int K, int row0, int nrows) {
    for (int r = c.gw; r < nrows; r += c.NGW) { u32x4* p = (u32x4*)(WT + (size_t)(row0 + r) * K);
        for (int i = c.lane; i < K / 8; i += 64) p[i] = (u32x4){0u, 0u, 0u, 0u}; }
}

DI void load_row_f32(const float* row, int lane, f32x4 (&v)[4]) {
#pragma unroll
    for (int j = 0; j < 4; ++j) v[j] = *((const f32x4*)row + lane + 64 * j);
}
DI void load_row_bf16(const bf16* row, int lane, f32x4 (&v)[4]) {
#pragma unroll
    for (int j = 0; j < 4; ++j) { const u32x2 w = *((const u32x2*)row + lane + 64 * j); v[j] = (f32x4){bflo(w.x), bfhi(w.x), bflo(w.y), bfhi(w.y)}; }
}
DI void store_row_bf16(bf16* row, int lane, const f32x4 (&v)[4]) {
#pragma unroll
    for (int j = 0; j < 4; ++j) { u32x2 w; w.x = pk2(v[j][0], v[j][1]); w.y = pk2(v[j][2], v[j][3]); *((u32x2*)row + lane + 64 * j) = w; }
}
DI float sumsq4(const f32x4 (&v)[4]) { float s = 0.f;
#pragma unroll
    for (int j = 0; j < 4; ++j) s += (v[j][0] * v[j][0] + v[j][1] * v[j][1]) + (v[j][2] * v[j][2] + v[j][3] * v[j][3]);
    return s; }
DI void pass_first(const Ctx& c, const float* x, bf16* HB, float* RSTD) {
    for (int m = c.gw; m < MROWS; m += c.NGW) {
        f32x4 v[4]; load_row_f32(x + (size_t)m * DM, c.lane, v);
        const float ss = wave_sum(sumsq4(v));
        store_row_bf16(HB + (size_t)m * DM, c.lane, v);
        if (c.lane == 0) RSTD[m] = rsqrtf(ss * (1.f / DM) + EPS);
    }
}
DI void pass_res(const Ctx& c, const bf16* a, const float* g1, bf16* HB, float* RSTD) {
    f32x4 g1v[4]; load_row_f32(g1, c.lane, g1v);
    for (int m = c.gw; m < MROWS; m += c.NGW) {
        f32x4 v[4], b[4]; load_row_bf16(a + (size_t)m * DM, c.lane, v); load_row_bf16(HB + (size_t)m * DM, c.lane, b);
        const float rstd = rsqrtf(wave_sum(sumsq4(v)) * (1.f / DM) + EPS);
#pragma unroll
        for (int j = 0; j < 4; ++j) b[j] = b[j] + v[j] * rstd * g1v[j];
        const float ss = wave_sum(sumsq4(b));
        store_row_bf16(HB + (size_t)m * DM, c.lane, b);
        if (c.lane == 0) RSTD[m] = rsqrtf(ss * (1.f / DM) + EPS);
    }
}
DI void pass_final(const Ctx& c, float* out, const float* g1, const bf16* HB) {
    f32x4 g1v[4]; load_row_f32(g1, c.lane, g1v);
    for (int m = c.gw; m < MROWS; m += c.NGW) {
        f32x4 v[4], b[4]; load_row_f32(out + (size_t)m * DM, c.lane, v); load_row_bf16(HB + (size_t)m * DM, c.lane, b);
        const float rstd = rsqrtf(wave_sum(sumsq4(v)) * (1.f / DM) + EPS);
#pragma unroll
        for (int j = 0; j < 4; ++j) { b[j] = b[j] + v[j] * rstd * g1v[j]; *((f32x4*)(out + (size_t)m * DM) + c.lane + 64 * j) = b[j]; }
    }
}

__device__ const double ROPE_INV[32] = {
    1.0, 0.7498942093324559, 0.5623413251903491, 0.4216965034285822, 0.31622776601683794, 0.23713737056616552, 0.1778279410038923, 0.1333521432163324,
    0.1, 0.07498942093324558, 0.05623413251903491, 0.042169650342858224, 0.03162277660168379, 0.023713737056616554, 0.01778279410038923, 0.01333521432163324,
    0.01, 0.007498942093324558, 0.005623413251903491, 0.004216965034285823, 0.0031622776601683794, 0.0023713737056616554, 0.0017782794100389228, 0.001333521432163324,
    0.001, 0.0007498942093324559, 0.0005623413251903491, 0.00042169650342858224, 0.00031622776601683794, 0.00023713737056616554, 0.00017782794100389227, 0.0001333521432163324};
DI void fill_rope(const Ctx& c, float* rope) {
    for (int i = c.bx * NTHREADS + c.tid; i < SEQ * 32; i += c.G * NTHREADS) {
        const int pos = i >> 5, k = i & 31;
        const double t = (double)pos * ROPE_INV[k] * 0.15915494309189535;
        const float fr = (float)(t - (double)(long long)t);
        rope[2 * i] = __builtin_amdgcn_cosf(fr); rope[2 * i + 1] = __builtin_amdgcn_sinf(fr);
    }
}
DI void pass_mla_mid(const Ctx& c, const bf16* DQKV, const float* gq, const float* gkv, const float* rope, bf16* CQ, bf16* CKV, bf16* KF) {
    float gqv[6], gkvv[4];
#pragma unroll
    for (int i = 0; i < 6; ++i) gqv[i] = gq[c.lane + 64 * i];
#pragma unroll
    for (int i = 0; i < 4; ++i) gkvv[i] = gkv[c.lane + 64 * i];
    for (int m = c.gw; m < MROWS; m += c.NGW) {
        const bf16* row = DQKV + (size_t)m * 768;
        float xq[6], xk[4]; float sq = 0.f, sk = 0.f;
#pragma unroll
        for (int i = 0; i < 6; ++i) { xq[i] = bf2f(row[c.lane + 64 * i]); sq += xq[i] * xq[i]; }
#pragma unroll
        for (int i = 0; i < 4; ++i) { xk[i] = bf2f(row[384 + c.lane + 64 * i]); sk += xk[i] * xk[i]; }
        const float rq = rsqrtf(wave_sum(sq) * (1.f / 384.f) + EPS), rk = rsqrtf(wave_sum(sk) * (1.f / 256.f) + EPS);
#pragma unroll
        for (int i = 0; i < 6; ++i) CQ[(size_t)m * 384 + c.lane + 64 * i] = f2bf(xq[i] * rq * gqv[i]);
#pragma unroll
        for (int i = 0; i < 4; ++i) CKV[(size_t)m * 256 + c.lane + 64 * i] = f2bf(xk[i] * rk * gkvv[i]);
        const int i = c.lane & 31; const float x1 = bf2f(row[640 + i]), x2 = bf2f(row[672 + i]);
        const float* rp = rope + ((size_t)(m & (SEQ - 1)) * 32 + i) * 2; const float cs = rp[0], sn = rp[1];
        const float ov = (c.lane < 32) ? (x1 * cs - x2 * sn) : (x1 * sn + x2 * cs);
        const bf16 ob = f2bf(ov); const int idx = 2 * i + (c.lane >> 5);
#pragma unroll
        for (int h = 0; h < 8; ++h) KF[(size_t)m * 1536 + h * 192 + 128 + idx] = ob;
    }
}
constexpr int CW_KMAX = 8192, CW_QCTR = 8448;
DI void pass_kmax(const Ctx& c, const bf16* Kd, unsigned* ctl) {
    LAS float* red = (LAS float*)c.lds;
    for (int rb = c.bx; rb < MROWS / 128; rb += c.G) {
        float mx = 0.f;
        for (int i = 0; i < 16; ++i) {
            const bf16* row = Kd + (size_t)(rb * 128 + c.wave * 16 + i) * 1024 + 16 * c.lane;
            const u32x4 a = *(const u32x4*)row, b = *(const u32x4*)(row + 8);
            float s = 0.f;
#pragma unroll
            for (int q = 0; q < 4; ++q) s += bflo(a[q]) * bflo(a[q]) + bfhi(a[q]) * bfhi(a[q]) + bflo(b[q]) * bflo(b[q]) + bfhi(b[q]) * bfhi(b[q]);
            s += __shfl_xor(s, 1); s += __shfl_xor(s, 2);
            mx = fmaxf(mx, s);
        }
        __syncthreads();
        if ((c.lane & 3) == 0) red[c.wave * 16 + (c.lane >> 2)] = mx;
        __syncthreads();
        if (c.tid < 16) { float m = 0.f;
#pragma unroll
            for (int w = 0; w < NWAVES; ++w) m = fmaxf(m, red[w * 16 + c.tid]);
            atomicMax(ctl + CW_KMAX + ((rb * 128) / SEQ) * 16 + c.tid, __float_as_uint(sqrtf(m))); }
    }
}
template <int DQK, bool ALIBI, bool ROPE, int ldq, int qhs, int ldk, int khs, int ldv, int vhs, int vdiv, int ldo, int ohs, int nheads>
DI void attention_phase(const Ctx& c, const bf16* Q, const bf16* K, const bf16* V, bf16* O, const float* rope, unsigned* ctl) {
    constexpr int NU = BATCH * nheads * 32;
    if (!ALIBI) {
        for (int u = c.bx; u < NU; u += c.G) {
            const int xcd = u & 7, slot = (u >> 3) & 31, rnd = u >> 8, bh = xcd + 8 * rnd, qb = slot;
            const int b = bh / nheads, h = bh % nheads;
            const size_t row0 = (size_t)b * SEQ;
            att::attn_unit<DQK, ALIBI, ROPE, ldq, ldk, ldv, ldo>(Q + (row0 + qb * 256) * ldq + h * qhs, K + row0 * ldk + h * khs, V + row0 * ldv + (h / vdiv) * vhs,
                                       O + (row0 + qb * 256) * ldo + h * ohs, SEQ, 0.f, qb * 256, rope, (char*)c.lds, c.tid, 0.f);
        }
    } else {
        volatile LAS unsigned* qw = (volatile LAS unsigned*)(c.lds + LDSCTL_OFF);
        for (;;) {
            if (c.tid == 0) qw[0] = __hip_atomic_fetch_add(ctl + CW_QCTR, 1u, __ATOMIC_RELAXED, __HIP_MEMORY_SCOPE_AGENT);
            __syncthreads();
            const int u = (int)qw[0];
            __syncthreads();
            if (u >= NU) break;
            const int hh = 7 - (u >> 8), r = u & 255, b = r >> 6, sub = (r >> 5) & 1, qb = r & 31, h = 2 * hh + sub;
            const size_t row0 = (size_t)b * SEQ;
            const float slope2 = exp2f(-(float)(hh + 1)) * LOG2E;
            const float kmax = __uint_as_float(__hip_atomic_load(ctl + CW_KMAX + b * 16 + h, __ATOMIC_RELAXED, __HIP_MEMORY_SCOPE_AGENT));
            att::attn_unit<DQK, ALIBI, ROPE, ldq, ldk, ldv, ldo>(Q + (row0 + qb * 256) * ldq + h * qhs, K + row0 * ldk + h * khs, V + row0 * ldv + (h / vdiv) * vhs,
                                       O + (row0 + qb * 256) * ldo + h * ohs, SEQ, slope2, qb * 256, rope, (char*)c.lds, c.tid, kmax);
        }
    }
}

DI void pass_diff_combine(const Ctx& c, const bf16* OS, const float* lamp, const float* subg, bf16* OC) {
    const float lam_init = 0.8f - 0.6f * expf(-0.3f * 1.0f);
    const float sa = wave_sum(lamp[c.lane] * lamp[64 + c.lane]), sb = wave_sum(lamp[128 + c.lane] * lamp[192 + c.lane]);
    const float lam = expf(sa) - expf(sb) + lam_init;
    const int h = c.lane >> 3, e0 = (c.lane & 7) * 16;
    float gv[16];
#pragma unroll
    for (int i = 0; i < 16; ++i) gv[i] = subg[e0 + i] * (1.f - lam_init);
    for (int m = c.gw; m < MROWS; m += c.NGW) {
        const bf16* r1 = OS + (size_t)m * 2048 + (2 * h) * 128 + e0; const bf16* r2 = r1 + 128;
        const u32x4 a0 = *(const u32x4*)r1, a1 = *(const u32x4*)(r1 + 8), b0 = *(const u32x4*)r2, b1 = *(const u32x4*)(r2 + 8);
        float o[16]; float ss = 0.f;
#pragma unroll
        for (int i = 0; i < 4; ++i) { o[2 * i] = bflo(a0[i]) - lam * bflo(b0[i]); o[2 * i + 1] = bfhi(a0[i]) - lam * bfhi(b0[i]);
            o[8 + 2 * i] = bflo(a1[i]) - lam * bflo(b1[i]); o[8 + 2 * i + 1] = bfhi(a1[i]) - lam * bfhi(b1[i]); }
#pragma unroll
        for (int i = 0; i < 16; ++i) ss += o[i] * o[i];
        ss += __shfl_xor(ss, 1); ss += __shfl_xor(ss, 2); ss += __shfl_xor(ss, 4);
        const float rstd = rsqrtf(ss * (1.f / 128.f) + EPS);
        u32x4 w0, w1;
#pragma unroll
        for (int i = 0; i < 4; ++i) { w0[i] = pk2(o[2 * i] * rstd * gv[2 * i], o[2 * i + 1] * rstd * gv[2 * i + 1]); w1[i] = pk2(o[8 + 2 * i] * rstd * gv[8 + 2 * i], o[8 + 2 * i + 1] * rstd * gv[8 + 2 * i + 1]); }
        bf16* op = OC + (size_t)m * 1024 + h * 128 + e0; *(u32x4*)op = w0; *(u32x4*)(op + 8) = w1;
    }
}

DI float gelu_tanh(float x) { const float z = 0.7978845608028654f * (x + 0.044715f * x * x * x); return x * frcp(1.f + fexp(-2.f * z)); }
DI void pass_conv(const Ctx& c, bf16* U, const bf16* HALO, const float* cw, const float* cb) {
    const int NSTRIP = MROWS / 16;
    for (int s = c.gw; s < NSTRIP; s += c.NGW) {
        const int t0 = s * 16; const bool first = (t0 & (SEQ - 1)) == 0, lastst = ((t0 + 16) & (SEQ - 1)) == 0;
#pragma unroll 1
        for (int it = 0; it < 11; ++it) {
            const int cc = c.lane + 64 * it, ch = 4 * cc, gcol = (ch >> 7) * 256 + (ch & 127);
            u32x2 ug[18], uv[18];
            { const bf16* hp = HALO + ((size_t)(first ? s : s - 1) * 2 + 1) * FFN_U + gcol; ug[0] = *(const u32x2*)hp; uv[0] = *(const u32x2*)(hp + 128); }
#pragma unroll
            for (int r = 0; r < 16; ++r) { const bf16* up = U + (size_t)(t0 + r) * FFN_U + gcol; ug[r + 1] = *(const u32x2*)up; uv[r + 1] = *(const u32x2*)(up + 128); }
            { const bf16* hp = HALO + ((size_t)(lastst ? s : s + 1) * 2) * FFN_U + gcol; ug[17] = *(const u32x2*)hp; uv[17] = *(const u32x2*)(hp + 128); }
            if (first) { ug[0] = (u32x2){0u, 0u}; uv[0] = ug[0]; }
            if (lastst) { ug[17] = (u32x2){0u, 0u}; uv[17] = ug[17]; }
            const f32x4 wg0 = *(const f32x4*)(cw + ch), wg1 = *(const f32x4*)(cw + FFN_U + ch), wg2 = *(const f32x4*)(cw + 2 * FFN_U + ch), bg = *(const f32x4*)(cb + ch);
            const f32x4 wv0 = *(const f32x4*)(cw + FFN_H + ch), wv1 = *(const f32x4*)(cw + FFN_U + FFN_H + ch), wv2 = *(const f32x4*)(cw + 2 * FFN_U + FFN_H + ch), bv = *(const f32x4*)(cb + FFN_H + ch);
#pragma unroll
            for (int r = 0; r < 16; ++r) {
                const u32x2 pg = ug[r], cg = ug[r + 1], ng = ug[r + 2], pv = uv[r], cv = uv[r + 1], nv = uv[r + 2];
                f32x4 g_, v_;
                g_[0] = bg[0] + wg0[0] * bflo(pg.x) + wg1[0] * bflo(cg.x) + wg2[0] * bflo(ng.x); g_[1] = bg[1] + wg0[1] * bfhi(pg.x) + wg1[1] * bfhi(cg.x) + wg2[1] * bfhi(ng.x);
                g_[2] = bg[2] + wg0[2] * bflo(pg.y) + wg1[2] * bflo(cg.y) + wg2[2] * bflo(ng.y); g_[3] = bg[3] + wg0[3] * bfhi(pg.y) + wg1[3] * bfhi(cg.y) + wg2[3] * bfhi(ng.y);
                v_[0] = bv[0] + wv0[0] * bflo(pv.x) + wv1[0] * bflo(cv.x) + wv2[0] * bflo(nv.x); v_[1] = bv[1] + wv0[1] * bfhi(pv.x) + wv1[1] * bfhi(cv.x) + wv2[1] * bfhi(nv.x);
                v_[2] = bv[2] + wv0[2] * bflo(pv.y) + wv1[2] * bflo(cv.y) + wv2[2] * bflo(nv.y); v_[3] = bv[3] + wv0[3] * bfhi(pv.y) + wv1[3] * bfhi(cv.y) + wv2[3] * bfhi(nv.y);
                u32x2 o; o.x = pk2(gelu_tanh(g_[0]) * v_[0], gelu_tanh(g_[1]) * v_[1]); o.y = pk2(gelu_tanh(g_[2]) * v_[2], gelu_tanh(g_[3]) * v_[3]);
                *(u32x2*)(U + (size_t)(t0 + r) * FFN_U + gcol) = o;
            }
        }
    }
}

constexpr int ML_CH = 128, ML_NC = SEQ / ML_CH, ML_H = 8, ML_DK = 64, ML_DV = 128, ML_EX = 160;
constexpr int ML_LDK = 72, ML_LDT = 96, ML_LDV = 160, ML_LDP = 136;
struct MlLds { LAS bf16* kA; LAS bf16* kB; LAS bf16* vx; LAS bf16* P; LAS bf16* Cs; LAS float* sc; };
DI void ml_gates(const Ctx& c, const float* gates, int row0, int h, LAS float* sc) {
    if (c.tid < 128) { const float* g = gates + (size_t)(row0 + c.tid) * 32 + h;
        sc[c.tid] = g[0]; sc[128 + c.tid] = log_sigmoid_(g[8]); sc[256 + c.tid] = g[16]; sc[384 + c.tid] = log_sigmoid_(g[24]); }
    __syncthreads();
    if (c.tid == 0) { float a = 0.f;
#pragma unroll 4
        for (int t = 0; t < 128; ++t) { a += sc[128 + t]; sc[512 + t] = a; } }
    if (c.tid == 64) { float a = 0.f;
#pragma unroll 4
        for (int t = 127; t >= 0; --t) { a += sc[384 + t]; sc[640 + t] = a; } }
    __syncthreads();
}
DI void ml_load_v(const Ctx& c, const bf16* v, int row0, int h, LAS bf16* vx) {
#pragma unroll
    for (int i = 0; i < 4; ++i) { const int ch = c.tid + 512 * i, r = ch >> 4, cc = (ch & 15) * 8;
        *(LAS u32x4*)(vx + r * ML_LDV + cc) = *(const u32x4*)(v + (size_t)(row0 + r) * 1024 + h * 128 + cc); }
    if (c.tid < 128) { LAS bf16* p = vx + c.tid * ML_LDV + 128;
        *(LAS u32x4*)p = (u32x4){0x00003f80u, 0u, 0u, 0u}; *(LAS u32x4*)(p + 8) = (u32x4){0u, 0u, 0u, 0u}; *(LAS u32x4*)(p + 16) = (u32x4){0u, 0u, 0u, 0u}; *(LAS u32x4*)(p + 24) = (u32x4){0u, 0u, 0u, 0u}; }
}
DI void ml_phase1(const Ctx& c, const bf16* k, const bf16* v, const float* gates, bf16* ST, float* DEC) {
    LAS bf16* kA = (LAS bf16*)c.lds; LAS bf16* kB = kA + 128 * ML_LDT; LAS bf16* vx = kB + 128 * ML_LDT; LAS float* sc = (LAS float*)(vx + 128 * ML_LDV);
    const int NU = BATCH * ML_H * ML_NC;
    for (int u = c.bx; u < NU; u += c.G) {
        const int ck = u % ML_NC, h = (u / ML_NC) % ML_H, b = u / (ML_NC * ML_H); const int row0 = b * SEQ + ck * ML_CH;
        ml_gates(c, gates, row0, h, sc);
        const float bl = sc[512 + 127], B0 = sc[640];
#pragma unroll
        for (int i = 0; i < 2; ++i) { const int ch = c.tid + 512 * i, r = ch >> 3, cc = (ch & 7) * 8;
            const u32x4 w = *(const u32x4*)(k + (size_t)(row0 + r) * 512 + h * 64 + cc);
            const float wF = fexp(bl - sc[512 + r] + sc[r]), wB = fexp(B0 - sc[640 + r] + sc[256 + r]);
            u32x4 a, bb;
#pragma unroll
            for (int q = 0; q < 4; ++q) { a[q] = pk2(bflo(w[q]) * wF, bfhi(w[q]) * wF); bb[q] = pk2(bflo(w[q]) * wB, bfhi(w[q]) * wB); }
            *(LAS u32x4*)(kA + r * ML_LDT + cc) = a; *(LAS u32x4*)(kB + r * ML_LDT + cc) = bb; }
        ml_load_v(c, v, row0, h, vx);
        __syncthreads();
#pragma unroll 1
        for (int id = c.wave; id < 20; id += 8) {
            const int dir = id / 10, rem = id % 10, db = rem / 5, eb = rem % 5;
            const LAS bf16* kw = dir ? kB : kA;
            f32x16 acc = {};
#pragma unroll 2
            for (int ks = 0; ks < 8; ++ks) acc = MFMA32(frag_tr(kw, ML_LDT, 16 * ks, 32 * db, c.lane), frag_tr(vx, ML_LDV, 16 * ks, 32 * eb, c.lane), acc);
            bf16* dst = ST + ((size_t)((b * ML_H + h) * 2 + dir) * ML_NC + ck) * (ML_DK * ML_EX);
            const int n = c.lane & 31, hi = c.lane >> 5;
#pragma unroll
            for (int r = 0; r < 16; ++r) dst[(32 * db + crow(r, hi)) * ML_EX + 32 * eb + n] = f2bf(acc[r]);
        }
        if (c.tid == 0) { float* d = DEC + (size_t)((b * ML_H + h) * 2) * ML_NC + ck; d[0] = fexp(bl); d[ML_NC] = fexp(B0); }
        __syncthreads();
    }
}
DI void ml_phase2(const Ctx& c, bf16* ST, const float* DEC) {
    constexpr int NG = ML_DK * ML_EX / 8;
    const int NTASK = BATCH * ML_H * 2 * NG;
    for (int t = c.bx * NTHREADS + c.tid; t < NTASK; t += c.G * NTHREADS) {
        const int g = t % NG, chain = t / NG, dir = chain & 1;
        bf16* base = ST + (size_t)chain * ML_NC * (ML_DK * ML_EX) + g * 8; const float* dec = DEC + (size_t)chain * ML_NC;
        float carry[8];
#pragma unroll
        for (int i = 0; i < 8; ++i) carry[i] = 0.f;
        for (int s = 0; s < ML_NC; ++s) {
            const int ck = dir ? (ML_NC - 1 - s) : s;
            u32x4* p = (u32x4*)(base + (size_t)ck * (ML_DK * ML_EX)); const u32x4 a = *p; const float d = dec[ck];
            u32x4 o;
#pragma unroll
            for (int q = 0; q < 4; ++q) { o[q] = pk2(carry[2 * q], carry[2 * q + 1]); carry[2 * q] = d * carry[2 * q] + bflo(a[q]); carry[2 * q + 1] = d * carry[2 * q + 1] + bfhi(a[q]); }
            *p = o;
        }
    }
}
DI void ml_phase3(const Ctx& c, const bf16* q, const bf16* k, const bf16* v, const bf16* og, const float* gates, const bf16* ST, const float* ng, bf16* Z) {
    LAS bf16* kl = (LAS bf16*)c.lds; LAS bf16* vx = kl + 128 * ML_LDK; LAS bf16* P = vx + 128 * ML_LDV; LAS bf16* Cs = P + 128 * ML_LDP; LAS float* sc = (LAS float*)(Cs + 64 * ML_LDV);
    LAS bf16* hb = P;
    const int NU = BATCH * ML_H * ML_NC;
    const int n = c.lane & 31, hi = c.lane >> 5, tb = c.wave & 3, wg2 = c.wave >> 2;
    for (int u = c.bx; u < NU; u += c.G) {
        const int ck = u % ML_NC, h = (u / ML_NC) % ML_H, b = u / (ML_NC * ML_H); const int row0 = b * SEQ + ck * ML_CH;
        ml_gates(c, gates, row0, h, sc);
#pragma unroll
        for (int i = 0; i < 2; ++i) { const int ch = c.tid + 512 * i, r = ch >> 3, cc = (ch & 7) * 8;
            *(LAS u32x4*)(kl + r * ML_LDK + cc) = *(const u32x4*)(k + (size_t)(row0 + r) * 512 + h * 64 + cc); }
        ml_load_v(c, v, row0, h, vx);
        const bf16* qg = q + (size_t)row0 * 512 + h * 64;
        bf16x8 qf[4];
#pragma unroll
        for (int kd = 0; kd < 4; ++kd) qf[kd] = gfrag_row(qg, 512, 32 * tb, 16 * kd, c.lane);
        f32x16 hs[2] = {};
#pragma unroll 1
        for (int dir = 0; dir < 2; ++dir) {
            const bf16* st = ST + ((size_t)((b * ML_H + h) * 2 + dir) * ML_NC + ck) * (ML_DK * ML_EX);
            for (int ch = c.tid; ch < 64 * 20; ch += NTHREADS) { const int r = ch / 20, cc = (ch % 20) * 8; *(LAS u32x4*)(Cs + r * ML_LDV + cc) = *(const u32x4*)(st + r * ML_EX + cc); }
            __syncthreads();
            const int ioff = dir ? 256 : 0, boff = dir ? 640 : 512;
            const float bt = sc[boff + 32 * tb + n];
#pragma unroll 1
            for (int sb2 = 0; sb2 < 2; ++sb2) {
                const int sb = 2 * wg2 + sb2;
                f32x16 a = {};
#pragma unroll
                for (int kd = 0; kd < 4; ++kd) a = MFMA32(frag_row(kl, ML_LDK, 32 * sb, 16 * kd, c.lane), qf[kd], a);
                const int t = 32 * tb + n;
#pragma unroll
                for (int g4 = 0; g4 < 4; ++g4) {
                    const int s0 = 32 * sb + 8 * g4 + 4 * hi;
                    float w[4];
#pragma unroll
                    for (int j = 0; j < 4; ++j) { const int s = s0 + j; const bool keep = dir ? (s >= t) : (s <= t);
                        const float e = fexp(fminf(bt - sc[boff + s], 0.f) + sc[ioff + s]); w[j] = keep ? a[4 * g4 + j] * e : 0.f; }
                    u32x2 o; o.x = pk2(w[0], w[1]); o.y = pk2(w[2], w[3]);
                    *(LAS u32x2*)(P + t * ML_LDP + s0) = o;
                }
            }
            __syncthreads();
            f32x16 acc[3] = {}, aci[3] = {};
#pragma unroll 2
            for (int ks = 0; ks < 8; ++ks) { const bf16x8 A = frag_row(P, ML_LDP, 32 * tb, 16 * ks, c.lane);
#pragma unroll
                for (int e = 0; e < 3; ++e) { const int et = (e == 2) ? 4 : 2 * wg2 + e; acc[e] = MFMA32(A, frag_tr(vx, ML_LDV, 16 * ks, 32 * et, c.lane), acc[e]); } }
#pragma unroll
            for (int kd = 0; kd < 4; ++kd) {
#pragma unroll
                for (int e = 0; e < 3; ++e) { const int et = (e == 2) ? 4 : 2 * wg2 + e; aci[e] = MFMA32(qf[kd], frag_tr(Cs, ML_LDV, 16 * kd, 32 * et, c.lane), aci[e]); } }
#pragma unroll
            for (int r = 0; r < 16; ++r) {
                const float eb_ = fexp(sc[boff + 32 * tb + crow(r, hi)]);
                const float t2 = acc[2][r] + eb_ * aci[2][r];
                const float den = __shfl(t2, hi * 32);
                const float inv = frcp(fmaxf(fabsf(den), 1.f));
                hs[0][r] += (acc[0][r] + eb_ * aci[0][r]) * inv; hs[1][r] += (acc[1][r] + eb_ * aci[1][r]) * inv;
            }
            __syncthreads();
        }
#pragma unroll
        for (int e = 0; e < 2; ++e)
#pragma unroll
            for (int r = 0; r < 16; ++r) hb[(32 * tb + crow(r, hi)) * ML_LDP + 32 * (2 * wg2 + e) + n] = f2bf(hs[e][r]);
        __syncthreads();
        const float g0 = ng[h * 128 + 2 * c.lane], g1 = ng[h * 128 + 2 * c.lane + 1];
        for (int rr = 0; rr < 16; ++rr) {
            const int t = 16 * c.wave + rr; const unsigned w = *(const LAS unsigned*)(hb + t * ML_LDP + 2 * c.lane);
            const float x0 = bflo(w), x1 = bfhi(w);
            const float mean = wave_sum(x0 + x1) * (1.f / 128.f); const float d0 = x0 - mean, d1 = x1 - mean;
            const float rstd = rsqrtf(wave_sum(d0 * d0 + d1 * d1) * (1.f / 128.f) + EPS);
            const unsigned ow = *(const unsigned*)(og + (size_t)(row0 + t) * 1024 + h * 128 + 2 * c.lane);
            *(unsigned*)(Z + (size_t)(row0 + t) * 1024 + h * 128 + 2 * c.lane) = pk2(d0 * rstd * g0 * sigmoidf_(bflo(ow)), d1 * rstd * g1 * sigmoidf_(bfhi(ow)));
        }
        __syncthreads();
    }
}

constexpr int RT_CH = 512, RT_NC = SEQ / RT_CH, RT_H = 4, RT_DK = 256, RT_DV = 512;
constexpr int RT_LDK = 264, RT_LDB = 544, RT_LDA = 72, RT_LD2 = 288;
DI void rt_phase2(const Ctx& c, const bf16* k, const bf16* v, const float* dlogit, bf16* RS) {
    LAS bf16* kw = (LAS bf16*)c.lds; LAS bf16* vh = kw + 64 * RT_LD2;
    const int NU = BATCH * RT_H * 2 * RT_NC;
    const int n = c.lane & 31, hi = c.lane >> 5;
    for (int u = c.bx; u < NU; u += c.G) {
        const int ck = u % RT_NC, dir = (u / RT_NC) & 1, h = (u / (2 * RT_NC)) % RT_H, b = u / (2 * RT_NC * RT_H);
        const int row0 = b * SEQ + ck * RT_CH;
        const float lg2 = log_sigmoid_(dlogit[dir * 4 + h]) * LOG2E;
        bf16* dst = RS + ((size_t)((b * RT_H + h) * 2 + dir) * RT_NC + ck) * (RT_DK * RT_DV);
        for (int half = 0; half < 2; ++half) {
            f32x16 acc[8] = {};
            u32x4 pk_[4], pv_[4];
#define R2_PREFETCH(sb_) do { int ot = c.tid; asm volatile("" : "+v"(ot)); \
            _Pragma("unroll") for (int i = 0; i < 4; ++i) { const int ch = ot + 512 * i, r = ch >> 5, cc = (ch & 31) * 8; const int s = 64 * (sb_) + r; \
                pk_[i] = *(const u32x4*)(k + (size_t)(row0 + s) * 1024 + h * 256 + cc); pv_[i] = *(const u32x4*)(v + (size_t)(row0 + s) * 2048 + h * 512 + half * 256 + cc); } } while (0)
            R2_PREFETCH(0);
#pragma unroll 1
            for (int sb = 0; sb < RT_CH / 64; ++sb) {
                __syncthreads();
                { int ot = c.tid; asm volatile("" : "+v"(ot));
#pragma unroll
                  for (int i = 0; i < 4; ++i) { const int ch = ot + 512 * i, r = ch >> 5, cc = (ch & 31) * 8; const int s = 64 * sb + r;
                    const float w = fexp2(lg2 * (float)(dir ? s : (RT_CH - 1 - s)));
                    u32x4 o;
#pragma unroll
                    for (int q = 0; q < 4; ++q) o[q] = pk2(bflo(pk_[i][q]) * w, bfhi(pk_[i][q]) * w);
                    *(LAS u32x4*)(kw + r * RT_LD2 + cc) = o;
                    *(LAS u32x4*)(vh + r * RT_LD2 + cc) = pv_[i]; } }
                if (sb + 1 < RT_CH / 64) R2_PREFETCH(sb + 1);
                __syncthreads();
#pragma unroll 1
                for (int ks = 0; ks < 4; ++ks) { const bf16x8 A = frag_tr(kw, RT_LD2, 16 * ks, 32 * c.wave, c.lane);
#pragma unroll
                    for (int et = 0; et < 8; ++et) { acc[et] = MFMA32(A, frag_tr(vh, RT_LD2, 16 * ks, 32 * et, c.lane), acc[et]); if (et == 3) __builtin_amdgcn_sched_barrier(0); } }
            }
#undef R2_PREFETCH
#pragma unroll
            for (int et = 0; et < 8; ++et)
#pragma unroll
                for (int r = 0; r < 16; ++r) dst[(size_t)(32 * c.wave + crow(r, hi)) * RT_DV + half * 256 + 32 * et + n] = f2bf(acc[et][r]);
        }
        __syncthreads();
    }
}
DI void rt_phase3(const Ctx& c, bf16* RS, const float* dlogit) {
    constexpr int NG = RT_DK * RT_DV / 8;
    const int NTASK = BATCH * RT_H * 2 * NG;
    for (int t = c.bx * NTHREADS + c.tid; t < NTASK; t += c.G * NTHREADS) {
        const int g = t % NG, chain = t / NG, dir = chain & 1, h = (chain >> 1) % RT_H;
        const float gch = fexp2(log_sigmoid_(dlogit[dir * 4 + h]) * LOG2E * (float)RT_CH);
        bf16* base = RS + (size_t)chain * RT_NC * (RT_DK * RT_DV) + (size_t)g * 8;
        float carry[8];
#pragma unroll
        for (int i = 0; i < 8; ++i) carry[i] = 0.f;
#pragma unroll
        for (int s = 0; s < RT_NC; ++s) {
            const int ck = dir ? (RT_NC - 1 - s) : s;
            u32x4* p = (u32x4*)(base + (size_t)ck * (RT_DK * RT_DV)); const u32x4 a = *p;
            u32x4 o;
#pragma unroll
            for (int q = 0; q < 4; ++q) { o[q] = pk2(carry[2 * q], carry[2 * q + 1]); carry[2 * q] = gch * carry[2 * q] + bflo(a[q]); carry[2 * q + 1] = gch * carry[2 * q + 1] + bfhi(a[q]); }
            *p = o;
        }
    }
}
DI void rt_phase4(const Ctx& c, const bf16* q, const bf16* k, const bf16* v, bf16* gz, const bf16* RS, const float* dlogit, const float* ng, const bool wr = true) {
    LAS bf16* kt = (LAS bf16*)c.lds; LAS bf16* Bt = kt + 64 * RT_LDK; LAS bf16* At = Bt + 64 * RT_LDB; LAS float* red = (LAS float*)(At + 128 * RT_LDA);
    constexpr int NI = RT_CH / 64, NQ = RT_CH / 128, NS = NI + 8;
    const int NU = BATCH * RT_H * RT_NC * NQ;
    const int n = c.lane & 31, hi = c.lane >> 5, tb = c.wave & 3, eh = c.wave >> 2;
    for (int u = c.bx; u < NU; u += c.G) {
        const int tq = u % NQ, ck = (u / NQ) % RT_NC, h = (u / (NQ * RT_NC)) % RT_H, b = u / (NQ * RT_NC * RT_H);
        const int rowc = b * SEQ + ck * RT_CH, rowq = rowc + tq * 128;
        const float lf2 = log_sigmoid_(dlogit[h]) * LOG2E, lb2 = log_sigmoid_(dlogit[4 + h]) * LOG2E;
        const bf16* qg = q + (size_t)rowq * 1024 + h * 256;
        f32x16 acc[8] = {};
        u32x4 sb_[8], sk_[4];
#define RT_PREFETCH(st) do { int ot = c.tid; asm volatile("" : "+v"(ot)); \
        if ((st) < NI) { const int s0_ = 64 * (st); \
            _Pragma("unroll") for (int i = 0; i < 4; ++i) { const int ch = ot + 512 * i, r = ch >> 5, cc = (ch & 31) * 8; sk_[i] = *(const u32x4*)(k + (size_t)(rowc + s0_ + r) * 1024 + h * 256 + cc); } \
            _Pragma("unroll") for (int i = 0; i < 8; ++i) { const int ch = ot + 512 * i, r = ch >> 6, cc = (ch & 63) * 8; sb_[i] = *(const u32x4*)(v + (size_t)(rowc + s0_ + r) * 2048 + h * 512 + cc); } \
        } else { const int dir_ = ((st) - NI) >> 2, d0_ = 64 * (((st) - NI) & 3); \
            const bf16* rs_ = RS + ((size_t)((b * RT_H + h) * 2 + dir_) * RT_NC + ck) * (RT_DK * RT_DV) + (size_t)d0_ * RT_DV; \
            _Pragma("unroll") for (int i = 0; i < 8; ++i) { const int ch = ot + 512 * i, r = ch >> 6, cc = (ch & 63) * 8; sb_[i] = *(const u32x4*)(rs_ + (size_t)r * RT_DV + cc); } \
            _Pragma("unroll") for (int i = 0; i < 2; ++i) { const int ch = ot + 512 * i, r = ch >> 3, cc = (ch & 7) * 8; sk_[i] = *(const u32x4*)(qg + (size_t)r * 1024 + d0_ + cc); } } } while (0)
        RT_PREFETCH(0);
#pragma unroll 1
        for (int step = 0; step < NS; ++step) {
            __syncthreads();
            { int ot = c.tid; asm volatile("" : "+v"(ot));
#pragma unroll
              for (int i = 0; i < 8; ++i) { const int ch = ot + 512 * i, r = ch >> 6, cc = (ch & 63) * 8; *(LAS u32x4*)(Bt + r * RT_LDB + cc) = sb_[i]; }
              if (step < NI) {
#pragma unroll
                  for (int i = 0; i < 4; ++i) { const int ch = ot + 512 * i, r = ch >> 5, cc = (ch & 31) * 8; *(LAS u32x4*)(kt + r * RT_LDK + cc) = sk_[i]; }
              } else {
                  const int dir = (step - NI) >> 2;
#pragma unroll
                  for (int i = 0; i < 2; ++i) { const int ch = ot + 512 * i, r = ch >> 3, cc = (ch & 7) * 8; const int tpos = 128 * tq + r;
                      const float xi = dir ? fexp2(lb2 * (float)(RT_CH - tpos)) : fexp2(lf2 * (float)(tpos + 1));
                      u32x4 o;
#pragma unroll
                      for (int q4 = 0; q4 < 4; ++q4) o[q4] = pk2(bflo(sk_[i][q4]) * xi, bfhi(sk_[i][q4]) * xi);
                      *(LAS u32x4*)(At + r * RT_LDA + cc) = o; }
              } }
            if (step >= NI && step + 1 < NS) RT_PREFETCH(step + 1);
            __syncthreads();
            if (step < NI) {
                const int s0 = 64 * step;
                f32x16 a = {};
#pragma unroll 4
                for (int kd = 0; kd < 16; ++kd) a = MFMA32(frag_row(kt, RT_LDK, 32 * eh, 16 * kd, c.lane), gfrag_row(qg, 1024, 32 * tb, 16 * kd, c.lane), a);
                const int tl = 32 * tb + n, tpos = 128 * tq + tl;
#pragma unroll
                for (int g4 = 0; g4 < 4; ++g4) {
                    const int sl = 32 * eh + 8 * g4 + 4 * hi;
                    float w[4];
#pragma unroll
                    for (int j = 0; j < 4; ++j) { const float rel = (float)(tpos - (s0 + sl + j));
                        const float mk = (rel >= 0.f ? fexp2(rel * lf2) : 0.f) + (rel <= 0.f ? fexp2(-rel * lb2) : 0.f); w[j] = a[4 * g4 + j] * mk; }
                    u32x2 o; o.x = pk2(w[0], w[1]); o.y = pk2(w[2], w[3]);
                    *(LAS u32x2*)(At + tl * RT_LDA + sl) = o;
                }
                RT_PREFETCH(step + 1);
                __syncthreads();
            }
#pragma unroll 1
            for (int ks = 0; ks < 4; ++ks) { const bf16x8 A = frag_row(At, RT_LDA, 32 * tb, 16 * ks, c.lane);
#pragma unroll
                for (int et = 0; et < 8; ++et) { acc[et] = MFMA32(A, frag_tr(Bt, RT_LDB, 16 * ks, 32 * (8 * eh + et), c.lane), acc[et]); if (et == 3) __builtin_amdgcn_sched_barrier(0); } }
        }
#undef RT_PREFETCH
#pragma unroll
        for (int r = 0; r < 16; ++r) {
            float s1 = 0.f, s2 = 0.f;
#pragma unroll
            for (int et = 0; et < 8; ++et) { s1 += acc[et][r]; s2 += acc[et][r] * acc[et][r]; }
#pragma unroll
            for (int o = 1; o < 32; o <<= 1) { s1 += __shfl_xor(s1, o); s2 += __shfl_xor(s2, o); }
            if (n == 0) { red[((32 * tb + crow(r, hi)) * 2 + eh) * 2] = s1; red[((32 * tb + crow(r, hi)) * 2 + eh) * 2 + 1] = s2; }
        }
        __syncthreads();
#pragma unroll
        for (int r = 0; r < 16; ++r) {
            const int tl = 32 * tb + crow(r, hi);
            const float s1 = red[(tl * 2) * 2] + red[(tl * 2 + 1) * 2], s2 = red[(tl * 2) * 2 + 1] + red[(tl * 2 + 1) * 2 + 1];
            const float mean = s1 * (1.f / 512.f), var = fmaxf(s2 * (1.f / 512.f) - mean * mean, 0.f), rstd = rsqrtf(var + EPS);
            bf16* gp = gz + (size_t)(rowq + tl) * 2048 + h * 512 + 256 * eh + n;
#pragma unroll
            for (int et = 0; et < 8; ++et) { const float gt = bf2f(gp[32 * et]); const float y = (acc[et][r] - mean) * rstd * ng[h * 512 + 256 * eh + 32 * et + n];
                if (wr) gp[32 * et] = f2bf(y * gt * sigmoidf_(gt)); }
        }
        __syncthreads();
    }
}

struct Args { const float* in[25]; float* out; unsigned char* ws; int ph_lo, ph_hi; };
constexpr int NPHASES = 64;
#define PHASE(...) do { if (ph >= lo && ph < hi) { { Ctx c = c0; c.lane = (int)__builtin_amdgcn_mbcnt_hi(~0u, __builtin_amdgcn_mbcnt_lo(~0u, 0u)); c.tid = c0.wave * 64 + c.lane; asm volatile("" : "+v"(c.tid)); \
    c.lane = c.tid & 63; c.wave = __builtin_amdgcn_readfirstlane(c.tid >> 6); c.gw = c.bx * NWAVES + c.wave; \
    __VA_ARGS__; } if (ph + 1 < hi) xcd_barrier(bar); } ++ph; } while (0)

template <int L> DI void run_layer(const Ctx& c0, const Args& args, const XcdBarrier& bar, const int lo, const int hi, int& ph) {
    unsigned char* ws = args.ws;
    const float* x = args.in[0]; const float* norm_g = args.in[1];
    float* rope = (float*)(ws + WS_ROPE);
    float* RSTD = (float*)(ws + 3 * MiB);
    bf16* HB = (bf16*)(ws + WS_XN);
    bf16* DOUT16 = (bf16*)args.out;
    unsigned char* S = ws + WS_S;
    bf16* WTmix = (bf16*)(ws + WT_MIX); bf16* WTup = (bf16*)(ws + WT_UP); bf16* WTdown = (bf16*)(ws + WT_DOWN);
    LAS unsigned char* ring = c0.lds;
    const float* g0 = norm_g + (size_t)(L * 4 + 0) * DM; const float* g1 = g0 + DM; const float* g2 = g0 + 2 * DM; const float* g3 = g0 + 3 * DM;
    bf16* AOUT = (bf16*)S;
#define FFN_JOBS(LL) {args.in[2] + (size_t)(LL) * DM * FFN_U, DM, FFN_U, WTup, MAP_FFNUP, 0, norm_g + (size_t)((LL) * 4 + 2) * DM}, {args.in[5] + (size_t)(LL) * FFN_H * DM, FFN_H, DM, WTdown, MAP_ID, 0, nullptr}
    if constexpr (L == 0) {
        bf16* Wd = WTmix; bf16* Wuq = (bf16*)(ws + WT_MIX + 2 * MiB); bf16* Wukv = (bf16*)(ws + WT_MIX + 4 * MiB); bf16* Wo = (bf16*)(ws + WT_MIX + 6 * MiB);
        bf16* DQKV = (bf16*)S; bf16* CQ = (bf16*)(S + 48 * MiB); bf16* CKV = (bf16*)(S + 72 * MiB); bf16* Q = (bf16*)(S + 88 * MiB); bf16* KF = (bf16*)(S + 184 * MiB);
        bf16* V = (bf16*)(S + 280 * MiB); bf16* O = (bf16*)(S + 344 * MiB);
        PHASE({
            fill_rope(c, rope);
            const TJob jobs[7] = {{args.in[6], DM, 384, Wd, MAP_ID, 0, g0}, {args.in[9], DM, 320, Wd, MAP_ID, 384, g0}, {args.in[8], 384, 1536, Wuq, MAP_ROPEQ, 0, nullptr},
                                  {args.in[11], 256, 2048, Wukv, MAP_ID, 0, nullptr}, {args.in[12], DM, DM, Wo, MAP_ID, 0, nullptr}, FFN_JOBS(0)};
            run_transposes<7>(c, jobs);
            zero_rows(c, Wd, DM, 704, 64);
            pass_first(c, x, HB, RSTD);
        });
        PHASE({ pg8::Gemm g{HB, Wd, MROWS, 768, DM, DM, 256}; pg8::StaticOrder so; so.init(MROWS, 768, c.G, c.bx);
            pg8::gemm_phase(ring, c.tid, g, so, pg8::epi_plain(DQKV, 768, 1.f, RSTD)); });
        PHASE({ pass_mla_mid(c, DQKV, args.in[7], args.in[10], rope, CQ, CKV, KF); });
        PHASE({ pg8::Gemm g{CQ, Wuq, MROWS, 1536, 384, 384, 256}; pg8::StaticOrder so; so.init(MROWS, 1536, c.G, c.bx);
              pg8::gemm_phase(ring, c.tid, g, so, pg8::epi_plain(Q, 1536, 0.07216878364870322f * LOG2E)); });
        PHASE({ pg8::Gemm g{CKV, Wukv, MROWS, 2048, 256, 256, 256}; pg8::StaticOrder so; so.init(MROWS, 2048, c.G, c.bx);
              pg8::EpiMlaKV E{KF, V}; pg8::gemm_phase(ring, c.tid, g, so, E); });
        PHASE({ attention_phase<192, false, true, 1536, 192, 1536, 192, 1024, 128, 1, 1024, 128, 8>(c, Q, KF, V, O, rope, (unsigned*)(ws + WS_CTL)); });
        PHASE({ pg8::Gemm g{O, Wo, MROWS, DM, DM, DM, 256}; pg8::StaticOrder so; so.init(MROWS, DM, c.G, c.bx);
            pg8::gemm_phase(ring, c.tid, g, so, pg8::epi_plain(AOUT, DM, 1.f)); });
    } else if constexpr (L == 1) {
        bf16* Wqkv = WTmix; bf16* Wo = (bf16*)(ws + WT_MIX + 8 * MiB);
        bf16* Qd = (bf16*)S; bf16* Kd = (bf16*)(S + 64 * MiB); bf16* Vd = (bf16*)(S + 128 * MiB); bf16* OS = (bf16*)(S + 192 * MiB); bf16* OC = (bf16*)(S + 320 * MiB);
        PHASE({ pg8::Gemm g{HB, Wqkv, MROWS, 3072, DM, DM, 256}; pg8::StaticOrder so; so.init(MROWS, 3072, c.G, c.bx);
            pg8::EpiSeg<false> E{}; E.p0 = Qd; E.ld0 = DM; E.s0 = 0.125f * LOG2E; E.e0 = 8; E.p1 = Kd; E.ld1 = DM; E.s1 = 1.f; E.e1 = 16; E.p2 = Vd; E.ld2 = DM; E.s2 = 1.f; E.e2 = 100000; E.rowscale = RSTD;
            pg8::gemm_phase(ring, c.tid, g, so, E); });
        PHASE({ pass_kmax(c, Kd, (unsigned*)(ws + WS_CTL)); });
        PHASE({ attention_phase<64, true, false, 1024, 64, 1024, 64, 1024, 128, 2, 2048, 128, 16>(c, Qd, Kd, Vd, OS, rope, (unsigned*)(ws + WS_CTL)); });
        PHASE({ pass_diff_combine(c, OS, args.in[14], args.in[15], OC); });
        PHASE({ pg8::Gemm g{OC, Wo, MROWS, DM, DM, DM, 256}; pg8::StaticOrder so; so.init(MROWS, DM, c.G, c.bx);
            pg8::gemm_phase(ring, c.tid, g, so, pg8::epi_plain(AOUT, DM, 1.f)); });
    } else if constexpr (L == 2) {
        bf16* Win = WTmix; bf16* Wout = (bf16*)(ws + WT_MIX + 8 * MiB);
        bf16* q = (bf16*)S; bf16* k = (bf16*)(S + 32 * MiB); bf16* v = (bf16*)(S + 64 * MiB); bf16* og = (bf16*)(S + 128 * MiB);
        float* gates = (float*)(S + 192 * MiB); float* DEC = (float*)(S + 196 * MiB); bf16* ST = (bf16*)(S + 200 * MiB); bf16* Z = (bf16*)(S + 288 * MiB);
        PHASE({ pg8::Gemm g{HB, Win, MROWS, 3328, DM, DM, 256}; pg8::StaticOrder so; so.init(MROWS, 3328, c.G, c.bx);
            pg8::EpiSeg<true> E{}; E.p0 = q; E.ld0 = 512; E.s0 = 1.f; E.e0 = 4; E.p1 = k; E.ld1 = 512; E.s1 = 0.125f; E.e1 = 8; E.p2 = v; E.ld2 = DM; E.s2 = 1.f; E.e2 = 16; E.p3 = og; E.ld3 = DM; E.s3 = 1.f;
            E.gates = gates; E.gbias = args.in[18]; E.gblk = 24; E.rowscale = RSTD;
            pg8::gemm_phase(ring, c.tid, g, so, E); });
        PHASE({ ml_phase1(c, k, v, gates, ST, DEC); });
        PHASE({ ml_phase2(c, ST, DEC); });
        PHASE({ ml_phase3(c, q, k, v, og, gates, ST, args.in[19], Z); });
        PHASE({ pg8::Gemm g{Z, Wout, MROWS, DM, DM, DM, 256}; pg8::StaticOrder so; so.init(MROWS, DM, c.G, c.bx);
            pg8::gemm_phase(ring, c.tid, g, so, pg8::epi_plain(AOUT, DM, 1.f)); });
    } else {
        bf16* Win = WTmix; bf16* Wo = (bf16*)(ws + WT_MIX + 12 * MiB);
        bf16* q = (bf16*)S; bf16* k = (bf16*)(S + 64 * MiB); bf16* v = (bf16*)(S + 128 * MiB); bf16* gz = (bf16*)(S + 256 * MiB); bf16* RS = DOUT16;
        PHASE({ pg8::Gemm g{HB, Win, MROWS, 6144, DM, DM, 256}; pg8::StaticOrder so; so.init(MROWS, 6144, c.G, c.bx);
            pg8::EpiSeg<false> E{}; E.p0 = q; E.ld0 = DM; E.s0 = 1.f; E.e0 = 8; E.p1 = k; E.ld1 = DM; E.s1 = 0.0625f; E.e1 = 16; E.p2 = v; E.ld2 = 2048; E.s2 = 1.f; E.e2 = 32; E.p3 = gz; E.ld3 = 2048; E.s3 = 1.f; E.rowscale = RSTD;
            pg8::gemm_phase(ring, c.tid, g, so, E); });
        PHASE({ rt_phase2(c, k, v, args.in[22], RS); });
        PHASE({ rt_phase3(c, RS, args.in[22]); });
        PHASE({ rt_phase4(c, q, k, v, gz, RS, args.in[22], args.in[23]); });
        PHASE({ pg8::Gemm g{gz, Wo, MROWS, DM, 2048, 2048, 256}; pg8::StaticOrder so; so.init(MROWS, DM, c.G, c.bx);
            pg8::gemm_phase(ring, c.tid, g, so, pg8::epi_plain(AOUT, DM, 1.f)); });
    }
    PHASE({ pass_res(c, AOUT, g1, HB, RSTD); });
    bf16* HH = (bf16*)S; float* HALO2 = (float*)(S + 352 * MiB);
    const float* cwL = args.in[3] + (size_t)L * 3 * FFN_U; const float* cbL = args.in[4] + (size_t)L * FFN_U;
    PHASE({ pg8::Gemm g{HB, WTup, MROWS, FFN_U, DM, DM, 256}; pg8::StaticOrder so; so.init(MROWS, FFN_U, c.G, c.bx);
        pg8::EpiFfnConv E{HH, HALO2, RSTD, cwL, cbL}; pg8::gemm_phase(ring, c.tid, g, so, E); });
#define FFN_DOWN_FIX() do { pg8::Unit u_; for (int i_ = 0; so.next(i_, u_); ++i_) pg8::ffn_fix_rows(c.lane, c.wave, NWAVES, u_.pm, u_.pm + 1, HALO2, cwL, cbL, HH); \
        asm volatile("s_waitcnt vmcnt(0)" ::: "memory"); __syncthreads(); } while (0)
    if constexpr (L < 3) {
        PHASE({ pg8::Gemm g{HH, WTdown, MROWS, DM, FFN_H, FFN_H, 256}; pg8::StaticOrder so; so.init(MROWS, DM, c.G, c.bx);
            FFN_DOWN_FIX();
            pg8::gemm_phase(ring, c.tid, g, so, pg8::epi_plain(DOUT16, DM, 1.f)); });
        PHASE({
            pass_res(c, DOUT16, g3, HB, RSTD);
            const float* gn = g0 + 4 * DM;
            if constexpr (L == 0) { const TJob jobs[4] = {{args.in[13], DM, 3072, WTmix, MAP_ID, 0, gn}, {args.in[16], DM, DM, (bf16*)(ws + WT_MIX + 8 * MiB), MAP_ID, 0, nullptr}, FFN_JOBS(1)}; run_transposes<4>(c, jobs); }
            else if constexpr (L == 1) { const TJob jobs[4] = {{args.in[17], DM, 3104, WTmix, MAP_ID, 0, gn}, {args.in[20], DM, DM, (bf16*)(ws + WT_MIX + 8 * MiB), MAP_ID, 0, nullptr}, FFN_JOBS(2)}; run_transposes<4>(c, jobs);
                zero_rows(c, WTmix, DM, 3104, 224); }
            else { const TJob jobs[4] = {{args.in[21], DM, 6144, WTmix, MAP_ID, 0, gn}, {args.in[24], 2048, DM, (bf16*)(ws + WT_MIX + 12 * MiB), MAP_ID, 0, nullptr}, FFN_JOBS(3)}; run_transposes<4>(c, jobs); }
        });
    } else {
        PHASE({ pg8::Gemm g{HH, WTdown, MROWS, DM, FFN_H, FFN_H, 256}; pg8::StaticOrder so; so.init(MROWS, DM, c.G, c.bx);
            FFN_DOWN_FIX();
            pg8::EpiF32 E{args.out, DM}; pg8::gemm_phase(ring, c.tid, g, so, E); });
        PHASE({ pass_final(c, args.out, g3, HB); });
    }
#undef FFN_DOWN_FIX
#undef FFN_JOBS
}

__global__ void __launch_bounds__(NTHREADS, 2) enc_fwd(Args args) {
    extern __shared__ __attribute__((aligned(16))) unsigned char lds_raw[];
    Ctx c;
    c.lds = (LAS unsigned char*)lds_raw;
    c.tid = threadIdx.x; c.lane = c.tid & 63; c.wave = __builtin_amdgcn_readfirstlane(c.tid >> 6);
    c.G = gridDim.x; c.bx = blockIdx.x; c.gw = c.bx * NWAVES + c.wave; c.NGW = c.G * NWAVES;
    volatile LAS unsigned* MISC = (volatile LAS unsigned*)(c.lds + MISC_OFF);
    for (int u = c.tid; u < (LDS_BYTES - LDSCTL_OFF) / 4; u += NTHREADS) ((LAS unsigned*)(c.lds + LDSCTL_OFF))[u] = 0u;
    __syncthreads();
    XcdBarrier bar = xcd_barrier_post((unsigned*)(args.ws + WS_CTL) + 4096, MISC + 8);
    const int lo = args.ph_lo, hi = args.ph_hi;
    int ph = 0;
    run_layer<0>(c, args, bar, lo, hi, ph);
    run_layer<1>(c, args, bar, lo, hi, ph);
    run_layer<2>(c, args, bar, lo, hi, ph);
    run_layer<3>(c, args, bar, lo, hi, ph);
}
#undef PHASE

#ifndef MK_N_LAUNCHES
#define MK_N_LAUNCHES 1
#endif
extern "C" void kernel_launch(void* const* d_in, const int* in_sizes, int n_in, void* d_out, int out_size, void* d_ws, size_t ws_size, hipStream_t stream) {
    static int grid = 0;
    if (grid == 0) {
        if (n_in != 25 || in_sizes[0] != MROWS * DM || out_size != MROWS * DM || ws_size < WS_END) {
            fprintf(stderr, "kernel_launch: unexpected shapes: n_in %d in0 %d out %d ws %zu (need %zu)\n", n_in, n_in > 0 ? in_sizes[0] : -1, out_size, ws_size, (size_t)WS_END); grid = -1; return; }
        int dev = 0, cus = 0, per_cu = 0;
        if (hipGetDevice(&dev) != hipSuccess || hipDeviceGetAttribute(&cus, hipDeviceAttributeMultiprocessorCount, dev) != hipSuccess) { grid = -1; return; }
        if (hipFuncSetAttribute((const void*)enc_fwd, hipFuncAttributeMaxDynamicSharedMemorySize, LDS_BYTES) != hipSuccess) { fprintf(stderr, "kernel_launch: hipFuncSetAttribute failed\n"); grid = -1; return; }
        if (hipOccupancyMaxActiveBlocksPerMultiprocessor(&per_cu, (const void*)enc_fwd, NTHREADS, LDS_BYTES) != hipSuccess || per_cu < 1)
            fprintf(stderr, "kernel_launch: note: occupancy query reports %d workgroups per CU\n", per_cu);
        (void)hipGetLastError();
        grid = cus;
    }
    if (grid < 0) return;
    Args a{};
    for (int i = 0; i < 25; ++i) a.in[i] = (const float*)d_in[i];
    a.out = (float*)d_out; a.ws = (unsigned char*)d_ws;
    if (MK_N_LAUNCHES == 1) {
        (void)hipMemsetAsync((char*)d_ws + WS_CTL, 0, CTL_ZERO_BYTES, stream);
        a.ph_lo = 0; a.ph_hi = NPHASES;
        hipLaunchKernelGGL(enc_fwd, dim3(grid), dim3(NTHREADS), LDS_BYTES, stream, a);
    } else {
        for (int p = 0; p < NPHASES; ++p) {
            (void)hipMemsetAsync((char*)d_ws + WS_CTL, 0, CTL_ZERO_BYTES, stream);
            a.ph_lo = p; a.ph_hi = p + 1;
            hipLaunchKernelGGL(enc_fwd, dim3(grid), dim3(NTHREADS), LDS_BYTES, stream, a);
        }
    }
    const hipError_t le = hipPeekAtLastError();
    if (le != hipSuccess) fprintf(stderr, "kernel_launch: launch failed: %s\n", hipGetErrorName(le));
}
```
